# Optimizing an MI355X kernel written in HIP

```python
import jax, jax.numpy as jnp
from jax import lax
import numpy as np

D_MODEL = 2048
BATCH = 4
SEQ = 4096
DEPTH = 2

GRID_W = 64
CTX_LEN = 256
HEAD_DIM = 64

CONV_CH = 512
CONV_K = 3
NA_HEADS = 12
NA_DIM = NA_HEADS * HEAD_DIM
WIN_ROWS_MAX = 8
WIN_COLS = 16
RW_HEADS = 12
RW_DIM = RW_HEADS * HEAD_DIM
RW_DECAY_LORA = 48
RW_A_LORA = 48
RW_GATE_LORA = 96

MIX_DIM = CONV_CH + NA_DIM + RW_DIM
A_COLS = 3 * CONV_CH
B_COLS = 3 * NA_DIM
RW_COLS = 3 * RW_DIM + RW_GATE_LORA + 2 * (RW_DECAY_LORA + RW_A_LORA)
IN_COLS = A_COLS + B_COLS + RW_COLS
RW_SPLITS = (RW_DIM, 2 * RW_DIM, 3 * RW_DIM, 3 * RW_DIM + RW_GATE_LORA, 3 * RW_DIM + RW_GATE_LORA + 2 * RW_DECAY_LORA)

N_EXPERTS = 64
TOP_K = 6
D_EXPERT = 512
D_SHARED = 512
ROUTE_SCALE = 2.5
MOE_BLOCK = 128

ROPE_THETA = 10000.0
NORM_EPS = 1e-6
GN_EPS = 64e-5
N_MOD = 6

kernel_name = "hybrid_latent_diffusion_block"


def rms_norm(x, g):
    xf = x.astype(jnp.float32)
    y = xf * lax.rsqrt(jnp.mean(xf * xf, axis=-1, keepdims=True) + NORM_EPS)
    return (y * g.astype(jnp.float32)).astype(x.dtype)


def modulate(xn, shift, scale):
    return xn * (1.0 + scale) + shift


def neighbours(x):
    zero = jnp.zeros_like(x[:, :1])
    prev = jnp.concatenate([zero, x[:, :-1]], axis=1)
    nxt = jnp.concatenate([x[:, 1:], zero], axis=1)
    return prev, nxt


def short_conv_mixer(za, conv_w):
    b_gate, c_gate, h = jnp.split(za, 3, axis=-1)
    u = c_gate * h
    prev, nxt = neighbours(u)
    conv = conv_w[0] * prev + conv_w[1] * u + conv_w[2] * nxt
    return b_gate * conv


def axial_rope_tables(n_tokens):
    pos = jnp.arange(n_tokens, dtype=jnp.int32)
    axes = jnp.stack([pos // GRID_W, pos % GRID_W], axis=-1).astype(jnp.float32)
    n_freq = HEAD_DIM // 4
    inv = 1.0 / (ROPE_THETA ** (jnp.arange(n_freq, dtype=jnp.float32) / n_freq))
    ang = axes[:, :, None] * inv
    return jnp.cos(ang), jnp.sin(ang)


def apply_axial_rope(x, rope):
    cos, sin = rope
    B, T, H, Dh = x.shape
    xf = x.astype(jnp.float32).reshape(B, T, H, 2, 2, Dh // 4)
    x1, x2 = xf[..., 0, :], xf[..., 1, :]
    cos = cos[None, :, None]
    sin = sin[None, :, None]
    out = jnp.stack([x1 * cos - x2 * sin, x2 * cos + x1 * sin], axis=-2)
    return out.reshape(B, T, H, Dh).astype(x.dtype)


def neighbourhood_index(rows, win_rows):
    q_row = np.arange(rows)
    q_col = np.arange(GRID_W)
    k_row = np.clip(q_row - win_rows // 2, 0, rows - win_rows)[:, None] + np.arange(win_rows)
    k_col = np.clip(q_col - WIN_COLS // 2, 0, GRID_W - WIN_COLS)[:, None] + np.arange(WIN_COLS)
    kidx = k_row[:, None, :, None] * GRID_W + k_col[None, :, None, :]
    d_row = k_row - q_row[:, None] + WIN_ROWS_MAX - 1
    d_col = k_col - q_col[:, None] + WIN_COLS - 1
    bidx = d_row[:, None, :, None] * (2 * WIN_COLS - 1) + d_col[None, :, None, :]
    n_win = win_rows * WIN_COLS
    return (kidx.reshape(rows, GRID_W, n_win).astype(np.int32),
            bidx.reshape(rows, GRID_W, n_win).astype(np.int32))


def neighbourhood_attention(zb_ctx, zb_lat, rpb, rope):
    B, L, _ = zb_lat.shape
    Lc = zb_ctx.shape[1]
    H, Dh = NA_HEADS, HEAD_DIM
    scale = Dh ** -0.5
    q_c, k_c, v_c = [t.reshape(B, Lc, H, Dh) for t in jnp.split(zb_ctx, 3, axis=-1)]
    q_l, k_l, v_l = [t.reshape(B, L, H, Dh) for t in jnp.split(zb_lat, 3, axis=-1)]

    s = jnp.einsum('bqhd,bkhd->bhqk', q_c, k_c).astype(jnp.float32) * scale
    p = jax.nn.softmax(s, axis=-1).astype(v_c.dtype)
    o_ctx = jnp.einsum('bhqk,bkhd->bqhd', p, v_c).reshape(B, Lc, H * Dh)

    rows = L // GRID_W
    kidx, bidx = neighbourhood_index(rows, min(WIN_ROWS_MAX, rows))
    n_win = kidx.shape[-1]
    q_rot = apply_axial_rope(q_l, rope)
    k_rot = apply_axial_rope(k_l, rope)
    bias = jnp.moveaxis(rpb.reshape(H, -1)[:, bidx], 1, 0).astype(jnp.float32)

    def to_rows(t):
        return jnp.moveaxis(t.reshape(B, rows, GRID_W, H, Dh), 1, 0)

    def row_block(args):
        qr_b, q_b, kidx_b, bias_b = args
        k_win = k_rot[:, kidx_b]
        v_win = v_l[:, kidx_b]
        s_win = jnp.einsum('bqhd,bqkhd->bhqk', qr_b, k_win).astype(jnp.float32) * scale + bias_b[None]
        s_ctx = jnp.einsum('bqhd,bkhd->bhqk', q_b, k_c).astype(jnp.float32) * scale
        p = jax.nn.softmax(jnp.concatenate([s_win, s_ctx], axis=-1), axis=-1).astype(v_l.dtype)
        return (jnp.einsum('bhqk,bqkhd->bqhd', p[..., :n_win], v_win)
                + jnp.einsum('bhqk,bkhd->bqhd', p[..., n_win:], v_c))

    o = lax.map(row_block, (to_rows(q_rot), to_rows(q_l), jnp.asarray(kidx), bias))
    o_lat = jnp.moveaxis(o, 0, 1).reshape(B, L, H * Dh)
    return o_ctx, o_lat


def rwkv_streams(zc, shift_mu, w0, w_up, a0, a_up, g_up, k_k, k_a):
    B, T, _ = zc.shape
    prev, nxt = neighbours(zc)
    zc = zc + shift_mu[0] * (prev - zc) + shift_mu[1] * (nxt - zc)
    r, k, v, g_lo, w_lo, a_lo = jnp.split(zc, RW_SPLITS, axis=-1)
    w_lo = w_lo.reshape(B, T, 2, RW_DECAY_LORA)
    a_lo = a_lo.reshape(B, T, 2, RW_A_LORA)
    w_pre = (w0 + jnp.einsum('btnr,nrc->btnc', jnp.tanh(w_lo), w_up)).astype(jnp.float32)
    decay = jnp.exp(-jnp.exp(-jax.nn.softplus(-w_pre) - 0.5))
    a = jax.nn.sigmoid((a0 + jnp.einsum('btnr,nrc->btnc', a_lo, a_up)).astype(jnp.float32))
    g = jax.nn.sigmoid(g_lo) @ g_up
    kk = (k * k_k).astype(jnp.float32).reshape(B, T, RW_HEADS, HEAD_DIM)
    kk = kk / jnp.maximum(jnp.sqrt(jnp.sum(kk * kk, axis=-1, keepdims=True)), 1e-12)
    kk = kk.reshape(B, T, 1, RW_DIM)
    k_dir = k.astype(jnp.float32)[:, :, None] * (1.0 + (a - 1.0) * k_a.astype(jnp.float32))
    b = kk * a
    return r, v, g, decay, kk, b, k_dir


def _dir_time_major(t):
    B, T, _, C = t.shape
    t = jnp.broadcast_to(t.astype(jnp.float32), (B, T, 2, C)).reshape(B, T, 2, RW_HEADS, HEAD_DIM)
    t = jnp.transpose(t, (1, 2, 0, 3, 4))
    return jnp.stack([t[:, 0], t[::-1, 1]], axis=1)


def _from_dir_time_major(y):
    y = jnp.stack([y[:, 0], y[::-1, 1]], axis=1)
    return jnp.transpose(y, (2, 0, 1, 3, 4))


def wkv_scan(s0, r, decay, kk, b, k, v):
    def step(s, inp):
        r_t, w_t, kk_t, b_t, k_t, v_t = inp
        sa = jnp.einsum('dbhvk,dbhk->dbhv', s, kk_t)
        s = s * w_t[..., None, :] - sa[..., None] * b_t[..., None, :] + v_t[..., None] * k_t[..., None, :]
        return s, jnp.einsum('dbhvk,dbhk->dbhv', s, r_t)
    return lax.scan(step, s0, (r, decay, kk, b, k, v))


def rwkv7_time_mix(zc_ctx, zc_lat, shift_mu, w0, w_up, a0, a_up, g_up, k_k, k_a, r_k, gn_g, gn_b):
    def run(zc, s0):
        B, T, _ = zc.shape
        r, v, g, decay, kk, b, k_dir = rwkv_streams(zc, shift_mu, w0, w_up, a0, a_up, g_up, k_k, k_a)
        seqs = [_dir_time_major(t) for t in (r[:, :, None], decay, kk, b, k_dir, v[:, :, None])]
        s_fin, y = wkv_scan(s0, *seqs)
        y = _from_dir_time_major(y).sum(axis=2)
        mean = jnp.mean(y, axis=-1, keepdims=True)
        var = jnp.mean(jnp.square(y - mean), axis=-1, keepdims=True)
        y = ((y - mean) * lax.rsqrt(var + GN_EPS)).reshape(B, T, RW_DIM) * gn_g + gn_b
        r_h = r.astype(jnp.float32).reshape(B, T, RW_HEADS, HEAD_DIM)
        v_h = v.astype(jnp.float32).reshape(B, T, RW_HEADS, HEAD_DIM)
        k_h = k_dir.reshape(B, T, 2, RW_HEADS, HEAD_DIM)
        bonus = jnp.einsum('bthn,btdhn,hn->bth', r_h, k_h, r_k.astype(jnp.float32))[..., None] * v_h
        out = (y + bonus.reshape(B, T, RW_DIM)) * g.astype(jnp.float32)
        return out.astype(zc.dtype), s_fin

    B = zc_lat.shape[0]
    s0 = jnp.zeros((2, B, RW_HEADS, HEAD_DIM, HEAD_DIM), jnp.float32)
    out_ctx, s_ctx = run(zc_ctx, s0)
    out_lat, _ = run(zc_lat, s_ctx)
    return out_ctx, out_lat


def moe_ffn(h, router_w, router_bias, e_gate, e_up, e_down, s_gate, s_up, s_down):
    n, d = h.shape
    scores = jax.nn.sigmoid((h @ router_w).astype(jnp.float32))
    _, idx = lax.top_k(scores + router_bias.astype(jnp.float32), TOP_K)
    wts = jnp.take_along_axis(scores, idx, axis=-1)
    wts = wts / jnp.sum(wts, axis=-1, keepdims=True) * ROUTE_SCALE

    e_flat = idx.reshape(-1)
    t_flat = jnp.repeat(jnp.arange(n, dtype=jnp.int32), TOP_K)
    w_flat = wts.reshape(-1)
    order = jnp.argsort(e_flat)
    e_s, t_s, w_s = e_flat[order], t_flat[order], w_flat[order]
    counts = jnp.zeros((N_EXPERTS,), jnp.int32).at[e_flat].add(1)
    start = jnp.cumsum(counts) - counts
    padded = (counts + MOE_BLOCK - 1) // MOE_BLOCK * MOE_BLOCK
    pend = jnp.cumsum(padded)
    pstart = pend - padded
    n_blocks = (n * TOP_K + MOE_BLOCK - 1) // MOE_BLOCK + N_EXPERTS
    cap = n_blocks * MOE_BLOCK
    dest = pstart[e_s] + jnp.arange(n * TOP_K, dtype=jnp.int32) - start[e_s]
    slot_tok = jnp.full((cap,), n, jnp.int32).at[dest].set(t_s)
    slot_w = jnp.zeros((cap,), jnp.float32).at[dest].set(w_s)
    block_exp = jnp.minimum(
        jnp.searchsorted(pend, jnp.arange(n_blocks, dtype=jnp.int32) * MOE_BLOCK, side='right'),
        N_EXPERTS - 1)
    h_pad = jnp.concatenate([h, jnp.zeros((1, d), h.dtype)], axis=0)

    def expert_block(args):
        tok, e = args
        xb = h_pad[tok]
        u = jax.nn.silu(xb @ e_gate[e]) * (xb @ e_up[e])
        return u @ e_down[e]

    y = lax.map(expert_block, (slot_tok.reshape(n_blocks, MOE_BLOCK), block_exp)).reshape(cap, d)
    routed = jnp.zeros((n + 1, d), h.dtype).at[slot_tok].add(y * slot_w[:, None].astype(h.dtype))[:n]
    shared = (jax.nn.silu(h @ s_gate) * (h @ s_up)) @ s_down
    return routed + shared


def setup_inputs(seed: int = 0) -> dict:
    key = jax.random.key(seed)
    ks = jax.random.split(key, 40)
    f32 = jnp.float32
    D = D_MODEL
    L = DEPTH

    def nrm(k, shape, scale):
        return jax.random.normal(k, shape, f32) * scale

    def unif(k, shape, lo, hi):
        return jax.random.uniform(k, shape, f32, lo, hi)

    return {
        "x": nrm(ks[0], (BATCH, SEQ, D), 1.0),
        "c": nrm(ks[1], (BATCH, D), 1.0),
        "ctx": nrm(ks[2], (BATCH, CTX_LEN, D), 1.0),
        "c_ctx": nrm(ks[3], (D,), 1.0),
        "norm1_g": 1.0 + nrm(ks[4], (L, D), 0.02),
        "norm2_g": 1.0 + nrm(ks[5], (L, D), 0.02),
        "ada_w": nrm(ks[6], (L, D, N_MOD * D), 0.5 * D ** -0.5),
        "ada_b": nrm(ks[7], (L, N_MOD * D), 0.02),
        "w_in": nrm(ks[8], (L, D, IN_COLS), D ** -0.5),
        "conv_w": nrm(ks[9], (L, CONV_K, CONV_CH), CONV_K ** -0.5),
        "rpb": nrm(ks[10], (L, NA_HEADS, 2 * WIN_ROWS_MAX - 1, 2 * WIN_COLS - 1), 0.1),
        "rw_shift": unif(ks[11], (L, 2, RW_COLS), 0.0, 0.5),
        "rw_w0": unif(ks[12], (L, 2, RW_DIM), -6.0, -1.0),
        "rw_w_up": nrm(ks[13], (L, 2, RW_DECAY_LORA, RW_DIM), 0.5 * RW_DECAY_LORA ** -0.5),
        "rw_a0": nrm(ks[14], (L, 2, RW_DIM), 0.1),
        "rw_a_up": nrm(ks[15], (L, 2, RW_A_LORA, RW_DIM), 0.5 * RW_A_LORA ** -0.5),
        "rw_g_up": nrm(ks[16], (L, RW_GATE_LORA, RW_DIM), RW_GATE_LORA ** -0.5),
        "rw_k_k": 0.85 + nrm(ks[17], (L, RW_DIM), 0.05),
        "rw_k_a": 1.0 + nrm(ks[18], (L, RW_DIM), 0.05),
        "rw_r_k": nrm(ks[19], (L, RW_HEADS, HEAD_DIM), 0.1),
        "rw_gn_g": 1.0 + nrm(ks[20], (L, RW_DIM), 0.02),
        "rw_gn_b": nrm(ks[21], (L, RW_DIM), 0.02),
        "w_out": nrm(ks[22], (L, MIX_DIM, D), MIX_DIM ** -0.5),
        "router_w": nrm(ks[23], (L, D, N_EXPERTS), D ** -0.5),
        "router_bias": nrm(ks[24], (L, N_EXPERTS), 0.01),
        "exp_gate": nrm(ks[25], (L, N_EXPERTS, D, D_EXPERT), D ** -0.5),
        "exp_up": nrm(ks[26], (L, N_EXPERTS, D, D_EXPERT), D ** -0.5),
        "exp_down": nrm(ks[27], (L, N_EXPERTS, D_EXPERT, D), D_EXPERT ** -0.5),
        "sh_gate": nrm(ks[28], (L, D, D_SHARED), D ** -0.5),
        "sh_up": nrm(ks[29], (L, D, D_SHARED), D ** -0.5),
        "sh_down": nrm(ks[30], (L, D_SHARED, D), D_SHARED ** -0.5),
        "final_g": 1.0 + nrm(ks[31], (D,), 0.02),
    }


def reference(x, c, ctx, c_ctx, norm1_g, norm2_g, ada_w, ada_b, w_in, conv_w, rpb,
              rw_shift, rw_w0, rw_w_up, rw_a0, rw_a_up, rw_g_up, rw_k_k, rw_k_a, rw_r_k,
              rw_gn_g, rw_gn_b, w_out, router_w, router_bias, exp_gate, exp_up, exp_down,
              sh_gate, sh_up, sh_down, final_g):
    B, L, D = x.shape
    Lc = ctx.shape[1]
    rope = axial_rope_tables(L)
    cond_lat = jax.nn.silu(c)
    cond_ctx = jax.nn.silu(c_ctx)[None]
    x_lat, x_ctx = x, ctx

    for l in range(DEPTH):
        last = l == DEPTH - 1
        mod_lat = (cond_lat @ ada_w[l] + ada_b[l]).reshape(B, 1, N_MOD, D)
        mod_ctx = (cond_ctx @ ada_w[l] + ada_b[l]).reshape(1, 1, N_MOD, D)

        h_ctx = modulate(rms_norm(x_ctx, norm1_g[l]), mod_ctx[:, :, 0], mod_ctx[:, :, 1])
        h_lat = modulate(rms_norm(x_lat, norm1_g[l]), mod_lat[:, :, 0], mod_lat[:, :, 1])
        z = jnp.concatenate([h_ctx, h_lat], axis=1) @ w_in[l]
        z_ctx, z_lat = z[:, :Lc], z[:, Lc:]
        za_c, zb_c, zc_c = jnp.split(z_ctx, [A_COLS, A_COLS + B_COLS], axis=-1)
        za_l, zb_l, zc_l = jnp.split(z_lat, [A_COLS, A_COLS + B_COLS], axis=-1)

        a_c = short_conv_mixer(za_c, conv_w[l])
        a_l = short_conv_mixer(za_l, conv_w[l])
        b_c, b_l = neighbourhood_attention(zb_c, zb_l, rpb[l], rope)
        c_c, c_l = rwkv7_time_mix(zc_c, zc_l, rw_shift[l], rw_w0[l], rw_w_up[l], rw_a0[l], rw_a_up[l],
                                  rw_g_up[l], rw_k_k[l], rw_k_a[l], rw_r_k[l], rw_gn_g[l], rw_gn_b[l])

        y_lat = jnp.concatenate([a_l, b_l, c_l], axis=-1) @ w_out[l]
        x_lat = x_lat + mod_lat[:, :, 2] * y_lat
        if not last:
            y_ctx = jnp.concatenate([a_c, b_c, c_c], axis=-1) @ w_out[l]
            x_ctx = x_ctx + mod_ctx[:, :, 2] * y_ctx

        f_lat_in = modulate(rms_norm(x_lat, norm2_g[l]), mod_lat[:, :, 3], mod_lat[:, :, 4])
        if last:
            f = moe_ffn(f_lat_in.reshape(-1, D), router_w[l], router_bias[l], exp_gate[l], exp_up[l],
                        exp_down[l], sh_gate[l], sh_up[l], sh_down[l]).reshape(B, L, D)
            x_lat = x_lat + mod_lat[:, :, 5] * f
        else:
            f_ctx_in = modulate(rms_norm(x_ctx, norm2_g[l]), mod_ctx[:, :, 3], mod_ctx[:, :, 4])
            tokens = jnp.concatenate([f_ctx_in, f_lat_in], axis=1).reshape(-1, D)
            f = moe_ffn(tokens, router_w[l], router_bias[l], exp_gate[l], exp_up[l], exp_down[l],
                        sh_gate[l], sh_up[l], sh_down[l]).reshape(B, Lc + L, D)
            x_ctx = x_ctx + mod_ctx[:, :, 5] * f[:, :Lc]
            x_lat = x_lat + mod_lat[:, :, 5] * f[:, Lc:]

    return rms_norm(x_lat, final_g)
```

```cpp
#include <hip/hip_runtime.h>
#include <stdint.h>

typedef unsigned short bf16_t;

constexpr int D = 2048, NB = 4, L = 4096, LC = 256, TT = L + LC, M = NB * TT;
constexpr int IN_COLS = 6432, ZLD = 6656;
constexpr int ZA = 0, ZB = 1536, ZC = 3840, RWC = 2592;
constexpr int NEXP = 64, TOPK = 6, DE = 512;
constexpr int NSTR = 10, SSTR = NSTR * 768;
constexpr int LCAP = M;
constexpr int UROWS = M * TOPK + NEXP * 256;
constexpr int NT = 512;

struct Params {
    const float *x, *c, *ctx, *c_ctx, *norm1_g, *norm2_g, *ada_w, *ada_b, *w_in, *conv_w, *rpb, *rw_shift, *rw_w0, *rw_w_up, *rw_a0, *rw_a_up, *rw_g_up,
        *rw_k_k, *rw_k_a, *rw_r_k, *rw_gn_g, *rw_gn_b, *w_out, *router_w, *router_bias, *exp_gate, *exp_up, *exp_down, *sh_gate, *sh_up, *sh_down, *final_g;
    float* out;
    unsigned* bar; float* mod; float* xcur; bf16_t* h; bf16_t* z; bf16_t* mix; float* streams; float* bonus; float* ydir;
    int* sel; float* selw; int* cnt; int* ltok; float* lw; bf16_t* U; bf16_t *WinT, *WoutT, *WguT, *WdnT; bf16_t *Qa, *Qr, *Ka, *Vt; bf16_t* Y; int* tpos; bf16_t *rw_P, *rw_Ry, *rw_H0, *rw_vb, *rw_gb; float *rw_QT, *rw_Y0; float* Wr; bf16_t *Lwa, *Lg;
};

__device__ __forceinline__ float bf2f(bf16_t b) { return __uint_as_float(((unsigned)b) << 16); }
__device__ __forceinline__ bf16_t f2bf(float f) { unsigned u = __float_as_uint(f); u += 0x7FFFu + ((u >> 16) & 1u); return (bf16_t)(u >> 16); }
__device__ __forceinline__ float sigmoidf_(float x) { return 1.0f / (1.0f + __expf(-x)); }
template <int CTRL, int RMASK> __device__ __forceinline__ float dpp_f(float old, float v) { return __int_as_float(__builtin_amdgcn_update_dpp(__float_as_int(old), __float_as_int(v), CTRL, RMASK, 0xF, false)); }
__device__ __forceinline__ float wave_sum(float v) {
    v += dpp_f<0xB1, 0xF>(0.f, v);
    v += dpp_f<0x4E, 0xF>(0.f, v);
    v += dpp_f<0x141, 0xF>(0.f, v);
    v += dpp_f<0x140, 0xF>(0.f, v);
    v += dpp_f<0x142, 0xA>(0.f, v);
    v += dpp_f<0x143, 0xC>(0.f, v);
    return __int_as_float(__builtin_amdgcn_readlane(__float_as_int(v), 63));
}
__device__ __forceinline__ float wave_max(float v) {
    v = fmaxf(v, dpp_f<0xB1, 0xF>(v, v));
    v = fmaxf(v, dpp_f<0x4E, 0xF>(v, v));
    v = fmaxf(v, dpp_f<0x141, 0xF>(v, v));
    v = fmaxf(v, dpp_f<0x140, 0xF>(v, v));
    v = fmaxf(v, dpp_f<0x142, 0xA>(v, v));
    v = fmaxf(v, dpp_f<0x143, 0xC>(v, v));
    return __int_as_float(__builtin_amdgcn_readlane(__float_as_int(v), 63));
}
__device__ __forceinline__ float bperm_f(int srclane, float v) { return __int_as_float(__builtin_amdgcn_ds_bpermute(srclane << 2, __float_as_int(v))); }
__device__ __forceinline__ int bperm_i(int srclane, int v) { return __builtin_amdgcn_ds_bpermute(srclane << 2, v); }
__device__ __forceinline__ int otid() { int t = threadIdx.x; asm volatile("" : "+v"(t)); return t; }
__device__ __forceinline__ void lds_barrier() { asm volatile("s_waitcnt lgkmcnt(0)" ::: "memory"); __builtin_amdgcn_s_barrier(); asm volatile("" ::: "memory"); }
__device__ __forceinline__ float bfl(unsigned u) { return __uint_as_float(u << 16); }
__device__ __forceinline__ float bfh(unsigned u) { return __uint_as_float(u & 0xffff0000u); }
__device__ __forceinline__ const float* in_row(const Params& p, int g) { const int b = g / TT, s = g - b * TT; return s < LC ? p.ctx + (size_t)(b * LC + s) * D : p.x + (size_t)(b * L + (s - LC)) * D; }
__device__ __forceinline__ int modrow(int g) { const int b = g / TT, s = g - b * TT; return s < LC ? 4 : b; }

#define XB_TMO      128
#define XB_XCNT(j)  (256  + 64 * (j))
#define XB_XSUB(j)  (1280 + 64 * (j))
#define XB_XGEN(j)  (2304 + 64 * (j))
#define XB_TOP      3328
#define XB_TOPGEN   3392
#define XCD_BAR_WORDS 3456
#define XB_SPIN_CAP (1u << 22)
#define LAS __attribute__((address_space(3)))

__device__ __forceinline__ unsigned xb_ld(unsigned* p)              { return __hip_atomic_load(p, __ATOMIC_RELAXED, __HIP_MEMORY_SCOPE_AGENT); }
__device__ __forceinline__ unsigned xb_add(unsigned* p, unsigned v) { return __hip_atomic_fetch_add(p, v, __ATOMIC_RELAXED, __HIP_MEMORY_SCOPE_AGENT); }
__device__ __forceinline__ unsigned xb_xcc_id() { return (unsigned)__builtin_amdgcn_s_getreg((3 << 11) | 20) & 0xFu; }
#define XB_SPIN(cond, bar) do { unsigned _sp = 0; while (cond) { __builtin_amdgcn_s_sleep(1); \
    if ((++_sp & 255u) == 0u) { if (xb_ld(&(bar)[XB_TMO])) break; if (_sp > XB_SPIN_CAP) { atomicAdd(&(bar)[XB_TMO], 1u); break; } } } } while (0)

struct XcdBarrier {
    unsigned* bar; unsigned x;
    volatile LAS unsigned* st;
};

__device__ __forceinline__ XcdBarrier xcd_barrier_post(unsigned* bar, volatile LAS unsigned* st) {
    XcdBarrier b; b.bar = bar; b.x = xb_xcc_id(); b.st = st;
    if (threadIdx.x == 0) (void)xb_add(&bar[XB_XCNT(b.x)], 1u);
    return b;
}
__device__ __forceinline__ void xcd_barrier_complete(unsigned* bar, unsigned x, unsigned& nloc, unsigned& nx) {
    const unsigned G = gridDim.x * gridDim.y * gridDim.z;
    unsigned sum, cnt, mine, sp = 0u;
    for (;;) {
        sum = 0u; cnt = 0u; mine = 0u;
#pragma unroll
        for (unsigned j = 0; j < 16; ++j) { const unsigned c = xb_ld(&bar[XB_XCNT(j)]); sum += c; cnt += (c > 0u) ? 1u : 0u; mine = (j == x) ? c : mine; }
        if (sum == G) break;
        __builtin_amdgcn_s_sleep(1);
        if ((++sp & 255u) == 0u) { if (xb_ld(&bar[XB_TMO])) break; if (sp > XB_SPIN_CAP) { atomicAdd(&bar[XB_TMO], 1u); break; } }
    }
    nloc = mine > 0u ? mine : 1u; nx = cnt > 0u ? cnt : 1u;
}

__device__ __forceinline__ void xcd_barrier(const XcdBarrier& b) {
    asm volatile("s_waitcnt vmcnt(0)" ::: "memory");
    __syncthreads();
    if (threadIdx.x == 0) {
        unsigned* bar = b.bar; const unsigned bx = xb_xcc_id();
        __builtin_amdgcn_s_waitcnt(0);
        unsigned nloc = b.st[0], nx = b.st[1];
        if (nloc == 0u) { xcd_barrier_complete(bar, bx, nloc, nx); b.st[0] = nloc; b.st[1] = nx; }
        const unsigned old = xb_add(&bar[XB_XSUB(bx)], 1u);
        const unsigned gen = old / nloc;
        if (old + 1u == (gen + 1u) * nloc) {
            __builtin_amdgcn_fence(__ATOMIC_RELEASE, "agent");
            asm volatile("s_waitcnt vmcnt(0)" ::: "memory");
            const unsigned og = xb_add(&bar[XB_TOP], 1u);
            const unsigned tg = og / nx;
            if (og + 1u == (tg + 1u) * nx) xb_add(&bar[XB_TOPGEN], 1u);
            else XB_SPIN(xb_ld(&bar[XB_TOPGEN]) == tg, bar);
            __builtin_amdgcn_fence(__ATOMIC_ACQUIRE, "agent");
            xb_add(&bar[XB_XGEN(bx)], 1u);
            asm volatile("s_waitcnt vmcnt(0)" ::: "memory");
        } else {
            XB_SPIN(xb_ld(&bar[XB_XGEN(bx)]) == gen, bar);
            __builtin_amdgcn_fence(__ATOMIC_ACQUIRE, "agent");
            asm volatile("s_waitcnt vmcnt(0)" ::: "memory");
        }
    }
    __syncthreads();
}


__device__ __forceinline__ void phase_copy(const Params& p, int bid, int nb) {
    const int tix = otid();
    if (bid == 0) for (int i = tix; i < D; i += NT) p.h[(size_t)M * D + i] = 0;
}

__device__ __forceinline__ void phase_router_w(const Params& p, int bid, int nb) {
    const int tix = otid();
    for (int i = bid * NT + tix; i < 2 * D * NEXP; i += nb * NT) {
        const int c = i & 3, n = (i >> 2) & 15, q = (i >> 6) & 3, nt = (i >> 8) & 3, j = (i >> 10) & 127, l = i >> 17;
        p.Wr[i] = p.router_w[((size_t)l * D + 16 * j + 4 * q + c) * NEXP + 16 * nt + n];
    }
}
__device__ __forceinline__ void phase_lora_w(const Params& p, int bid, int nb) {
    const int tix = otid();
    for (int i = bid * NT + tix; i < 2 * 2 * 12 * 2 * 64 * 72; i += nb * NT) {
        const int r = i % 72, c = (i / 72) & 63, which = (i / (72 * 64)) & 1, hh = (i / (72 * 64 * 2)) % 12, n = (i / (72 * 64 * 2 * 12)) & 1, l = i / (72 * 64 * 2 * 12 * 2);
        const float* src = (which == 0 ? p.rw_w_up : p.rw_a_up) + ((size_t)(l * 2 + n) * 48) * 768 + hh * 64 + c;
        p.Lwa[i] = r < 48 ? f2bf(src[(size_t)r * 768]) : (bf16_t)0;
    }
    for (int i = bid * NT + tix; i < 2 * 12 * 64 * 104; i += nb * NT) {
        const int r = i % 104, c = (i / 104) & 63, hh = (i / (104 * 64)) % 12, l = i / (104 * 64 * 12);
        p.Lg[i] = r < 96 ? f2bf(p.rw_g_up[((size_t)l * 96 + r) * 768 + hh * 64 + c]) : (bf16_t)0;
    }
}
__device__ __forceinline__ void phase_adaln(const Params& p, float* lds, int bid, int nb) {
    const int tix = otid();
    float* cond = lds;
    float* red = lds + 5 * D;
    for (int i = tix; i < 5 * D; i += NT) { const int r = i / D, d = i % D; const float v = r < 4 ? p.c[r * D + d] : p.c_ctx[d]; cond[i] = v * sigmoidf_(v); }
    __syncthreads();
    const int tid = tix, cg = tid & 15, ks = tid >> 4, wid = tid >> 6, lane = tid & 63;
    const int nitems = 2 * (6 * D / 64);
    for (int it = bid; it < nitems; it += nb) {
        const int l = it / (6 * D / 64), c0 = (it % (6 * D / 64)) * 64 + cg * 4;
        const float* W = p.ada_w + (size_t)l * D * 6 * D + c0;
        float4 acc[5];
#pragma unroll
        for (int r = 0; r < 5; ++r) acc[r] = make_float4(0.f, 0.f, 0.f, 0.f);
#pragma unroll 8
        for (int k = ks; k < D; k += 32) {
            const float4 w = *(const float4*)(W + (size_t)k * 6 * D);
#pragma unroll
            for (int r = 0; r < 5; ++r) { const float cv = cond[r * D + k]; acc[r].x += cv * w.x; acc[r].y += cv * w.y; acc[r].z += cv * w.z; acc[r].w += cv * w.w; }
        }
#pragma unroll
        for (int r = 0; r < 5; ++r) {
            acc[r].x += bperm_f(lane ^ 16, acc[r].x); acc[r].x += bperm_f(lane ^ 32, acc[r].x);
            acc[r].y += bperm_f(lane ^ 16, acc[r].y); acc[r].y += bperm_f(lane ^ 32, acc[r].y);
            acc[r].z += bperm_f(lane ^ 16, acc[r].z); acc[r].z += bperm_f(lane ^ 32, acc[r].z);
            acc[r].w += bperm_f(lane ^ 16, acc[r].w); acc[r].w += bperm_f(lane ^ 32, acc[r].w);
        }
        __syncthreads();
        if (lane < 16) {
#pragma unroll
            for (int r = 0; r < 5; ++r) { float* q = red + ((wid * 16 + lane) * 20 + r * 4); q[0] = acc[r].x; q[1] = acc[r].y; q[2] = acc[r].z; q[3] = acc[r].w; }
        }
        __syncthreads();
        if (tid < 16 * 20) {
            const int cgi = tid / 20, rj = tid % 20, r = rj / 4, j = rj % 4;
            float s = 0.f;
#pragma unroll
            for (int w = 0; w < 8; ++w) s += red[(w * 16 + cgi) * 20 + rj];
            const int col = (it % (6 * D / 64)) * 64 + cgi * 4 + j;
            p.mod[(size_t)(l * 5 + r) * 6 * D + col] = s + p.ada_b[(size_t)l * 6 * D + col];
        }
    }
}

__device__ __forceinline__ void moe_tables(const Params& p, LAS int* tab, int lc);

__device__ __forceinline__ void moe_combine_row(const Params& p, const LAS int* tab, int lm  , int g, int lane, float4 (&v)[8]) {
    int slot[TOPK + 1]; float w[TOPK + 1];
#pragma unroll
    for (int k = 0; k < TOPK; ++k) { const int e = p.sel[g * TOPK + k]; slot[k] = tab[66 + e] + p.tpos[g * TOPK + k]; w[k] = p.selw[g * TOPK + k]; }
    slot[TOPK] = tab[66 + NEXP] + g; w[TOPK] = 1.0f;
    const float* gt = p.mod + (size_t)(lm * 5 + modrow(g)) * 6 * D + 5 * D;
#pragma unroll
    for (int i = 0; i < 8; ++i) {
        const int d = (i * 64 + lane) * 4; float a0 = 0.f, a1 = 0.f, a2 = 0.f, a3 = 0.f;
#pragma unroll
        for (int k = 0; k <= TOPK; ++k) { const uint2 y = *(const uint2*)(p.Y + (size_t)slot[k] * D + d);
            a0 += w[k] * __uint_as_float(y.x << 16); a1 += w[k] * __uint_as_float(y.x & 0xffff0000u); a2 += w[k] * __uint_as_float(y.y << 16); a3 += w[k] * __uint_as_float(y.y & 0xffff0000u); }
        const float4 g4 = *(const float4*)(gt + d);
        v[i].x += g4.x * a0; v[i].y += g4.y * a1; v[i].z += g4.z * a2; v[i].w += g4.w * a3;
    }
}

template <int WHICH>
__device__ __forceinline__ void phase_norm(const Params& p, float* lds, LAS int* tab, int l, int bid, int nb) {
    const bool comb = (WHICH == 0 && l > 0);
    if (comb) moe_tables(p, tab, l - 1);
    const int tix = otid();
    const int wid = tix >> 6, lane = tix & 63;
    const float* gam = (WHICH == 0 ? p.norm1_g : p.norm2_g) + (size_t)l * D;
    float* frow = lds + wid * D;
    for (int g = bid * 8 + wid; g < M; g += nb * 8) {
        const float* xr = (WHICH == 0 && l == 0) ? in_row(p, g) : p.xcur + (size_t)g * D;
        float4 v[8]; float ss = 0.f;
#pragma unroll
        for (int i = 0; i < 8; ++i) v[i] = *(const float4*)(xr + (i * 64 + lane) * 4);
        if (comb) { moe_combine_row(p, tab, l - 1, g, lane, v);
#pragma unroll
            for (int i = 0; i < 8; ++i) *(float4*)(p.xcur + (size_t)g * D + (i * 64 + lane) * 4) = v[i]; }
#pragma unroll
        for (int i = 0; i < 8; ++i) ss += v[i].x * v[i].x + v[i].y * v[i].y + v[i].z * v[i].z + v[i].w * v[i].w;
        ss = wave_sum(ss);
        const float rs = rsqrtf(ss * (1.0f / D) + 1e-6f);
        const float* mrow = p.mod + (size_t)(l * 5 + modrow(g)) * 6 * D;
        const float* sh = mrow + (WHICH == 0 ? 0 : 3) * D; const float* sc = mrow + (WHICH == 0 ? 1 : 4) * D;
#pragma unroll
        for (int i = 0; i < 8; ++i) {
            const int d = (i * 64 + lane) * 4;
            const float4 gg = *(const float4*)(gam + d), s4 = *(const float4*)(sh + d), c4 = *(const float4*)(sc + d);
            float4 o;
            o.x = v[i].x * rs * gg.x * (1.0f + c4.x) + s4.x; o.y = v[i].y * rs * gg.y * (1.0f + c4.y) + s4.y;
            o.z = v[i].z * rs * gg.z * (1.0f + c4.z) + s4.z; o.w = v[i].w * rs * gg.w * (1.0f + c4.w) + s4.w;
            uint2 pk; pk.x = (unsigned)f2bf(o.x) | ((unsigned)f2bf(o.y) << 16); pk.y = (unsigned)f2bf(o.z) | ((unsigned)f2bf(o.w) << 16);
            *(uint2*)(p.h + (size_t)g * D + d) = pk;
            if (WHICH == 1) *(float4*)(frow + d) = o;
        }
        if (WHICH == 1) {
            const float* rw = p.router_w + (size_t)l * D * NEXP + lane;
            float a0 = 0.f, a1 = 0.f, a2 = 0.f, a3 = 0.f;
            for (int k = 0; k < D; k += 4) {
                const float4 f = *(const float4*)(frow + k);
                a0 += f.x * rw[(size_t)(k + 0) * NEXP]; a1 += f.y * rw[(size_t)(k + 1) * NEXP]; a2 += f.z * rw[(size_t)(k + 2) * NEXP]; a3 += f.w * rw[(size_t)(k + 3) * NEXP];
            }
            const float score = 1.0f / (1.0f + expf(-((a0 + a1) + (a2 + a3))));
            float val = score + p.router_bias[l * NEXP + lane];
            int myidx[TOPK]; float mysc[TOPK]; float tot = 0.f;
#pragma unroll
            for (int k = 0; k < TOPK; ++k) {
                float bv = val; int bi = lane;
#pragma unroll
                for (int o = 32; o >= 1; o >>= 1) { const float ov = bperm_f(lane ^ o, bv); const int oi = bperm_i(lane ^ o, bi); if (ov > bv || (ov == bv && oi < bi)) { bv = ov; bi = oi; } }
                const float sc_k = bperm_f(bi, score);
                myidx[k] = bi; mysc[k] = sc_k; tot += sc_k;
                if (lane == bi) val = -INFINITY;
            }
            if (lane == 0) {
#pragma unroll
                for (int k = 0; k < TOPK; ++k) { p.sel[g * TOPK + k] = myidx[k]; p.selw[g * TOPK + k] = mysc[k] / tot * 2.5f; }
            }
        }
    }
}


namespace pg8 {
typedef short bf16x8 __attribute__((ext_vector_type(8)));
typedef float f32x4 __attribute__((ext_vector_type(4)));
typedef unsigned u32x4 __attribute__((ext_vector_type(4)));
constexpr int BM = 256, BK = 64, HALF = 128, HTB = HALF * BK * 2  , STAGE_BYTES = 8 * HTB, NXCD = 8, WGM = 8;
__device__ __forceinline__ int lds_byte(int r, int c) { const int st = (r >> 4) * 2 + (c >> 5), rr = r & 15, cc = c & 31, ob = rr * 64 + cc * 2; return st * 1024 + (ob ^ (((ob >> 9) & 1) << 5)); }
__device__ __forceinline__ void stage_rc(int b, int& R, int& C) { const int st = b / 1024, sb = b % 1024, swz = sb ^ (((sb >> 9) & 1) << 5); R = (st >> 1) * 16 + swz / 64; C = (st & 1) * 32 + (swz % 64) / 2; }
__device__ __forceinline__ int perm32(int rho) { const int n = rho >> 4, i = rho & 15; return 8 * (i >> 2) + 4 * n + (i & 3); }
typedef float cvt_f32x2 __attribute__((ext_vector_type(2)));
typedef __bf16 cvt_bf16x2 __attribute__((ext_vector_type(2)));
__device__ __forceinline__ unsigned cvt_pk_bf16(float lo, float hi) { const cvt_f32x2 v = {lo, hi}; const cvt_bf16x2 b = __builtin_convertvector(v, cvt_bf16x2); return __builtin_bit_cast(unsigned, b); }
struct Unit { int pm, pn, e, ord; };
template <bool PERM, class Sched, class Epi>
__device__ __forceinline__ void gemm_phase(LAS unsigned char* lds, const char* Abase, const int K, const Sched& S, const Epi& E) {
    const int tid = otid(), wid = __builtin_amdgcn_readfirstlane(tid >> 6), lane = tid & 63, wr = wid >> 2, wc = wid & 3, fr = lane & 15, fq = lane >> 4;
    const int nt = K / BK;
    unsigned voffB[2];
#pragma unroll
    for (int i = 0; i < 2; ++i) { int R, C; stage_rc(tid * 16 + i * 8192, R, C); const int Rb = PERM ? ((R & ~31) + perm32(R & 31)) : R; voffB[i] = (unsigned)(Rb * K + C) * 2u; }
    const size_t kstep = (size_t)(BK * 2);
    const size_t hstep = (size_t)HALF * K * 2;
    const unsigned ldsw = (unsigned)wid * 1024u;
    const int aoff = lds_byte(wr * 64 + fr, fq * 8), boff = lds_byte(wc * 32 + fr, fq * 8);
#define PG8_SA(b, h) (((b) * 2 + (h)) * HTB)
#define PG8_SB(b, h) ((4 + (b) * 2 + (h)) * HTB)
#define PG8_STAGE(bufoff, gbase, voff) do { _Pragma("unroll") for (int _i = 0; _i < 2; ++_i) \
        __builtin_amdgcn_global_load_lds((const unsigned*)((const char*)(gbase) + (voff)[_i]), (LAS unsigned*)(lds + (bufoff) + ldsw + _i * 8192), 16, 0, 0); } while (0)
#define PG8_LDA(dst, b, h) do { _Pragma("unroll") for (int m = 0; m < 4; ++m) _Pragma("unroll") for (int k = 0; k < 2; ++k) dst[m][k] = *(const LAS bf16x8*)(lds + PG8_SA(b, h) + aoff + m * 2048 + k * 1024); } while (0)
#define PG8_LDB(dst, b, h) do { _Pragma("unroll") for (int n = 0; n < 2; ++n) _Pragma("unroll") for (int k = 0; k < 2; ++k) dst[n][k] = *(const LAS bf16x8*)(lds + PG8_SB(b, h) + boff + n * 2048 + k * 1024); } while (0)
#define PG8_MMA(ai, bj, At, Bt) do { __builtin_amdgcn_s_setprio(1); _Pragma("unroll") for (int m = 0; m < 4; ++m) _Pragma("unroll") for (int n = 0; n < 2; ++n) _Pragma("unroll") for (int k = 0; k < 2; ++k) \
        acc[ai][bj][m][n] = __builtin_amdgcn_mfma_f32_16x16x32_bf16(Bt[n][k], At[m][k], acc[ai][bj][m][n], 0, 0, 0); __builtin_amdgcn_s_setprio(0); } while (0)
#define PG8_WAIT_V(n) asm volatile("s_waitcnt vmcnt(" #n ")" ::: "memory")
#define PG8_WAIT_L(n) asm volatile("s_waitcnt lgkmcnt(" #n ")" ::: "memory")
#define PG8_BAR __builtin_amdgcn_s_barrier()
#define PG8_SCHED __builtin_amdgcn_sched_barrier(0)
#define PG8_ROWS(u, v) do { const int _t = otid(); _Pragma("unroll") for (int _i = 0; _i < 2; ++_i) { int _R, _C; stage_rc(_t * 16 + _i * 8192, _R, _C); \
        _Pragma("unroll") for (int _h = 0; _h < 2; ++_h) v[_h][_i] = S.arow(u, _h * HALF + _R) + (unsigned)(_C * 2); } } while (0)
    Unit cur, nxt; int ui = 0;
    if (!S.next(0, cur)) return;
    f32x4 acc[2][2][4][2];
#pragma unroll
    for (int a = 0; a < 2; ++a)
#pragma unroll
        for (int b = 0; b < 2; ++b)
#pragma unroll
            for (int m = 0; m < 4; ++m)
#pragma unroll
                for (int n = 0; n < 2; ++n) acc[a][b][m][n] = (f32x4){0.f, 0.f, 0.f, 0.f};
    bf16x8 At[4][2], B0[2][2], B1[2][2];
    unsigned va[2][2];
    PG8_ROWS(cur, va);
    const char* cB = S.bptr(cur);
    PG8_STAGE(PG8_SB(0, 0), cB, voffB); PG8_STAGE(PG8_SA(0, 0), Abase, va[0]); PG8_STAGE(PG8_SB(0, 1), cB + hstep, voffB); PG8_STAGE(PG8_SA(0, 1), Abase, va[1]);
    if (wr == 1) PG8_BAR;
    PG8_WAIT_V(4); PG8_BAR;
    PG8_STAGE(PG8_SB(1, 0), cB + kstep, voffB); PG8_STAGE(PG8_SA(1, 0), Abase + kstep, va[0]); PG8_STAGE(PG8_SB(1, 1), cB + hstep + kstep, voffB);
    PG8_WAIT_V(6); PG8_BAR;
    for (;;) {
        const bool has_next = S.next(ui + 1, nxt);
        const char* nB = has_next ? S.bptr(nxt) : cB;
        for (int t = 0; t < nt; t += 2) {
            const bool last = (t == nt - 2);
            const char* a1 = Abase + (size_t)(t + 1) * kstep;
            const char* a2 = last ? Abase : Abase + (size_t)(t + 2) * kstep; const char* b2 = last ? nB : cB + (size_t)(t + 2) * kstep;
            const char* a3 = a2 + kstep; const char* b3 = b2 + kstep;
            PG8_LDB(B0, 0, 0); PG8_SCHED; PG8_LDA(At, 0, 0); PG8_STAGE(PG8_SA(1, 1), a1, va[1]);
            PG8_WAIT_L(8); PG8_BAR; PG8_WAIT_L(0); PG8_MMA(0, 0, At, B0); PG8_BAR; PG8_SCHED;
            if (last && has_next) { PG8_ROWS(nxt, va); }
            PG8_LDB(B1, 0, 1); PG8_STAGE(PG8_SB(0, 0), b2, voffB);
            PG8_BAR; PG8_WAIT_L(0); PG8_MMA(0, 1, At, B1); PG8_BAR;
            PG8_LDA(At, 0, 1); PG8_STAGE(PG8_SA(0, 0), a2, va[0]);
            PG8_BAR; PG8_WAIT_L(0); PG8_MMA(1, 0, At, B0); PG8_BAR; PG8_SCHED;
            PG8_STAGE(PG8_SB(0, 1), b2 + hstep, voffB);
            PG8_WAIT_V(6); PG8_BAR; PG8_MMA(1, 1, At, B1); PG8_BAR;
            PG8_LDB(B0, 1, 0); PG8_SCHED; PG8_LDA(At, 1, 0); PG8_STAGE(PG8_SA(0, 1), a2, va[1]);
            PG8_WAIT_L(8); PG8_BAR; PG8_WAIT_L(0); PG8_MMA(0, 0, At, B0); PG8_BAR; PG8_SCHED;
            PG8_LDB(B1, 1, 1); PG8_STAGE(PG8_SB(1, 0), b3, voffB);
            PG8_BAR; PG8_WAIT_L(0); PG8_MMA(0, 1, At, B1); PG8_BAR;
            PG8_LDA(At, 1, 1); PG8_STAGE(PG8_SA(1, 0), a3, va[0]);
            PG8_BAR; PG8_WAIT_L(0); PG8_MMA(1, 0, At, B0); PG8_BAR; PG8_SCHED;
            PG8_STAGE(PG8_SB(1, 1), b3 + hstep, voffB);
            PG8_WAIT_V(6); PG8_BAR; PG8_MMA(1, 1, At, B1); PG8_BAR;
        }
        E(acc, cur, wr, wc, fr, fq);
        if (!has_next) break;
#pragma unroll
        for (int a = 0; a < 2; ++a)
#pragma unroll
            for (int b = 0; b < 2; ++b)
#pragma unroll
                for (int m = 0; m < 4; ++m)
#pragma unroll
                    for (int n = 0; n < 2; ++n) acc[a][b][m][n] = (f32x4){0.f, 0.f, 0.f, 0.f};
        cur = nxt; cB = nB; ++ui;
    }
    PG8_WAIT_V(0);
    if (wr == 0) PG8_BAR;
    PG8_BAR;
#undef PG8_SA
#undef PG8_SB
#undef PG8_STAGE
#undef PG8_LDA
#undef PG8_LDB
#undef PG8_MMA
#undef PG8_WAIT_V
#undef PG8_WAIT_L
#undef PG8_BAR
#undef PG8_SCHED
#undef PG8_ROWS
}
struct DenseSched {
    int nM, nN, nwg, G, c; const char* Bt; unsigned rowbytes; int skipctx;
    __device__ __forceinline__ bool next(int i, Unit& u) const {
        const long L = (long)i * G + c; if (L >= nwg) return false;
        int wgid = (int)L; { const int q = nwg / NXCD, r = nwg % NXCD, xcd = wgid % NXCD, off = wgid / NXCD; wgid = (xcd < r ? xcd * (q + 1) : r * (q + 1) + (xcd - r) * q) + off; }
        const int nig = WGM * nN, gid = wgid / nig, fm = gid * WGM, gsz = (nM - fm) < WGM ? (nM - fm) : WGM;
        u.pm = fm + ((wgid % nig) % gsz); u.pn = (wgid % nig) / gsz; u.e = 0; u.ord = i; if (skipctx) u.pm = (u.pm >> 4) * 17 + 1 + (u.pm & 15); return true;
    }
    __device__ __forceinline__ unsigned arow(const Unit& u, int r) const { return (unsigned)(u.pm * BM + r) * rowbytes; }
    __device__ __forceinline__ const char* bptr(const Unit& u) const { return Bt + (size_t)u.pn * BM * rowbytes; }
};
}

struct CvTile { const float* src; bf16_t* dst; int ldn, nvalid, k0, n0, K, split; };
constexpr int CV_IN = 32 * 26, CV_OUT = 32 * 8, CV_PER_E = 32 * 2 + 32 * 2 + 8 * 8, CV_TOTAL = CV_IN + CV_OUT + 65 * CV_PER_E;
__device__ __forceinline__ CvTile cv_desc(const Params& p, int l, int it) {
    const int r1 = it - CV_IN, r2 = r1 - CV_OUT;
    const bool is_in = it < CV_IN, is_out = !is_in && r1 < CV_OUT;
    const int e = r2 >= 0 ? r2 / CV_PER_E : 0, re = r2 >= 0 ? r2 % CV_PER_E : 0;
    const bool is_gu = !is_in && !is_out && re < 128, up = re >= 64, is_dn = !is_in && !is_out && !is_gu;
    const int rg = re & 63, rd = re - 128;
    const float* sgu = e < NEXP ? (up ? p.exp_up : p.exp_gate) + ((size_t)l * NEXP + e) * D * DE : (up ? p.sh_up : p.sh_gate) + (size_t)l * D * DE;
    const float* sdn = e < NEXP ? p.exp_down + ((size_t)l * NEXP + e) * DE * D : p.sh_down + (size_t)l * DE * D;
    CvTile t;
    t.src = is_in ? p.w_in + (size_t)l * D * IN_COLS : (is_out ? p.w_out + (size_t)l * D * D : (is_gu ? sgu : sdn));
    t.dst = is_in ? p.WinT : (is_out ? p.WoutT : (is_gu ? p.WguT + (size_t)e * 1024 * D : p.WdnT + (size_t)e * D * DE));
    t.ldn = is_in ? IN_COLS : (is_gu ? DE : D); t.nvalid = t.ldn;
    t.k0 = (is_in ? it / 26 : (is_out ? r1 / 8 : (is_gu ? rg / 2 : rd / 8))) * 64;
    t.n0 = (is_in ? it % 26 : (is_out ? r1 % 8 : (is_gu ? rg % 2 : rd % 8))) * 256;
    t.K = is_dn ? DE : D; t.split = is_gu ? (up ? 2 : 1) : 0;
    return t;
}
__device__ __forceinline__ void cv_load(const CvTile& t, int tid, pg8::f32x4 (&v)[8]) {
    const int kp = tid >> 6, c4 = (tid & 63) * 4;
#pragma unroll
    for (int j = 0; j < 8; ++j) v[j] = (t.n0 + c4 < t.nvalid) ? *(const pg8::f32x4*)(t.src + (size_t)(t.k0 + 8 * kp + j) * t.ldn + t.n0 + c4) : (pg8::f32x4){0.f, 0.f, 0.f, 0.f};
}
__device__ __forceinline__ void cv_store(const CvTile& t, int tid, bf16_t* T  , const pg8::f32x4 (&v)[8]) {
    const int kp = tid >> 6, c4 = (tid & 63) * 4;
    uint4 o;
    o.x = pg8::cvt_pk_bf16(v[0][0], v[1][0]); o.y = pg8::cvt_pk_bf16(v[2][0], v[3][0]); o.z = pg8::cvt_pk_bf16(v[4][0], v[5][0]); o.w = pg8::cvt_pk_bf16(v[6][0], v[7][0]); *(uint4*)(T + (c4 + 0) * 72 + 8 * kp) = o;
    o.x = pg8::cvt_pk_bf16(v[0][1], v[1][1]); o.y = pg8::cvt_pk_bf16(v[2][1], v[3][1]); o.z = pg8::cvt_pk_bf16(v[4][1], v[5][1]); o.w = pg8::cvt_pk_bf16(v[6][1], v[7][1]); *(uint4*)(T + (c4 + 1) * 72 + 8 * kp) = o;
    o.x = pg8::cvt_pk_bf16(v[0][2], v[1][2]); o.y = pg8::cvt_pk_bf16(v[2][2], v[3][2]); o.z = pg8::cvt_pk_bf16(v[4][2], v[5][2]); o.w = pg8::cvt_pk_bf16(v[6][2], v[7][2]); *(uint4*)(T + (c4 + 2) * 72 + 8 * kp) = o;
    o.x = pg8::cvt_pk_bf16(v[0][3], v[1][3]); o.y = pg8::cvt_pk_bf16(v[2][3], v[3][3]); o.z = pg8::cvt_pk_bf16(v[4][3], v[5][3]); o.w = pg8::cvt_pk_bf16(v[6][3], v[7][3]); *(uint4*)(T + (c4 + 3) * 72 + 8 * kp) = o;
    lds_barrier();
#pragma unroll
    for (int j = 0; j < 4; ++j) {
        const int q = tid + 512 * j, nl = q >> 3, kc = q & 7, n = t.n0 + nl;
        const size_t drow = t.split == 0 ? (size_t)n : (size_t)((n >> 7) * 256 + (t.split == 2 ? 128 : 0) + (n & 127));
        *(uint4*)(t.dst + drow * t.K + t.k0 + kc * 8) = *(const uint4*)(T + nl * 72 + kc * 8);
    }
}
__device__ __forceinline__ void phase_convert(const Params& p, float* lds, int l, int bid, int nb) {
    const int tid = otid();
    bf16_t* T0 = (bf16_t*)lds; bf16_t* T1 = T0 + 256 * 72;
    pg8::f32x4 va[8], vb[8];
    __syncthreads();
    int it = bid;
    if (it < CV_TOTAL) cv_load(cv_desc(p, l, it), tid, va);
    for (; it < CV_TOTAL; it += 2 * nb) {
        const bool has1 = it + nb < CV_TOTAL, has2 = it + 2 * nb < CV_TOTAL;
        if (has1) cv_load(cv_desc(p, l, it + nb), tid, vb);
        cv_store(cv_desc(p, l, it), tid, T0, va);
        if (has2) cv_load(cv_desc(p, l, it + 2 * nb), tid, va);
        if (has1) cv_store(cv_desc(p, l, it + nb), tid, T1, vb);
    }
    __syncthreads();
}

struct EpiZ {
    bf16_t* z;
    __device__ __forceinline__ void operator()(const pg8::f32x4 (&acc)[2][2][4][2], const pg8::Unit& u, int wr, int wc, int fr, int fq) const {
        const int row0 = u.pm * 256 + wr * 64 + fr, col0 = u.pn * 256 + wc * 32 + 8 * fq;
#pragma unroll
        for (int ai = 0; ai < 2; ++ai)
#pragma unroll
            for (int m = 0; m < 4; ++m) { bf16_t* rowp = z + (size_t)(row0 + ai * 128 + m * 16) * ZLD + col0;
#pragma unroll
                for (int bj = 0; bj < 2; ++bj) { const pg8::f32x4 v0 = acc[ai][bj][m][0], v1 = acc[ai][bj][m][1];
                    pg8::u32x4 w; w.x = pg8::cvt_pk_bf16(v0[0], v0[1]); w.y = pg8::cvt_pk_bf16(v0[2], v0[3]); w.z = pg8::cvt_pk_bf16(v1[0], v1[1]); w.w = pg8::cvt_pk_bf16(v1[2], v1[3]);
                    *(pg8::u32x4*)(rowp + bj * 128) = w; } }
    }
};
struct EpiOut {
    float* xcur; const float* mod; int l; const float* xin; const float* cin;
    __device__ __forceinline__ void operator()(const pg8::f32x4 (&acc)[2][2][4][2], const pg8::Unit& u, int wr, int wc, int fr, int fq) const {
        const int row0 = u.pm * 256 + wr * 64 + fr, col0 = u.pn * 256 + wc * 32 + 4 * fq;
#pragma unroll
        for (int ai = 0; ai < 2; ++ai)
#pragma unroll
            for (int m = 0; m < 4; ++m) { const int g = row0 + ai * 128 + m * 16; float* xr = xcur + (size_t)g * D + col0; const float* gt = mod + (size_t)(l * 5 + modrow(g)) * 6 * D + 2 * D + col0;
                const int gb = g / TT, gs = g - gb * TT; const float* xs = l != 0 ? xr : (gs < LC ? cin + (size_t)(gb * LC + gs) * D : xin + (size_t)(gb * L + (gs - LC)) * D) + col0;
#pragma unroll
                for (int bj = 0; bj < 2; ++bj)
#pragma unroll
                    for (int n = 0; n < 2; ++n) { const int co = bj * 128 + n * 16; pg8::f32x4 x4 = *(const pg8::f32x4*)(xs + co); const pg8::f32x4 g4 = *(const pg8::f32x4*)(gt + co); x4 += g4 * acc[ai][bj][m][n]; *(pg8::f32x4*)(xr + co) = x4; } }
    }
};
__device__ __forceinline__ void phase_gemm_in(const Params& p, LAS unsigned char* stage, int bid, int nb) {
    pg8::DenseSched S; S.nM = M / 256; S.nN = ZLD / 256; S.nwg = S.nM * S.nN; S.G = nb; S.c = bid; S.Bt = (const char*)p.WinT; S.rowbytes = D * 2; S.skipctx = 0;
    EpiZ E; E.z = p.z;
    pg8::gemm_phase<true>(stage, (const char*)p.h, D, S, E);
}
__device__ __forceinline__ void phase_gemm_out(const Params& p, LAS unsigned char* stage, int l, int bid, int nb) {
    pg8::DenseSched S; S.skipctx = (l == 1); S.nM = S.skipctx ? NB * L / 256 : M / 256; S.nN = D / 256; S.nwg = S.nM * S.nN; S.G = nb; S.c = bid; S.Bt = (const char*)p.WoutT; S.rowbytes = D * 2;
    EpiOut E; E.xcur = p.xcur; E.mod = p.mod; E.l = l; E.xin = p.x; E.cin = p.ctx;
    pg8::gemm_phase<false>(stage, (const char*)p.mix, D, S, E);
}
__device__ __forceinline__ void phase_prep(const Params& p, float* lds, int l, int bid, int nb) {
    const int tix = otid();
    const int tid = tix;
    {
        float* cst = lds;
        __syncthreads();
        for (int i = tid; i < 1024; i += NT) { const int pos = i >> 4, f = i & 15; float sn, cs; sincosf((float)pos * expf(-(float)f * (9.210340371976184f / 16.0f)), &sn, &cs); cst[i] = cs; cst[1024 + i] = sn; }
        __syncthreads();
        const int lane = tid & 63, wid = tid >> 6;
        const int tl = lane >> 3, dv = lane & 7, axis = dv >> 2, half = (dv >> 1) & 1, f0 = 8 * (dv & 1);
        bf16_t* Tw = (bf16_t*)(lds + 2048) + wid * (64 * 72);
        for (int wt = bid * 8 + wid; wt < NB * 12 * (TT / 64); wt += nb * 8) {
            const int tile = wt % (TT / 64), bh = wt / (TT / 64), b = bh / 12, hh = bh % 12, s0 = tile * 64;
#pragma unroll 2
            for (int i = 0; i < 8; ++i) {
                const int s = s0 + 8 * i + tl; const bf16_t* zr = p.z + (size_t)(b * TT + s) * ZLD + ZB + hh * 64 + 8 * dv;
                const uint4 q8 = *(const uint4*)zr, k8 = *(const uint4*)(zr + 768), v8 = *(const uint4*)(zr + 1536);
                *(uint4*)(p.Qa + ((size_t)bh * TT + s) * 64 + 8 * dv) = q8;
                const unsigned vw[4] = {v8.x, v8.y, v8.z, v8.w};
#pragma unroll
                for (int e = 0; e < 4; ++e) { Tw[(8 * dv + 2 * e) * 72 + 8 * i + tl] = (bf16_t)(vw[e] & 0xffffu); Tw[(8 * dv + 2 * e + 1) * 72 + 8 * i + tl] = (bf16_t)(vw[e] >> 16); }
                uint4 ko = k8;
                if (s >= LC) {
                    const int t = s - LC, pos = axis == 0 ? (t >> 6) : (t & 63);
                    const unsigned qw[4] = {q8.x, q8.y, q8.z, q8.w}, kw[4] = {k8.x, k8.y, k8.z, k8.w};
                    unsigned qo[4], kq[4];
#pragma unroll
                    for (int e = 0; e < 4; ++e) {
                        const unsigned qpw = (unsigned)bperm_i(lane ^ 2, (int)qw[e]), kpw = (unsigned)bperm_i(lane ^ 2, (int)kw[e]);
                        const float c0 = cst[pos * 16 + f0 + 2 * e], s0f = cst[1024 + pos * 16 + f0 + 2 * e], c1 = cst[pos * 16 + f0 + 2 * e + 1], s1f = cst[1024 + pos * 16 + f0 + 2 * e + 1];
                        const float qa0 = bfl(qw[e]), qa1 = bfh(qw[e]), qb0 = bfl(qpw), qb1 = bfh(qpw), ka0 = bfl(kw[e]), ka1 = bfh(kw[e]), kb0 = bfl(kpw), kb1 = bfh(kpw);
                        const float sg = half == 0 ? -1.f : 1.f;
                        qo[e] = pg8::cvt_pk_bf16(qa0 * c0 + sg * qb0 * s0f, qa1 * c1 + sg * qb1 * s1f);
                        kq[e] = pg8::cvt_pk_bf16(ka0 * c0 + sg * kb0 * s0f, ka1 * c1 + sg * kb1 * s1f);
                    }
                    *(uint4*)(p.Qr + ((size_t)bh * L + t) * 64 + 8 * dv) = make_uint4(qo[0], qo[1], qo[2], qo[3]);
                    ko = make_uint4(kq[0], kq[1], kq[2], kq[3]);
                }
                *(uint4*)(p.Ka + ((((size_t)bh * (TT / 16) + (s >> 4)) * 2 + (dv >> 2)) * 16 + (s & 15)) * 32 + 8 * (dv & 3)) = ko;
            }
            __builtin_amdgcn_wave_barrier();
#pragma unroll 2
            for (int i = 0; i < 8; ++i) {
                const int item = i * 64 + lane, q4 = item & 3, d = (item >> 2) & 63, blk = item >> 8;
                const uint2 lo = *(const uint2*)(Tw + d * 72 + blk * 32 + 4 * q4), hi = *(const uint2*)(Tw + d * 72 + blk * 32 + 16 + 4 * q4);
                *(uint4*)(p.Vt + (((size_t)bh * (TT / 32) + tile * 2 + blk) * 64 + d) * 32 + 8 * q4) = make_uint4(lo.x, lo.y, hi.x, hi.y); }
            __builtin_amdgcn_wave_barrier();
        }
        __syncthreads();
    }
    const float* cw = p.conv_w + (size_t)l * 3 * 512;
    for (int i = bid * NT + tid; i < M * 64; i += nb * NT) {
        const int ch = (i & 63) * 8, g = i >> 6, s = g % TT;
        const bf16_t* zr = p.z + (size_t)g * ZLD + ch;
        const uint4 bg = *(const uint4*)zr, cg = *(const uint4*)(zr + 512), hv = *(const uint4*)(zr + 1024);
        uint4 cgp = make_uint4(0u, 0u, 0u, 0u), hp = cgp, cgn = cgp, hn = cgp;
        if (s != 0 && s != LC) { cgp = *(const uint4*)(zr + 512 - ZLD); hp = *(const uint4*)(zr + 1024 - ZLD); }
        if (s != LC - 1 && s != TT - 1) { cgn = *(const uint4*)(zr + 512 + ZLD); hn = *(const uint4*)(zr + 1024 + ZLD); }
        const float4 w0a = *(const float4*)(cw + ch), w0b = *(const float4*)(cw + ch + 4), w1a = *(const float4*)(cw + 512 + ch), w1b = *(const float4*)(cw + 512 + ch + 4), w2a = *(const float4*)(cw + 1024 + ch), w2b = *(const float4*)(cw + 1024 + ch + 4);
        const float w0[8] = {w0a.x, w0a.y, w0a.z, w0a.w, w0b.x, w0b.y, w0b.z, w0b.w}, w1[8] = {w1a.x, w1a.y, w1a.z, w1a.w, w1b.x, w1b.y, w1b.z, w1b.w}, w2[8] = {w2a.x, w2a.y, w2a.z, w2a.w, w2b.x, w2b.y, w2b.z, w2b.w};
        const unsigned bgw[4] = {bg.x, bg.y, bg.z, bg.w}, cgw[4] = {cg.x, cg.y, cg.z, cg.w}, hw[4] = {hv.x, hv.y, hv.z, hv.w}, cpw[4] = {cgp.x, cgp.y, cgp.z, cgp.w}, hpw[4] = {hp.x, hp.y, hp.z, hp.w}, cnw[4] = {cgn.x, cgn.y, cgn.z, cgn.w}, hnw[4] = {hn.x, hn.y, hn.z, hn.w};
        unsigned o[4];
#pragma unroll
        for (int e = 0; e < 4; ++e) {
            const float r0 = bfl(bgw[e]) * (w0[2 * e] * bfl(cpw[e]) * bfl(hpw[e]) + w1[2 * e] * bfl(cgw[e]) * bfl(hw[e]) + w2[2 * e] * bfl(cnw[e]) * bfl(hnw[e]));
            const float r1 = bfh(bgw[e]) * (w0[2 * e + 1] * bfh(cpw[e]) * bfh(hpw[e]) + w1[2 * e + 1] * bfh(cgw[e]) * bfh(hw[e]) + w2[2 * e + 1] * bfh(cnw[e]) * bfh(hnw[e]));
            o[e] = pg8::cvt_pk_bf16(r0, r1);
        }
        *(uint4*)(p.mix + (size_t)g * D + ch) = make_uint4(o[0], o[1], o[2], o[3]);
    }
}

typedef short rw_bf16x8 __attribute__((ext_vector_type(8)));
typedef float rw_f32x4 __attribute__((ext_vector_type(4)));
constexpr int RLD = 72, FLD = 68, GLD = 104;
constexpr int RW_UNITS = NB * 12 * (TT / 64) * 2;
template <int K> __device__ __forceinline__ void mm_t(rw_f32x4 (&acc)[2], const bf16_t* A, int lda, const bf16_t* Bt, int ldb, int rb, int ch, int fr, int q) {
#pragma unroll
    for (int ks = 0; ks < K / 32; ++ks) {
        const rw_bf16x8 a = *(const rw_bf16x8*)(A + (16 * rb + fr) * lda + 32 * ks + 8 * q);
#pragma unroll
        for (int nt = 0; nt < 2; ++nt) { const rw_bf16x8 b = *(const rw_bf16x8*)(Bt + (32 * ch + 16 * nt + fr) * ldb + 32 * ks + 8 * q); acc[nt] = __builtin_amdgcn_mfma_f32_16x16x32_bf16(b, a, acc[nt], 0, 0, 0); }
    }
}
__device__ __forceinline__ bool rw_map(int tid, int n, int hh, int& kind, int& c8, int& col, int& rg) {
    const int w = __builtin_amdgcn_readfirstlane(tid >> 6), ln = tid & 63; rg = ln & 7; const int cvl = ln >> 3;
    if (w < 3) { kind = w; c8 = cvl * 8; col = w * 768 + hh * 64 + c8; return true; }
    if (w < 5) { kind = w; c8 = cvl * 8; col = (w == 3 ? 2400 : 2496) + n * 48 + c8; return cvl < 6; }
    if (w < 7) { kind = 5; const int cg = (w - 5) * 8 + cvl; c8 = cg * 8; col = 2304 + c8; return n == 0 && cg < 12; }
    kind = 6; c8 = 0; col = 0; return false;
}
struct RwPre { uint4 raw[10]; float4 m0a, m0b, m1a, m1b; };
__device__ __forceinline__ void rwkv_prefetch(const Params& p, int l, int unit, int tid, RwPre& P) {
    const int n = unit & 1, ci = (unit >> 1) % (TT / 64), bh = (unit >> 1) / (TT / 64), b = bh / 12, hh = bh % 12;
    const int segb = ci < 4 ? 0 : LC, sege = ci < 4 ? LC : TT, s0 = ci * 64;
    int kind, c8, col, rg; const bool act = rw_map(tid, n, hh, kind, c8, col, rg);
#pragma unroll
    for (int i = 0; i < 10; ++i) P.raw[i] = make_uint4(0u, 0u, 0u, 0u);
    if (unit < RW_UNITS && act) {
        const int j0 = 8 * rg;
        const int ta = n == 0 ? s0 + j0 : s0 + 63 - j0 - 7;
        const bf16_t* zp = p.z + (size_t)(b * TT + ta) * ZLD + ZC + col;
#pragma unroll
        for (int i = 0; i < 10; ++i) { const int tk = ta - 1 + i; if (tk >= segb && tk < sege) P.raw[i] = *(const uint4*)(zp + (ptrdiff_t)(i - 1) * ZLD); }
        const float* mu = p.rw_shift + (size_t)l * 2 * RWC;
        P.m0a = *(const float4*)(mu + col); P.m0b = *(const float4*)(mu + col + 4); P.m1a = *(const float4*)(mu + RWC + col); P.m1b = *(const float4*)(mu + RWC + col + 4);
    }
}
__device__ __forceinline__ void rwkv_unit(const Params& p, unsigned char* Lb, int l, int unit, int unit_next, RwPre& P) {
    const int tid = otid(), wid = tid >> 6, lane = tid & 63, rb = wid & 3, ch = wid >> 2, fr = lane & 15, q = lane >> 4;
    const int n = unit & 1, ci = (unit >> 1) % (TT / 64), bh = (unit >> 1) / (TT / 64), b = bh / 12, hh = bh % 12;
    const int segb = ci < 4 ? 0 : LC, sege = ci < 4 ? LC : TT, s0 = ci * 64;
    float* rf = (float*)Lb; float* kf = rf + 64 * FLD; float* red = kf + 64 * FLD;
    bf16_t* Aw = (bf16_t*)(Lb + 36864); bf16_t* Aa = Aw + 64 * RLD; bf16_t* Bw = Aa + 64 * RLD; bf16_t* Ba = Bw + 64 * RLD; bf16_t* Ag = Ba + 64 * RLD; bf16_t* Bg = Ag + 64 * GLD;
    bf16_t* Rt = (bf16_t*)(Lb + 36864); bf16_t* Kt = (bf16_t*)(Lb + 46080); bf16_t* Bt = (bf16_t*)(Lb + 55296); bf16_t* kap = (bf16_t*)(Lb + 64512);
    bf16_t* KtT = (bf16_t*)(Lb + 73728); bf16_t* BtT = (bf16_t*)(Lb + 82944); bf16_t* kapT = (bf16_t*)(Lb + 92160); bf16_t* VT = (bf16_t*)(Lb + 101376);
    float* btot = (float*)(Lb + 110592); float* GCv = btot + 256;
    bf16_t* Akk = (bf16_t*)(Lb + 27648); bf16_t* Ark = (bf16_t*)(Lb + 111872); bf16_t* Arb = (bf16_t*)(Lb + 121088); bf16_t* XT = (bf16_t*)(Lb + 130304);
    bf16_t* const Ms[2] = {(bf16_t*)(Lb + 0), (bf16_t*)(Lb + 46080)}; bf16_t* const MTs[2] = {(bf16_t*)(Lb + 9216), (bf16_t*)(Lb + 55296)}; bf16_t* const Ts[2] = {(bf16_t*)(Lb + 18432), (bf16_t*)(Lb + 64512)};
    const float* mu = p.rw_shift + (size_t)l * 2 * RWC;
    lds_barrier();
    float4 cst[2][5];
#pragma unroll
    for (int nt = 0; nt < 2; ++nt) { const int c = hh * 64 + 32 * ch + 16 * nt + 4 * q;
        cst[nt][0] = *(const float4*)(p.rw_k_k + (size_t)l * 768 + c); cst[nt][1] = *(const float4*)(p.rw_k_a + (size_t)l * 768 + c); cst[nt][2] = *(const float4*)(p.rw_r_k + (size_t)l * 768 + c);
        cst[nt][3] = *(const float4*)(p.rw_w0 + ((size_t)l * 2 + n) * 768 + c); cst[nt][4] = *(const float4*)(p.rw_a0 + ((size_t)l * 2 + n) * 768 + c); }
    const uint4* srcw = (const uint4*)(p.Lwa + (size_t)((l * 2 + n) * 12 + hh) * 2 * 64 * 72);
    const uint4* srcg = (const uint4*)(p.Lg + (size_t)(l * 12 + hh) * 64 * 104);
    const uint4 wv0 = srcw[tid], wv1 = srcw[tid + 512], wv2 = tid < 128 ? srcw[tid + 1024] : make_uint4(0u, 0u, 0u, 0u);
    uint4 gv0 = make_uint4(0u, 0u, 0u, 0u), gv1 = gv0; if (n == 0) { gv0 = srcg[tid]; if (tid < 320) gv1 = srcg[tid + 512]; }
    {
        int kind, c8, col, rg;
        if (rw_map(tid, n, hh, kind, c8, col, rg)) {
            const int j0 = 8 * rg;
            const int ta = n == 0 ? s0 + j0 : s0 + 63 - j0 - 7;
            const float m0[8] = {P.m0a.x, P.m0a.y, P.m0a.z, P.m0a.w, P.m0b.x, P.m0b.y, P.m0b.z, P.m0b.w}, m1[8] = {P.m1a.x, P.m1a.y, P.m1a.z, P.m1a.w, P.m1b.x, P.m1b.y, P.m1b.z, P.m1b.w};
            unsigned vpk[8][4];
#pragma unroll
            for (int i = 0; i < 8; ++i) {
                const int tk = ta + i, j = n == 0 ? tk - s0 : s0 + 63 - tk;
                const uint4 pu = P.raw[i], cu = P.raw[i + 1], nu = P.raw[i + 2];
                const unsigned pw[4] = {pu.x, pu.y, pu.z, pu.w}, cw[4] = {cu.x, cu.y, cu.z, cu.w}, nw[4] = {nu.x, nu.y, nu.z, nu.w};
                float x[8];
#pragma unroll
                for (int e = 0; e < 4; ++e) { const float c0 = bfl(cw[e]), c1 = bfh(cw[e]);
                    x[2 * e] = c0 + m0[2 * e] * (bfl(pw[e]) - c0) + m1[2 * e] * (bfl(nw[e]) - c0); x[2 * e + 1] = c1 + m0[2 * e + 1] * (bfh(pw[e]) - c1) + m1[2 * e + 1] * (bfh(nw[e]) - c1); }
                if (kind == 0) { *(float4*)(rf + j * FLD + c8) = make_float4(x[0], x[1], x[2], x[3]); *(float4*)(rf + j * FLD + c8 + 4) = make_float4(x[4], x[5], x[6], x[7]); }
                else if (kind == 1) { *(float4*)(kf + j * FLD + c8) = make_float4(x[0], x[1], x[2], x[3]); *(float4*)(kf + j * FLD + c8 + 4) = make_float4(x[4], x[5], x[6], x[7]); }
                else if (kind == 2) {
#pragma unroll
                    for (int e = 0; e < 8; ++e) { const unsigned hbits = (unsigned)f2bf(x[e]); vpk[e][i >> 1] = (i & 1) ? (vpk[e][i >> 1] | (hbits << 16)) : hbits; }
                    if (n == 0) { uint4 o; o.x = pg8::cvt_pk_bf16(x[0], x[1]); o.y = pg8::cvt_pk_bf16(x[2], x[3]); o.z = pg8::cvt_pk_bf16(x[4], x[5]); o.w = pg8::cvt_pk_bf16(x[6], x[7]);
                        *(uint4*)(p.rw_vb + ((size_t)(bh * (TT / 64) + ci) * 64 + j) * 64 + c8) = o; } }
                else {
                    bf16_t* dst = kind == 3 ? Aw + j * RLD + c8 : (kind == 4 ? Aa + j * RLD + c8 : Ag + j * GLD + c8);
                    if (kind == 3) {
#pragma unroll
                        for (int e = 0; e < 8; ++e) x[e] = 1.0f - 2.0f * __builtin_amdgcn_rcpf(1.0f + __builtin_amdgcn_exp2f(2.8853900817779268f * x[e])); }
                    else if (kind == 5) {
#pragma unroll
                        for (int e = 0; e < 8; ++e) x[e] = __builtin_amdgcn_rcpf(1.0f + __builtin_amdgcn_exp2f(-1.4426950408889634f * x[e])); }
                    uint4 o; o.x = pg8::cvt_pk_bf16(x[0], x[1]); o.y = pg8::cvt_pk_bf16(x[2], x[3]); o.z = pg8::cvt_pk_bf16(x[4], x[5]); o.w = pg8::cvt_pk_bf16(x[6], x[7]); *(uint4*)dst = o;
                }
            }
            if (kind == 2) {
#pragma unroll
                for (int e = 0; e < 8; ++e) { uint4 o = make_uint4(vpk[e][0], vpk[e][1], vpk[e][2], vpk[e][3]);
                    if (n != 0) o = make_uint4((o.w << 16) | (o.w >> 16), (o.z << 16) | (o.z >> 16), (o.y << 16) | (o.y >> 16), (o.x << 16) | (o.x >> 16));
                    *(uint4*)(VT + (c8 + e) * RLD + j0) = o; }
            }
        }
    }
    for (int i = tid; i < 64 * 16; i += NT) { const int j = i >> 4, c = 48 + (i & 15); Aw[j * RLD + c] = 0; Aa[j * RLD + c] = 0; }
    { uint4* dw = (uint4*)Bw; dw[tid] = wv0; dw[tid + 512] = wv1; if (tid < 128) dw[tid + 1024] = wv2;
      if (n == 0) { uint4* dg = (uint4*)Bg; dg[tid] = gv0; if (tid < 320) dg[tid + 512] = gv1; } }
    rwkv_prefetch(p, l, unit_next, tid, P);
    lds_barrier();
    rw_f32x4 accw[2], acca[2], accg[2];
#pragma unroll
    for (int nt = 0; nt < 2; ++nt) { accw[nt] = (rw_f32x4){0.f, 0.f, 0.f, 0.f}; acca[nt] = accw[nt]; accg[nt] = accw[nt]; }
    mm_t<64>(accw, Aw, RLD, Bw, RLD, rb, ch, fr, q);
    mm_t<64>(acca, Aa, RLD, Ba, RLD, rb, ch, fr, q);
    if (n == 0) mm_t<96>(accg, Ag, GLD, Bg, GLD, rb, ch, fr, q);
    const int t = 16 * rb + fr, s = n == 0 ? s0 + t : s0 + 63 - t, g = b * TT + s;
    float kv[2][4], rv[2][4], kkr[2][4], av[2][4], lw[2][4], kd[2][4], G[2][4]; float ssq = 0.f, bon = 0.f;
#pragma unroll
    for (int nt = 0; nt < 2; ++nt) {
        const int c = 32 * ch + 16 * nt + 4 * q;
        const float4 k4 = *(const float4*)(kf + t * FLD + c), r4 = *(const float4*)(rf + t * FLD + c);
        const float4 kk4 = cst[nt][0], ka4 = cst[nt][1], rk4 = cst[nt][2], w04 = cst[nt][3], a04 = cst[nt][4];
        const float ke[4] = {k4.x, k4.y, k4.z, k4.w}, re[4] = {r4.x, r4.y, r4.z, r4.w}, kke[4] = {kk4.x, kk4.y, kk4.z, kk4.w}, kae[4] = {ka4.x, ka4.y, ka4.z, ka4.w}, rke[4] = {rk4.x, rk4.y, rk4.z, rk4.w}, w0e[4] = {w04.x, w04.y, w04.z, w04.w}, a0e[4] = {a04.x, a04.y, a04.z, a04.w};
#pragma unroll
        for (int j = 0; j < 4; ++j) {
            kv[nt][j] = ke[j]; rv[nt][j] = re[j]; kkr[nt][j] = ke[j] * kke[j]; ssq += kkr[nt][j] * kkr[nt][j];
            const float wpre = w0e[j] + accw[nt][j]; lw[nt][j] = -0.6065306597126334f * __builtin_amdgcn_rcpf(1.0f + __expf(-wpre));
            av[nt][j] = __builtin_amdgcn_rcpf(1.0f + __expf(-(a0e[j] + acca[nt][j])));
            kd[nt][j] = ke[j] * (1.0f + (av[nt][j] - 1.0f) * kae[j]); bon += re[j] * kd[nt][j] * rke[j];
            float x = lw[nt][j];
            x += __int_as_float(__builtin_amdgcn_update_dpp(0, __float_as_int(x), 0x111, 0xF, 0xF, true)); x += __int_as_float(__builtin_amdgcn_update_dpp(0, __float_as_int(x), 0x112, 0xF, 0xF, true));
            x += __int_as_float(__builtin_amdgcn_update_dpp(0, __float_as_int(x), 0x114, 0xF, 0xF, true)); x += __int_as_float(__builtin_amdgcn_update_dpp(0, __float_as_int(x), 0x118, 0xF, 0xF, true));
            G[nt][j] = x; if (fr == 15) btot[rb * 64 + c + j] = x;
        }
    }
    ssq += bperm_f(lane ^ 16, ssq); ssq += bperm_f(lane ^ 32, ssq); bon += bperm_f(lane ^ 16, bon); bon += bperm_f(lane ^ 32, bon);
    if (q == 0) { red[ch * 64 + t] = ssq; red[128 + ch * 64 + t] = bon; }
    lds_barrier();
    const float rnorm = 1.0f / fmaxf(sqrtf(red[t] + red[64 + t]), 1e-12f);
    if (ch == 0 && q == 0) p.bonus[((size_t)n * M + g) * 12 + hh] = red[128 + t] + red[192 + t];
    const size_t uoff = (size_t)unit * 4096;
#pragma unroll
    for (int nt = 0; nt < 2; ++nt)
#pragma unroll
        for (int j = 0; j < 4; ++j) { const int c = 32 * ch + 16 * nt + 4 * q + j; float pre = 0.f, tot = 0.f;
#pragma unroll
            for (int r2 = 0; r2 < 4; ++r2) { const float bt = btot[r2 * 64 + c]; tot += bt; if (r2 < rb) pre += bt; }
            G[nt][j] += pre; if (t == 63) GCv[c] = __expf(tot); }
#pragma unroll
    for (int nt = 0; nt < 2; ++nt) {
        const int c = 32 * ch + 16 * nt + 4 * q;
        float rt[4], kt[4], bt[4], kp[4];
#pragma unroll
        for (int j = 0; j < 4; ++j) { const float gam = __expf(G[nt][j]), ig = __expf(-G[nt][j]), gp = __expf(G[nt][j] - lw[nt][j]); const float kk = kkr[nt][j] * rnorm;
            rt[j] = rv[nt][j] * gam; kt[j] = kd[nt][j] * ig; bt[j] = kk * av[nt][j] * ig; kp[j] = kk * gp;
            KtT[(c + j) * RLD + t] = f2bf(kt[j]); BtT[(c + j) * RLD + t] = f2bf(bt[j]); kapT[(c + j) * RLD + t] = f2bf(kp[j]); }
        uint2 o; o.x = pg8::cvt_pk_bf16(rt[0], rt[1]); o.y = pg8::cvt_pk_bf16(rt[2], rt[3]); *(uint2*)(Rt + t * RLD + c) = o;
        o.x = pg8::cvt_pk_bf16(kt[0], kt[1]); o.y = pg8::cvt_pk_bf16(kt[2], kt[3]); *(uint2*)(Kt + t * RLD + c) = o;
        o.x = pg8::cvt_pk_bf16(bt[0], bt[1]); o.y = pg8::cvt_pk_bf16(bt[2], bt[3]); *(uint2*)(Bt + t * RLD + c) = o;
        o.x = pg8::cvt_pk_bf16(kp[0], kp[1]); o.y = pg8::cvt_pk_bf16(kp[2], kp[3]); *(uint2*)(kap + t * RLD + c) = o;
        if (n == 0) { o.x = pg8::cvt_pk_bf16(accg[nt][0], accg[nt][1]); o.y = pg8::cvt_pk_bf16(accg[nt][2], accg[nt][3]); *(uint2*)(p.rw_gb + ((size_t)(bh * (TT / 64) + ci) * 64 + t) * 64 + c) = o; }
    }
    lds_barrier();
#define RW_ZERO(a) do { a[0] = (rw_f32x4){0.f, 0.f, 0.f, 0.f}; a[1] = a[0]; } while (0)
#define RW_STORE_BF(dst, a) do { _Pragma("unroll") for (int _nt = 0; _nt < 2; ++_nt) { uint2 _o; _o.x = pg8::cvt_pk_bf16(a[_nt][0], a[_nt][1]); _o.y = pg8::cvt_pk_bf16(a[_nt][2], a[_nt][3]); \
        *(uint2*)((dst) + t * RLD + 32 * ch + 16 * _nt + 4 * q) = _o; } } while (0)
    { rw_f32x4 a1[2], a2[2], a3[2], a4[2], a5[2]; RW_ZERO(a1); RW_ZERO(a2); RW_ZERO(a3); RW_ZERO(a4); RW_ZERO(a5);
      mm_t<64>(a1, kap, RLD, Bt, RLD, rb, ch, fr, q);
      mm_t<64>(a2, Bt, RLD, kap, RLD, rb, ch, fr, q);
      mm_t<64>(a3, kap, RLD, Kt, RLD, rb, ch, fr, q);
      mm_t<64>(a4, Rt, RLD, Kt, RLD, rb, ch, fr, q);
      mm_t<64>(a5, Rt, RLD, Bt, RLD, rb, ch, fr, q);
      rw_f32x4 t1[2];
#pragma unroll
      for (int nt = 0; nt < 2; ++nt)
#pragma unroll
          for (int j = 0; j < 4; ++j) { const int cc = 32 * ch + 16 * nt + 4 * q + j;
              a1[nt][j] = cc < t ? -a1[nt][j] : 0.f; t1[nt][j] = a1[nt][j] + (cc == t ? 1.f : 0.f);
              a2[nt][j] = t < cc ? -a2[nt][j] : 0.f;
              a3[nt][j] = cc < t ? a3[nt][j] : 0.f; a4[nt][j] = cc <= t ? a4[nt][j] : 0.f; a5[nt][j] = cc <= t ? a5[nt][j] : 0.f; }
      RW_STORE_BF(Ms[0], a1); RW_STORE_BF(MTs[0], a2); RW_STORE_BF(Ts[0], t1); RW_STORE_BF(Akk, a3); RW_STORE_BF(Ark, a4); RW_STORE_BF(Arb, a5); }
    lds_barrier();
    { rw_f32x4 a1[2], a2[2], a3[2]; RW_ZERO(a1); RW_ZERO(a2); RW_ZERO(a3);
      mm_t<64>(a1, VT, RLD, Akk, RLD, rb, ch, fr, q);
      mm_t<64>(a2, Ms[0], RLD, MTs[0], RLD, rb, ch, fr, q);
      mm_t<64>(a3, MTs[0], RLD, Ms[0], RLD, rb, ch, fr, q);
      RW_STORE_BF(XT, a1); RW_STORE_BF(Ms[1], a2); RW_STORE_BF(MTs[1], a3); }
    lds_barrier();
#pragma unroll
    for (int k = 1; k <= 5; ++k) {
        const bf16_t* Tk = Ts[(k + 1) & 1]; bf16_t* Tn = Ts[k & 1];
        rw_f32x4 a1[2]; RW_ZERO(a1);
        mm_t<64>(a1, Tk, RLD, MTs[k & 1], RLD, rb, ch, fr, q);
#pragma unroll
        for (int nt = 0; nt < 2; ++nt) { const uint2 o = *(const uint2*)(Tk + t * RLD + 32 * ch + 16 * nt + 4 * q); a1[nt][0] += bfl(o.x); a1[nt][1] += bfh(o.x); a1[nt][2] += bfl(o.y); a1[nt][3] += bfh(o.y); }
        RW_STORE_BF(Tn, a1);
        if (k < 5) { rw_f32x4 a2[2], a3[2]; RW_ZERO(a2); RW_ZERO(a3);
            mm_t<64>(a2, Ms[k & 1], RLD, MTs[k & 1], RLD, rb, ch, fr, q);
            mm_t<64>(a3, MTs[k & 1], RLD, Ms[k & 1], RLD, rb, ch, fr, q);
            RW_STORE_BF(Ms[(k + 1) & 1], a2); RW_STORE_BF(MTs[(k + 1) & 1], a3); }
        lds_barrier();
    }
    { rw_f32x4 a1[2], a2[2]; RW_ZERO(a1); RW_ZERO(a2);
      mm_t<64>(a1, kapT, RLD, Ts[1], RLD, rb, ch, fr, q);
      mm_t<64>(a2, XT, RLD, Ts[1], RLD, rb, ch, fr, q);
      RW_STORE_BF(Ms[0], a1); RW_STORE_BF(MTs[0], a2); }
    lds_barrier();
    { const bf16_t* WT = Ms[0]; const bf16_t* U0T = MTs[0];
      rw_f32x4 a1[2]; RW_ZERO(a1); mm_t<64>(a1, BtT, RLD, WT, RLD, rb, ch, fr, q);
      { const float gc = GCv[t];
#pragma unroll
        for (int nt = 0; nt < 2; ++nt) { uint2 o; float e[4];
#pragma unroll
            for (int j = 0; j < 4; ++j) e[j] = gc * ((32 * ch + 16 * nt + 4 * q + j == t ? 1.f : 0.f) - a1[nt][j]);
            o.x = pg8::cvt_pk_bf16(e[0], e[1]); o.y = pg8::cvt_pk_bf16(e[2], e[3]); *(uint2*)(p.rw_P + uoff + t * 64 + 32 * ch + 16 * nt + 4 * q) = o; } }
      rw_f32x4 a2[2], a3[2]; RW_ZERO(a2); RW_ZERO(a3); mm_t<64>(a2, VT, RLD, KtT, RLD, rb, ch, fr, q); mm_t<64>(a3, U0T, RLD, BtT, RLD, rb, ch, fr, q);
#pragma unroll
      for (int nt = 0; nt < 2; ++nt) { const int c = 32 * ch + 16 * nt + 4 * q; const float4 gc4 = *(const float4*)(GCv + c);
          *(float4*)(p.rw_QT + uoff + t * 64 + c) = make_float4(gc4.x * (a2[nt][0] - a3[nt][0]), gc4.y * (a2[nt][1] - a3[nt][1]), gc4.z * (a2[nt][2] - a3[nt][2]), gc4.w * (a2[nt][3] - a3[nt][3])); }
      rw_f32x4 a4[2]; RW_ZERO(a4); mm_t<64>(a4, Arb, RLD, WT, RLD, rb, ch, fr, q);
#pragma unroll
      for (int nt = 0; nt < 2; ++nt) { const int c = 32 * ch + 16 * nt + 4 * q; const uint2 r2 = *(const uint2*)(Rt + t * RLD + c); uint2 o;
          o.x = pg8::cvt_pk_bf16(bfl(r2.x) - a4[nt][0], bfh(r2.x) - a4[nt][1]); o.y = pg8::cvt_pk_bf16(bfl(r2.y) - a4[nt][2], bfh(r2.y) - a4[nt][3]); *(uint2*)(p.rw_Ry + uoff + t * 64 + c) = o; }
      rw_f32x4 a5[2], a6[2]; RW_ZERO(a5); RW_ZERO(a6); mm_t<64>(a5, Ark, RLD, VT, RLD, rb, ch, fr, q); mm_t<64>(a6, Arb, RLD, U0T, RLD, rb, ch, fr, q);
#pragma unroll
      for (int nt = 0; nt < 2; ++nt) { const int c = 32 * ch + 16 * nt + 4 * q; *(float4*)(p.rw_Y0 + uoff + t * 64 + c) = make_float4(a5[nt][0] - a6[nt][0], a5[nt][1] - a6[nt][1], a5[nt][2] - a6[nt][2], a5[nt][3] - a6[nt][3]); } }
#undef RW_ZERO
#undef RW_STORE_BF
}

__device__ __forceinline__ void rwkv_chain(const Params& p, unsigned char* Lb, int chain) {
    const int tid = otid(), wid = tid >> 6, lane = tid & 63, rb = wid & 3, ch = wid >> 2, fr = lane & 15, q = lane >> 4;
    const int n = chain / 48, bh = chain % 48;
    bf16_t* HT[2] = {(bf16_t*)Lb, (bf16_t*)(Lb + 9216)};
    rw_f32x4 hacc[2];
    hacc[0] = (rw_f32x4){0.f, 0.f, 0.f, 0.f}; hacc[1] = hacc[0];
    __syncthreads();
    auto uoff_of = [&](int step) { const int ci = n == 0 ? step : (step < 4 ? 3 - step : (TT / 64 - 1) - (step - 4)); return (size_t)(((bh * (TT / 64) + ci) << 1) | n) * 4096; };
    struct Ops { rw_bf16x8 p0, p1; float4 q0, q1; };
    auto load_ops = [&](int step, Ops& o) { const size_t uo = uoff_of(step); const bf16_t* Pp = p.rw_P + uo + (16 * rb + fr) * 64 + 8 * q; o.p0 = *(const rw_bf16x8*)Pp; o.p1 = *(const rw_bf16x8*)(Pp + 32);
        o.q0 = *(const float4*)(p.rw_QT + uo + (32 * ch + fr) * 64 + 16 * rb + 4 * q); o.q1 = *(const float4*)(p.rw_QT + uo + (32 * ch + 16 + fr) * 64 + 16 * rb + 4 * q); };
    auto do_step = [&](int step, const Ops& o) {
        const size_t uoff = uoff_of(step);
        bf16_t* hb = HT[step & 1];
#pragma unroll
        for (int nt = 0; nt < 2; ++nt) { uint2 w; w.x = pg8::cvt_pk_bf16(hacc[nt][0], hacc[nt][1]); w.y = pg8::cvt_pk_bf16(hacc[nt][2], hacc[nt][3]);
            const int v = 32 * ch + 16 * nt + fr, k0 = 16 * rb + 4 * q;
            *(uint2*)(hb + v * RLD + k0) = w; *(uint2*)(p.rw_H0 + uoff + v * 64 + k0) = w; }
        lds_barrier();
#pragma unroll
        for (int nt = 0; nt < 2; ++nt) {
            const bf16_t* bp = hb + (32 * ch + 16 * nt + fr) * RLD + 8 * q;
            const rw_bf16x8 b0 = *(const rw_bf16x8*)bp, b1 = *(const rw_bf16x8*)(bp + 32);
            const float4 cq = nt == 0 ? o.q0 : o.q1;
            rw_f32x4 c = (rw_f32x4){cq.x, cq.y, cq.z, cq.w};
            c = __builtin_amdgcn_mfma_f32_16x16x32_bf16(o.p0, b0, c, 0, 0, 0);
            hacc[nt] = __builtin_amdgcn_mfma_f32_16x16x32_bf16(o.p1, b1, c, 0, 0, 0);
        }
    };
    Ops A, B; load_ops(0, A); load_ops(1, B);
    for (int step = 0; step < TT / 64; step += 2) {
        do_step(step, A); if (step + 2 < TT / 64) load_ops(step + 2, A);
        do_step(step + 1, B); if (step + 3 < TT / 64) load_ops(step + 3, B);
    }
}

__device__ __forceinline__ void rwkv_out(const Params& p, unsigned char* Lb, int l, int unit3) {
    const int tid = otid(), wid = tid >> 6, lane = tid & 63, rb = wid & 3, ch = wid >> 2, fr = lane & 15, q = lane >> 4;
    const int ci = unit3 % (TT / 64), bh = unit3 / (TT / 64), b = bh / 12, hh = bh % 12;
    float* red = (float*)Lb;
    const int t = 16 * rb + fr, g = b * TT + ci * 64 + t;
    rw_f32x4 y[2]; y[0] = (rw_f32x4){0.f, 0.f, 0.f, 0.f}; y[1] = y[0];
#pragma unroll
    for (int n = 0; n < 2; ++n) {
        const size_t uoff = (size_t)(((bh * (TT / 64) + ci) << 1) | n) * 4096;
        const int row = n == 0 ? t : 63 - t;
        const bf16_t* ap = p.rw_Ry + uoff + row * 64 + 8 * q;
        const rw_bf16x8 a0 = *(const rw_bf16x8*)ap, a1 = *(const rw_bf16x8*)(ap + 32);
#pragma unroll
        for (int nt = 0; nt < 2; ++nt) {
            const int c = 32 * ch + 16 * nt;
            const bf16_t* bp = p.rw_H0 + uoff + (c + fr) * 64 + 8 * q;
            const rw_bf16x8 b0 = *(const rw_bf16x8*)bp, b1 = *(const rw_bf16x8*)(bp + 32);
            const float4 y0 = *(const float4*)(p.rw_Y0 + uoff + row * 64 + c + 4 * q);
            rw_f32x4 acc = (rw_f32x4){y0.x, y0.y, y0.z, y0.w};
            acc = __builtin_amdgcn_mfma_f32_16x16x32_bf16(b0, a0, acc, 0, 0, 0);
            acc = __builtin_amdgcn_mfma_f32_16x16x32_bf16(b1, a1, acc, 0, 0, 0);
            y[nt] += acc;
        }
    }
    float s1 = 0.f, s2 = 0.f;
#pragma unroll
    for (int nt = 0; nt < 2; ++nt)
#pragma unroll
        for (int j = 0; j < 4; ++j) { s1 += y[nt][j]; s2 += y[nt][j] * y[nt][j]; }
    s1 += bperm_f(lane ^ 16, s1); s1 += bperm_f(lane ^ 32, s1); s2 += bperm_f(lane ^ 16, s2); s2 += bperm_f(lane ^ 32, s2);
    __syncthreads();
    if (q == 0) { red[ch * 64 + t] = s1; red[128 + ch * 64 + t] = s2; }
    __syncthreads();
    const float mean = (red[t] + red[64 + t]) * (1.0f / 64.0f), var = fmaxf((red[128 + t] + red[192 + t]) * (1.0f / 64.0f) - mean * mean, 0.f), rstd = rsqrtf(var + 64e-5f);
    const float bon = p.bonus[(size_t)g * 12 + hh] + p.bonus[((size_t)M + g) * 12 + hh];
    const float* gng = p.rw_gn_g + (size_t)l * 768 + hh * 64; const float* gnb = p.rw_gn_b + (size_t)l * 768 + hh * 64;
    const size_t coff = ((size_t)(bh * (TT / 64) + ci) * 64 + t) * 64;
#pragma unroll
    for (int nt = 0; nt < 2; ++nt) {
        const int c = 32 * ch + 16 * nt + 4 * q;
        const float4 gg = *(const float4*)(gng + c), gb = *(const float4*)(gnb + c);
        const uint2 vv = *(const uint2*)(p.rw_vb + coff + c), gt = *(const uint2*)(p.rw_gb + coff + c);
        const float o0 = ((y[nt][0] - mean) * rstd * gg.x + gb.x + bon * bfl(vv.x)) * bfl(gt.x), o1 = ((y[nt][1] - mean) * rstd * gg.y + gb.y + bon * bfh(vv.x)) * bfh(gt.x);
        const float o2 = ((y[nt][2] - mean) * rstd * gg.z + gb.z + bon * bfl(vv.y)) * bfl(gt.y), o3 = ((y[nt][3] - mean) * rstd * gg.w + gb.w + bon * bfh(vv.y)) * bfh(gt.y);
        uint2 o; o.x = pg8::cvt_pk_bf16(o0, o1); o.y = pg8::cvt_pk_bf16(o2, o3);
        *(uint2*)(p.mix + (size_t)g * D + 1280 + hh * 64 + c) = o;
    }
}

typedef short attn_bf16x8 __attribute__((ext_vector_type(8)));
typedef float attn_f32x4 __attribute__((ext_vector_type(4)));
constexpr int ATT_LAT = NB * 12 * 64 * 4, ATT_CTX = NB * 12 * (LC / 16), ATT_TASKS = ATT_LAT + ATT_CTX;
__device__ __forceinline__ attn_bf16x8 ld_frag16(const bf16_t* ptr) { return *(const attn_bf16x8*)ptr; }
__device__ __forceinline__ attn_bf16x8 ld_frag8x2(const bf16_t* p0, const bf16_t* p1) {
    const uint2 a = *(const uint2*)p0, b = *(const uint2*)p1; uint4 r; r.x = a.x; r.y = a.y; r.z = b.x; r.w = b.y; return *(const attn_bf16x8*)&r; }
struct AttnFrag { attn_bf16x8 k[2][2]; attn_bf16x8 v[4]; };
__device__ __forceinline__ void attn_load(AttnFrag& F, const bf16_t* Kh  , const bf16_t* Vh  , int s0  , int qi, int q) {
#pragma unroll
    for (int t = 0; t < 2; ++t)
#pragma unroll
        for (int ks = 0; ks < 2; ++ks) F.k[t][ks] = ld_frag16(Kh + ((size_t)(((s0 >> 4) + t) * 2 + ks) * 16 + qi) * 32 + 8 * q);
#pragma unroll
    for (int db = 0; db < 4; ++db) F.v[db] = ld_frag16(Vh + ((size_t)(s0 >> 5) * 64 + 16 * db + qi) * 32 + 8 * q);
}
__device__ __forceinline__ void attn_compute(const AttnFrag& F, const attn_bf16x8 (&qf)[2], int lane, float& m, float& l, attn_f32x4 (&oacc)[4],
                                             bool win, const float* brow  , unsigned vmask  , const int (&boff)[8]) {
    attn_f32x4 st[2];
#pragma unroll
    for (int t = 0; t < 2; ++t) {
        attn_f32x4 z4 = {0.f, 0.f, 0.f, 0.f};
        z4 = __builtin_amdgcn_mfma_f32_16x16x32_bf16(F.k[t][0], qf[0], z4, 0, 0, 0);
        st[t] = __builtin_amdgcn_mfma_f32_16x16x32_bf16(F.k[t][1], qf[1], z4, 0, 0, 0);
    }
    float sc[8]; float mx = -1e30f;
#pragma unroll
    for (int i = 0; i < 8; ++i) {
        float s = st[i >> 2][i & 3] * 0.18033688011112042f;
        if (win) s = ((vmask >> i) & 1u) ? s + brow[boff[i]] : -1e30f;
        sc[i] = s; mx = fmaxf(mx, s);
    }
    mx = fmaxf(mx, bperm_f(lane ^ 16, mx)); mx = fmaxf(mx, bperm_f(lane ^ 32, mx));
    if (__any(mx > m)) {
        const float mn = fmaxf(m, mx), alpha = __builtin_amdgcn_exp2f(m - mn);
        l *= alpha; m = mn;
#pragma unroll
        for (int db = 0; db < 4; ++db) oacc[db] *= alpha;
    }
    float ps = 0.f; float pv[8];
#pragma unroll
    for (int i = 0; i < 8; ++i) { pv[i] = __builtin_amdgcn_exp2f(sc[i] - m); ps += pv[i]; }
    l += ps;
    uint4 pk; pk.x = pg8::cvt_pk_bf16(pv[0], pv[1]); pk.y = pg8::cvt_pk_bf16(pv[2], pv[3]); pk.z = pg8::cvt_pk_bf16(pv[4], pv[5]); pk.w = pg8::cvt_pk_bf16(pv[6], pv[7]);
    const attn_bf16x8 pb = *(const attn_bf16x8*)&pk;
#pragma unroll
    for (int db = 0; db < 4; ++db) oacc[db] = __builtin_amdgcn_mfma_f32_16x16x32_bf16(F.v[db], pb, oacc[db], 0, 0, 0);
}
constexpr int ATT_LAT2 = NB * 12 * 64 * 2, ATT_CTX2 = NB * 12 * (LC / 32), ATT_TASKS2 = ATT_LAT2 + ATT_CTX2;
__device__ __forceinline__ void attn_task2(const Params& p, const float* rpbs  , int task) {
    const int lane = otid() & 63, qi = lane & 15, q = lane >> 4;
    const bool lat = task < ATT_LAT2;
    int bh, qrow = 0, qp;
    if (lat) { bh = task >> 7; const int rem = task & 127; qrow = rem >> 1; qp = rem & 1; }
    else { const int t2 = task - ATT_LAT2; bh = t2 >> 3; qp = t2 & 7; }
    const int b = bh / 12, hh = bh % 12;
    const bf16_t* Kh = p.Ka + (size_t)bh * TT * 64; const bf16_t* Vh = p.Vt + (size_t)bh * 64 * TT;
    int sq[2]; attn_bf16x8 qa[2][2], qr[2][2];
#pragma unroll
    for (int u = 0; u < 2; ++u) {
        sq[u] = lat ? LC + qrow * 64 + (2 * qp + u) * 16 + qi : (2 * qp + u) * 16 + qi;
        const bf16_t* qp0 = p.Qa + ((size_t)bh * TT + sq[u]) * 64 + 8 * q; qa[u][0] = ld_frag16(qp0); qa[u][1] = ld_frag16(qp0 + 32); qr[u][0] = qa[u][0]; qr[u][1] = qa[u][1];
        if (lat) { const bf16_t* qp1 = p.Qr + ((size_t)bh * L + (sq[u] - LC)) * 64 + 8 * q; qr[u][0] = ld_frag16(qp1); qr[u][1] = ld_frag16(qp1 + 32); }
    }
    const int krow0 = min(max(qrow - 4, 0), 56);
    bool need0[2], need1[2]; unsigned vm0[2], vm1[2]; int boff[2][8];
#pragma unroll
    for (int u = 0; u < 2; ++u) { const int qb = 2 * qp + u, qc = qb * 16 + qi, kcol0 = min(max(qc - 8, 0), 48);
        const int clo = min(max(qb * 16 - 8, 0), 48), chi = min(max(qb * 16 + 7, 0), 48) + 16; need0[u] = clo < 32; need1[u] = chi > 32; vm0[u] = 0u; vm1[u] = 0u;
#pragma unroll
        for (int i = 0; i < 8; ++i) { const int kc = 16 * (i >> 2) + 4 * q + (i & 3); boff[u][i] = kc - qc + 15; vm0[u] |= ((unsigned)(kc - kcol0) < 16u ? 1u : 0u) << i; vm1[u] |= ((unsigned)(kc + 32 - kcol0) < 16u ? 1u : 0u) << i; } }
    const bool cb0 = need0[0] || need0[1], cb1 = need1[0] || need1[1]; const int ncb = (cb0 && cb1) ? 2 : 1, cbo = cb0 ? 0 : 1;
    const int nsteps = lat ? 8 + 8 * ncb : 8;
    float m[2] = {-1e30f, -1e30f}, l[2] = {0.f, 0.f}; attn_f32x4 oacc[2][4];
#pragma unroll
    for (int u = 0; u < 2; ++u)
#pragma unroll
        for (int db = 0; db < 4; ++db) oacc[u][db] = (attn_f32x4){0.f, 0.f, 0.f, 0.f};
#define ATT_S0(s, s0v, krv, cbv) do { if ((s) < 8) { s0v = (s) * 32; krv = 0; cbv = 0; } else { const int _w = (s) - 8; krv = ncb == 2 ? (_w >> 1) : _w; cbv = ncb == 2 ? (_w & 1) : cbo; s0v = LC + (krow0 + krv) * 64 + cbv * 32; } } while (0)
#define ATT_LOAD(F, s) do { int _s0, _kr, _cb; ATT_S0((s), _s0, _kr, _cb); attn_load(F, Kh, Vh, _s0, qi, q); } while (0)
#define ATT_COMP(F, s) do { int _s0, _kr, _cb; ATT_S0((s), _s0, _kr, _cb); const bool _w = (s) >= 8; const float* _br = rpbs + hh * 465 + (krow0 + _kr - qrow + 7) * 31; \
        _Pragma("unroll") for (int u = 0; u < 2; ++u) if (!_w || (_cb == 0 ? need0[u] : need1[u])) attn_compute(F, _w ? qr[u] : qa[u], lane, m[u], l[u], oacc[u], _w, _br + _cb * 32, _cb ? vm1[u] : vm0[u], boff[u]); } while (0)
    AttnFrag FA, FB;
    ATT_LOAD(FA, 0);
    for (int s = 0; s < nsteps; s += 2) {
        ATT_LOAD(FB, s + 1);
        ATT_COMP(FA, s);
        if (s + 2 < nsteps) ATT_LOAD(FA, s + 2);
        ATT_COMP(FB, s + 1);
    }
#undef ATT_S0
#undef ATT_LOAD
#undef ATT_COMP
#pragma unroll
    for (int u = 0; u < 2; ++u) {
        float lt = l[u]; lt += bperm_f(lane ^ 16, lt); lt += bperm_f(lane ^ 32, lt);
        const float rinv = 1.0f / lt;
        bf16_t* op = p.mix + (size_t)(b * TT + sq[u]) * D + 512 + hh * 64 + 4 * q;
#pragma unroll
        for (int db = 0; db < 4; ++db) { uint2 w; w.x = pg8::cvt_pk_bf16(oacc[u][db][0] * rinv, oacc[u][db][1] * rinv); w.y = pg8::cvt_pk_bf16(oacc[u][db][2] * rinv, oacc[u][db][3] * rinv); *(uint2*)(op + 16 * db) = w; }
    }
}

constexpr int RT_LD = 2052;
__device__ __forceinline__ void phase_router(const Params& p, unsigned char* Lb, int l, int bid, int nb) {
    const int tix = otid(), wid = tix >> 6, lane = tix & 63;
    float* At = (float*)Lb;
    float* Pp = At + 16 * RT_LD;
    int* ent = (int*)(Pp + 2 * 16 * 64);
    int* lcnt = ent + 480 * 4; int* lbase = lcnt + 64;
    const float* gam = p.norm2_g + (size_t)l * D;
    __syncthreads();
    if (tix < 64) lcnt[tix] = 0;
    int nloc = 0;
    const bool latonly = (l == 1);
    for (int tile = bid; tile < (latonly ? NB * L / 16 : M / 16); tile += nb, ++nloc) {
        const int g0 = latonly ? (tile >> 8) * TT + LC + (tile & 255) * 16 : tile * 16;
        __syncthreads();
#pragma unroll 1
        for (int rr = 0; rr < 2; ++rr) {
            const int r = 2 * wid + rr, g = g0 + r;
            const float* xr = p.xcur + (size_t)g * D;
            float4 v[8]; float ss = 0.f;
#pragma unroll
            for (int i = 0; i < 8; ++i) { v[i] = *(const float4*)(xr + (i * 64 + lane) * 4); ss += v[i].x * v[i].x + v[i].y * v[i].y + v[i].z * v[i].z + v[i].w * v[i].w; }
            ss = wave_sum(ss);
            const float rs = rsqrtf(ss * (1.0f / D) + 1e-6f);
            const float* mrow = p.mod + (size_t)(l * 5 + modrow(g)) * 6 * D; const float* sh = mrow + 3 * D; const float* sc = mrow + 4 * D;
#pragma unroll
            for (int i = 0; i < 8; ++i) {
                const int d = (i * 64 + lane) * 4;
                const float4 gg = *(const float4*)(gam + d), s4 = *(const float4*)(sh + d), c4 = *(const float4*)(sc + d);
                float4 o;
                o.x = v[i].x * rs * gg.x * (1.0f + c4.x) + s4.x; o.y = v[i].y * rs * gg.y * (1.0f + c4.y) + s4.y; o.z = v[i].z * rs * gg.z * (1.0f + c4.z) + s4.z; o.w = v[i].w * rs * gg.w * (1.0f + c4.w) + s4.w;
                uint2 pk; pk.x = pg8::cvt_pk_bf16(o.x, o.y); pk.y = pg8::cvt_pk_bf16(o.z, o.w);
                *(uint2*)(p.h + (size_t)g * D + d) = pk;
                *(float4*)(At + r * RT_LD + d) = o;
            }
        }
        __syncthreads();
        {
            const int nt = wid & 3, kh = wid >> 2, fr = lane & 15, q = lane >> 4;
            pg8::f32x4 acc = {0.f, 0.f, 0.f, 0.f};
            const float* wp = p.Wr + (((size_t)(l * 128 + kh * 64) * 4 + nt) * 64 + lane) * 4;
            const float* ap = At + fr * RT_LD + kh * 1024 + 4 * q;
#pragma unroll 16
            for (int j = 0; j < 64; ++j) {
                const float4 a4 = *(const float4*)(ap + 16 * j), b4 = *(const float4*)(wp + (size_t)j * 1024);
                acc = __builtin_amdgcn_mfma_f32_16x16x4f32(a4.x, b4.x, acc, 0, 0, 0); acc = __builtin_amdgcn_mfma_f32_16x16x4f32(a4.y, b4.y, acc, 0, 0, 0);
                acc = __builtin_amdgcn_mfma_f32_16x16x4f32(a4.z, b4.z, acc, 0, 0, 0); acc = __builtin_amdgcn_mfma_f32_16x16x4f32(a4.w, b4.w, acc, 0, 0, 0);
            }
#pragma unroll
            for (int jj = 0; jj < 4; ++jj) Pp[(kh * 16 + 4 * q + jj) * 64 + 16 * nt + fr] = acc[jj];
        }
        __syncthreads();
#pragma unroll 1
        for (int rr = 0; rr < 2; ++rr) {
            const int r = 2 * wid + rr, g = g0 + r;
            const float score = 1.0f / (1.0f + expf(-(Pp[r * 64 + lane] + Pp[(16 + r) * 64 + lane])));
            float val = score + p.router_bias[l * NEXP + lane];
            int myidx[TOPK]; float mysc[TOPK]; float tot = 0.f;
#pragma unroll
            for (int k = 0; k < TOPK; ++k) {
                float bv = val; int bi = lane;
#pragma unroll
                for (int o = 32; o >= 1; o >>= 1) { const float ov = bperm_f(lane ^ o, bv); const int oi = bperm_i(lane ^ o, bi); if (ov > bv || (ov == bv && oi < bi)) { bv = ov; bi = oi; } }
                const float sc_k = bperm_f(bi, score);
                myidx[k] = bi; mysc[k] = sc_k; tot += sc_k;
                if (lane == bi) val = -INFINITY;
            }
            if (lane < TOPK) {
                int e = myidx[0]; float w = mysc[0];
#pragma unroll
                for (int k = 1; k < TOPK; ++k) if (lane == k) { e = myidx[k]; w = mysc[k]; }
                w = w / tot * 2.5f;
                p.sel[g * TOPK + lane] = e; p.selw[g * TOPK + lane] = w;
                const int lp = atomicAdd(&lcnt[e], 1);
                int* en = ent + ((nloc * 16 + r) * TOPK + lane) * 4; en[0] = e; en[1] = __float_as_int(w); en[2] = g * 8 + lane; en[3] = lp;
            }
        }
    }
    __syncthreads();
    if (tix < 64) lbase[tix] = lcnt[tix] ? atomicAdd(p.cnt + l * NEXP + tix, lcnt[tix]) : 0;
    __syncthreads();
    for (int i = tix; i < nloc * 16 * TOPK; i += NT) {
        const int e = ent[i * 4], gk = ent[i * 4 + 2], pos = lbase[e] + ent[i * 4 + 3];
        p.ltok[(size_t)e * LCAP + pos] = gk >> 3; p.lw[(size_t)e * LCAP + pos] = __int_as_float(ent[i * 4 + 1]); p.tpos[(gk >> 3) * TOPK + (gk & 7)] = pos;
    }
}

constexpr int MAXU = 17;
__device__ __forceinline__ void moe_tables(const Params& p, LAS int* tab, int lc) {
    const int tix = otid();
    __syncthreads();
    if (tix == 0) { int ts = 0, of = 0;
        for (int e = 0; e < NEXP; ++e) { const int c = __hip_atomic_load(p.cnt + lc * NEXP + e, __ATOMIC_RELAXED, __HIP_MEMORY_SCOPE_AGENT); tab[e] = ts; tab[66 + e] = of; tab[132 + e] = c; ts += (c + 255) / 256; of += (c + 255) / 256 * 256; }
        tab[NEXP] = ts; tab[66 + NEXP] = of; ts += M / 256; of += M;
        tab[65] = ts; tab[66 + 65] = of; }
    __syncthreads();
}
struct MoeSched {
    const LAS int* tab; const LAS unsigned* rowtab; int NPN, G, c, total; unsigned rowbytes; const char* Bt; size_t bstride;
    __device__ __forceinline__ bool next(int i, pg8::Unit& u) const {
        const int Lq = i * G + c; if (Lq >= total) return false;
        const int rt = Lq / NPN; u.pn = Lq - rt * NPN;
        int lo = 0, hi = 64;
        while (lo < hi) { const int mid = (lo + hi + 1) >> 1; if (tab[mid] <= rt) lo = mid; else hi = mid - 1; }
        u.e = lo; u.pm = rt - tab[lo]; u.ord = i; return true;
    }
    __device__ __forceinline__ unsigned arow(const pg8::Unit& u, int r) const { return rowtab[u.ord * 256 + r] * rowbytes; }
    __device__ __forceinline__ const char* bptr(const pg8::Unit& u) const { return Bt + (size_t)u.e * bstride + (size_t)u.pn * 256 * rowbytes; }
};
struct EpiGU {
    bf16_t* U; const LAS int* tab;
    __device__ __forceinline__ void operator()(const pg8::f32x4 (&acc)[2][2][4][2], const pg8::Unit& u, int wr, int wc, int fr, int fq) const {
        const int cn = (u.e < NEXP ? tab[132 + u.e] : M), off = tab[66 + u.e], col0 = u.pn * 128 + wc * 32 + 8 * fq;
#pragma unroll
        for (int ai = 0; ai < 2; ++ai)
#pragma unroll
            for (int m = 0; m < 4; ++m) { const int i = u.pm * 256 + ai * 128 + wr * 64 + m * 16 + fr;
                if (i < cn) { float o[8];
#pragma unroll
                    for (int n = 0; n < 2; ++n)
#pragma unroll
                        for (int j = 0; j < 4; ++j) { const float gv = acc[ai][0][m][n][j], uv = acc[ai][1][m][n][j]; o[n * 4 + j] = gv * __builtin_amdgcn_rcpf(1.0f + __expf(-gv)) * uv; }
                    pg8::u32x4 w; w.x = pg8::cvt_pk_bf16(o[0], o[1]); w.y = pg8::cvt_pk_bf16(o[2], o[3]); w.z = pg8::cvt_pk_bf16(o[4], o[5]); w.w = pg8::cvt_pk_bf16(o[6], o[7]);
                    *(pg8::u32x4*)(U + (size_t)(off + i) * DE + col0) = w; } }
    }
};
struct EpiDown {
    bf16_t* Y; const LAS int* tab;
    __device__ __forceinline__ void operator()(const pg8::f32x4 (&acc)[2][2][4][2], const pg8::Unit& u, int wr, int wc, int fr, int fq) const {
        const int cn = (u.e < NEXP ? tab[132 + u.e] : M), off = tab[66 + u.e], col0 = u.pn * 256 + wc * 32 + 8 * fq;
#pragma unroll
        for (int ai = 0; ai < 2; ++ai)
#pragma unroll
            for (int m = 0; m < 4; ++m) { const int i = u.pm * 256 + ai * 128 + wr * 64 + m * 16 + fr;
                if (i < cn) { bf16_t* rowp = Y + (size_t)(off + i) * D + col0;
#pragma unroll
                    for (int bj = 0; bj < 2; ++bj) { const pg8::f32x4 v0 = acc[ai][bj][m][0], v1 = acc[ai][bj][m][1];
                        pg8::u32x4 w; w.x = pg8::cvt_pk_bf16(v0[0], v0[1]); w.y = pg8::cvt_pk_bf16(v0[2], v0[3]); w.z = pg8::cvt_pk_bf16(v1[0], v1[1]); w.w = pg8::cvt_pk_bf16(v1[2], v1[3]);
                        *(pg8::u32x4*)(rowp + bj * 128) = w; } } }
    }
};
template <bool DOWN>
__device__ __forceinline__ void phase_gemm_moe(const Params& p, LAS unsigned char* stage, LAS int* tab, LAS unsigned* rowtab, int l, int bid, int nb) {
    const int tix = otid();
    moe_tables(p, tab, l);
    MoeSched S; S.tab = tab; S.rowtab = rowtab; S.NPN = DOWN ? 8 : 4; S.G = nb; S.c = bid; S.total = tab[65] * S.NPN;
    S.rowbytes = DOWN ? DE * 2 : D * 2; S.Bt = DOWN ? (const char*)p.WdnT : (const char*)p.WguT; S.bstride = DOWN ? (size_t)D * DE * 2 : (size_t)1024 * D * 2;
    for (int i = 0; i < MAXU; ++i) { pg8::Unit u; if (!S.next(i, u)) break;
        if (tix < 256) { const int idx = u.pm * 256 + tix, cn = (u.e < NEXP ? tab[132 + u.e] : M); unsigned v;
            if (DOWN) v = (unsigned)(tab[66 + u.e] + idx); else v = idx < cn ? (u.e < NEXP ? (unsigned)p.ltok[(size_t)u.e * LCAP + idx] : (unsigned)idx) : (unsigned)M;
            rowtab[i * 256 + tix] = v; } }
    __syncthreads();
    if (DOWN) { EpiDown E; E.Y = p.Y; E.tab = tab; pg8::gemm_phase<true>(stage, (const char*)p.U, DE, S, E); }
    else { EpiGU E; E.U = p.U; E.tab = tab; pg8::gemm_phase<true>(stage, (const char*)p.h, D, S, E); }
}
__device__ __forceinline__ void phase_final(const Params& p, LAS int* tab, int bid, int nb) {
    moe_tables(p, tab, 1);
    const int tix = otid();
    const int wid = tix >> 6, lane = tix & 63;
    for (int r = bid * 8 + wid; r < NB * L; r += nb * 8) {
        const int b = r / L, t = r % L; const float* xr = p.xcur + (size_t)(b * TT + LC + t) * D;
        float4 v[8]; float ss = 0.f;
#pragma unroll
        for (int i = 0; i < 8; ++i) v[i] = *(const float4*)(xr + (i * 64 + lane) * 4);
        moe_combine_row(p, tab, 1, b * TT + LC + t, lane, v);
#pragma unroll
        for (int i = 0; i < 8; ++i) ss += v[i].x * v[i].x + v[i].y * v[i].y + v[i].z * v[i].z + v[i].w * v[i].w;
        ss = wave_sum(ss); const float rs = rsqrtf(ss * (1.0f / D) + 1e-6f);
#pragma unroll
        for (int i = 0; i < 8; ++i) { const int d = (i * 64 + lane) * 4; const float4 gg = *(const float4*)(p.final_g + d);
            float4 o; o.x = v[i].x * rs * gg.x; o.y = v[i].y * rs * gg.y; o.z = v[i].z * rs * gg.z; o.w = v[i].w * rs * gg.w;
            *(float4*)(p.out + (size_t)r * D + d) = o; }
    }
}


constexpr int LDS_BYTES = 160 * 1024;
extern __shared__ __attribute__((aligned(16))) unsigned char dyn_lds_raw[];
__device__ __forceinline__ LAS unsigned char* lds_las(unsigned off) { asm volatile("" : "+s"(off)); return (LAS unsigned char*)(unsigned long)off; }
__device__ __forceinline__ int obid() { int b = blockIdx.x; asm volatile("" : "+s"(b)); return b; }
__device__ __forceinline__ int onb() { int b = gridDim.x; asm volatile("" : "+s"(b)); return b; }
typedef const __attribute__((address_space(4))) Params* KParams;
__device__ __forceinline__ KParams kp_opaque(KParams q) { asm volatile("" : "+s"(q)); return q; }
#define PPH (*(const Params*)kp_opaque(kp))
__global__ __launch_bounds__(512, 2) void mega(Params p_byval) {
    const KParams kp = (KParams)__builtin_amdgcn_kernarg_segment_ptr();
    if (threadIdx.x == 0) *(uint4*)dyn_lds_raw = make_uint4(0u, 0u, 0u, 0u);
    __syncthreads();
    XcdBarrier bar = xcd_barrier_post(PPH.bar, (volatile LAS unsigned*)dyn_lds_raw);
    const unsigned lds0 = (unsigned)(unsigned long long)(LAS unsigned char*)dyn_lds_raw;
#define LDSB ((unsigned char*)lds_las(lds0 + 1024u))
#define lds ((float*)LDSB)
#define stage (lds_las(lds0 + 1024u))
#define tab ((LAS int*)lds_las(lds0 + 1024u + 131072u))
#define rowtab ((LAS unsigned*)lds_las(lds0 + 1024u + 131072u + 1024u))
#define bid (obid())
#define nb (onb())
    phase_copy(PPH, bid, nb);
    phase_router_w(PPH, bid, nb);
    phase_lora_w(PPH, bid, nb);
    phase_adaln(PPH, lds, bid, nb);
    xcd_barrier(bar);
#pragma unroll 1
    for (int l = 0; l < 2; ++l) {
        phase_norm<0>(PPH, lds, tab, l, bid, nb);
        phase_convert(PPH, lds, l, bid, nb);
        xcd_barrier(bar);
        phase_gemm_in(PPH, stage, bid, nb);
        xcd_barrier(bar);
        phase_prep(PPH, lds, l, bid, nb);
        { const int b1 = obid(), n1 = onb(); RwPre pre; rwkv_prefetch(PPH, l, b1, otid(), pre); for (int unit = b1; unit < RW_UNITS; unit += n1) rwkv_unit(PPH, LDSB, l, unit, unit + n1, pre); }
        xcd_barrier(bar);
        { const int tix = otid(), wid = __builtin_amdgcn_readfirstlane(tix >> 6); const int bid_l = obid(), nb_l = onb();
          float* const rp_l = lds + 32768;
          { const Params& pr = PPH; for (int i = tix; i < 12 * 465; i += NT) rp_l[i] = pr.rpb[(size_t)l * 12 * 465 + i] * 1.4426950408889634f; }
          __syncthreads();
          if (bid_l < 96) rwkv_chain(PPH, LDSB, bid_l);
          { const int wt = nb_l > 96 ? 96 + 2 * (nb_l - 96) : nb_l, w0 = nb_l > 96 ? (bid_l < 96 ? bid_l : 96 + 2 * (bid_l - 96)) : bid_l, w1 = nb_l > 96 ? (bid_l < 96 ? bid_l + 1 : 96 + 2 * (bid_l - 95)) : bid_l + 1;
            const int lo = (int)((long)w0 * ATT_LAT2 / wt), hi = (int)((long)w1 * ATT_LAT2 / wt); for (int task = lo + wid; task < hi; task += 8) attn_task2(PPH, rp_l, task); }
          if (l == 0) for (int task = ATT_LAT2 + bid_l * 8 + wid; task < ATT_TASKS2; task += nb_l * 8) attn_task2(PPH, rp_l, task); }
        xcd_barrier(bar);
        { const int b1 = obid(), n1 = onb(); for (int u3 = b1; u3 < RW_UNITS / 2; u3 += n1) if (l == 0 || u3 % (TT / 64) >= 4) rwkv_out(PPH, LDSB, l, u3); }
        xcd_barrier(bar);
        phase_gemm_out(PPH, stage, l, bid, nb);
        xcd_barrier(bar);
        phase_router(PPH, LDSB, l, bid, nb);
        xcd_barrier(bar);
        phase_gemm_moe<false>(PPH, stage, tab, rowtab, l, bid, nb);
        xcd_barrier(bar);
        phase_gemm_moe<true>(PPH, stage, tab, rowtab, l, bid, nb);
        xcd_barrier(bar);
    }
    phase_final(PPH, tab, bid, nb);
}

#undef bid
#undef nb
#undef LDSB
#undef lds
#undef stage
#undef tab
#undef rowtab
extern "C" void kernel_launch(void* const* d_in, const int* in_sizes, int n_in, void* d_out, int out_size, void* d_ws, size_t ws_size, hipStream_t stream) {
    static int grid = 0;
    if (grid == 0) {
        int dev = 0, cus = 0, per_cu = 0;
        if (hipGetDevice(&dev) != hipSuccess || hipDeviceGetAttribute(&cus, hipDeviceAttributeMultiprocessorCount, dev) != hipSuccess) { grid = -1; return; }
        if (hipFuncSetAttribute((const void*)mega, hipFuncAttributeMaxDynamicSharedMemorySize, LDS_BYTES) != hipSuccess) { grid = -1; return; }
        if (hipOccupancyMaxActiveBlocksPerMultiprocessor(&per_cu, (const void*)mega, NT, LDS_BYTES) != hipSuccess || per_cu < 1) { grid = -1; return; }
        (void)hipGetLastError();
        grid = cus;
        if (grid < 96) { grid = -1; return; }
    }
    if (grid < 0) return;
    Params p{};
    const float** pf = (const float**)&p;
    for (int i = 0; i < 32; ++i) pf[i] = (const float*)d_in[i];
    p.out = (float*)d_out;
    char* w = (char*)d_ws; size_t o = 0;
    auto take = [&](size_t bytes) { char* r = w + o; o += (bytes + 255) & ~(size_t)255; return r; };
    p.bar = (unsigned*)take(XCD_BAR_WORDS * 4 + 2 * NEXP * 4);
    p.cnt = (int*)(p.bar + XCD_BAR_WORDS);
    p.mod = (float*)take((size_t)2 * 5 * 6 * D * 4);
    p.xcur = (float*)take((size_t)M * D * 4);
    p.h = (bf16_t*)take((size_t)(M + 1) * D * 2);
    p.mix = (bf16_t*)take((size_t)M * D * 2);
    p.z = (bf16_t*)take((size_t)M * ZLD * 2);
    p.Y = p.z;
    p.streams = (float*)take((size_t)M * SSTR * 4);
    p.bonus = (float*)take((size_t)2 * M * 12 * 4);
    { char* sb = (char*)p.streams; const size_t U = (size_t)RW_UNITS * 4096;
      p.rw_P = (bf16_t*)sb; sb += U * 2; p.rw_Ry = (bf16_t*)sb; sb += U * 2; p.rw_H0 = (bf16_t*)sb; sb += U * 2; p.rw_QT = (float*)sb; sb += U * 4; p.rw_Y0 = (float*)sb; sb += U * 4;
      p.rw_vb = (bf16_t*)sb; sb += U; p.rw_gb = (bf16_t*)sb; sb += U; }
    p.ydir = (float*)take((size_t)2 * M * 768 * 4);
    p.tpos = (int*)take((size_t)M * TOPK * 4);
    p.sel = (int*)take((size_t)M * TOPK * 4);
    p.selw = (float*)take((size_t)M * TOPK * 4);
    p.ltok = (int*)take((size_t)NEXP * LCAP * 4);
    p.lw = (float*)take((size_t)NEXP * LCAP * 4);
    p.U = (bf16_t*)take((size_t)(UROWS + M) * DE * 2);
    p.WinT = (bf16_t*)take((size_t)ZLD * D * 2);
    p.WoutT = (bf16_t*)take((size_t)D * D * 2);
    p.WguT = (bf16_t*)take((size_t)65 * 1024 * D * 2);
    p.WdnT = (bf16_t*)take((size_t)65 * D * DE * 2);
    p.Qa = (bf16_t*)take((size_t)NB * 12 * TT * 64 * 2);
    p.Qr = (bf16_t*)take((size_t)NB * 12 * L * 64 * 2);
    p.Ka = (bf16_t*)take((size_t)NB * 12 * TT * 64 * 2);
    p.Vt = (bf16_t*)take((size_t)NB * 12 * 64 * TT * 2);
    p.Wr = (float*)take((size_t)2 * D * NEXP * 4);
    p.Lwa = (bf16_t*)take((size_t)2 * 2 * 12 * 2 * 64 * 72 * 2);
    p.Lg = (bf16_t*)take((size_t)2 * 12 * 64 * 104 * 2);
    if (o > ws_size) return;
    if (hipMemsetAsync(p.bar, 0, XCD_BAR_WORDS * sizeof(unsigned) + 2 * NEXP * 4, stream) != hipSuccess) return;
    hipLaunchKernelGGL(mega, dim3(grid), dim3(NT), LDS_BYTES, stream, p);
}
```

```cpp
#include <hip/hip_runtime.h>
#include <stdint.h>

typedef unsigned short bf16_t;

constexpr int D = 2048, NB = 4, L = 4096, LC = 256, TT = L + LC, M = NB * TT;
constexpr int IN_COLS = 6432, ZLD = 6656;
constexpr int ZA = 0, ZB = 1536, ZC = 3840, RWC = 2592;
constexpr int NEXP = 64, TOPK = 6, DE = 512;
constexpr int NSTR = 10, SSTR = NSTR * 768;
constexpr int LCAP = M;
constexpr int UROWS = M * TOPK + NEXP * 256;
constexpr int NT = 512;

struct Params {
    const float *x, *c, *ctx, *c_ctx, *norm1_g, *norm2_g, *ada_w, *ada_b, *w_in, *conv_w, *rpb, *rw_shift, *rw_w0, *rw_w_up, *rw_a0, *rw_a_up, *rw_g_up,
        *rw_k_k, *rw_k_a, *rw_r_k, *rw_gn_g, *rw_gn_b, *w_out, *router_w, *router_bias, *exp_gate, *exp_up, *exp_down, *sh_gate, *sh_up, *sh_down, *final_g;
    float* out;
    unsigned* bar; float* mod; float* xcur; bf16_t* h; bf16_t* z; bf16_t* mix; float* streams; float* bonus; float* ydir;
    int* sel; float* selw; int* cnt; int* ltok; float* lw; bf16_t* U; bf16_t *WinT, *WoutT, *WguT, *WdnT; bf16_t *Qa, *Qr, *Ka, *Vt; bf16_t* Y; int* tpos; bf16_t *rw_P, *rw_Ry, *rw_H0, *rw_vb, *rw_gb; float *rw_QT, *rw_Y0; float* Wr; bf16_t *Lwa, *Lg;
};

__device__ __forceinline__ float bf2f(bf16_t b) { return __uint_as_float(((unsigned)b) << 16); }
__device__ __forceinline__ bf16_t f2bf(float f) { unsigned u = __float_as_uint(f); u += 0x7FFFu + ((u >> 16) & 1u); return (bf16_t)(u >> 16); }
__device__ __forceinline__ float sigmoidf_(float x) { return 1.0f / (1.0f + __expf(-x)); }
template <int CTRL, int RMASK> __device__ __forceinline__ float dpp_f(float old, float v) { return __int_as_float(__builtin_amdgcn_update_dpp(__float_as_int(old), __float_as_int(v), CTRL, RMASK, 0xF, false)); }
__device__ __forceinline__ float wave_sum(float v) {
    v += dpp_f<0xB1, 0xF>(0.f, v);
    v += dpp_f<0x4E, 0xF>(0.f, v);
    v += dpp_f<0x141, 0xF>(0.f, v);
    v += dpp_f<0x140, 0xF>(0.f, v);
    v += dpp_f<0x142, 0xA>(0.f, v);
    v += dpp_f<0x143, 0xC>(0.f, v);
    return __int_as_float(__builtin_amdgcn_readlane(__float_as_int(v), 63));
}
__device__ __forceinline__ float wave_max(float v) {
    v = fmaxf(v, dpp_f<0xB1, 0xF>(v, v));
    v = fmaxf(v, dpp_f<0x4E, 0xF>(v, v));
    v = fmaxf(v, dpp_f<0x141, 0xF>(v, v));
    v = fmaxf(v, dpp_f<0x140, 0xF>(v, v));
    v = fmaxf(v, dpp_f<0x142, 0xA>(v, v));
    v = fmaxf(v, dpp_f<0x143, 0xC>(v, v));
    return __int_as_float(__builtin_amdgcn_readlane(__float_as_int(v), 63));
}
__device__ __forceinline__ float bperm_f(int srclane, float v) { return __int_as_float(__builtin_amdgcn_ds_bpermute(srclane << 2, __float_as_int(v))); }
__device__ __forceinline__ int bperm_i(int srclane, int v) { return __builtin_amdgcn_ds_bpermute(srclane << 2, v); }
__device__ __forceinline__ int otid() { int t = threadIdx.x; asm volatile("" : "+v"(t)); return t; }
__device__ __forceinline__ void lds_barrier() { asm volatile("s_waitcnt lgkmcnt(0)" ::: "memory"); __builtin_amdgcn_s_barrier(); asm volatile("" ::: "memory"); }
__device__ __forceinline__ float bfl(unsigned u) { return __uint_as_float(u << 16); }
__device__ __forceinline__ float bfh(unsigned u) { return __uint_as_float(u & 0xffff0000u); }
__device__ __forceinline__ const float* in_row(const Params& p, int g) { const int b = g / TT, s = g - b * TT; return s < LC ? p.ctx + (size_t)(b * LC + s) * D : p.x + (size_t)(b * L + (s - LC)) * D; }
__device__ __forceinline__ int modrow(int g) { const int b = g / TT, s = g - b * TT; return s < LC ? 4 : b; }

#define XB_TMO      128
#define XB_XCNT(j)  (256  + 64 * (j))
#define XB_XSUB(j)  (1280 + 64 * (j))
#define XB_XGEN(j)  (2304 + 64 * (j))
#define XB_TOP      3328
#define XB_TOPGEN   3392
#define XCD_BAR_WORDS 3456
#define XB_SPIN_CAP (1u << 22)
#define LAS __attribute__((address_space(3)))

__device__ __forceinline__ unsigned xb_ld(unsigned* p)              { return __hip_atomic_load(p, __ATOMIC_RELAXED, __HIP_MEMORY_SCOPE_AGENT); }
__device__ __forceinline__ unsigned xb_add(unsigned* p, unsigned v) { return __hip_atomic_fetch_add(p, v, __ATOMIC_RELAXED, __HIP_MEMORY_SCOPE_AGENT); }
__device__ __forceinline__ unsigned xb_xcc_id() { return (unsigned)__builtin_amdgcn_s_getreg((3 << 11) | 20) & 0xFu; }
#define XB_SPIN(cond, bar) do { unsigned _sp = 0; while (cond) { __builtin_amdgcn_s_sleep(1); \
    if ((++_sp & 255u) == 0u) { if (xb_ld(&(bar)[XB_TMO])) break; if (_sp > XB_SPIN_CAP) { atomicAdd(&(bar)[XB_TMO], 1u); break; } } } } while (0)

struct XcdBarrier {
    unsigned* bar; unsigned x;
    volatile LAS unsigned* st;
};

__device__ __forceinline__ XcdBarrier xcd_barrier_post(unsigned* bar, volatile LAS unsigned* st) {
    XcdBarrier b; b.bar = bar; b.x = xb_xcc_id(); b.st = st;
    if (threadIdx.x == 0) (void)xb_add(&bar[XB_XCNT(b.x)], 1u);
    return b;
}
__device__ __forceinline__ void xcd_barrier_complete(unsigned* bar, unsigned x, unsigned& nloc, unsigned& nx) {
    const unsigned G = gridDim.x * gridDim.y * gridDim.z;
    unsigned sum, cnt, mine, sp = 0u;
    for (;;) {
        sum = 0u; cnt = 0u; mine = 0u;
#pragma unroll
        for (unsigned j = 0; j < 16; ++j) { const unsigned c = xb_ld(&bar[XB_XCNT(j)]); sum += c; cnt += (c > 0u) ? 1u : 0u; mine = (j == x) ? c : mine; }
        if (sum == G) break;
        __builtin_amdgcn_s_sleep(1);
        if ((++sp & 255u) == 0u) { if (xb_ld(&bar[XB_TMO])) break; if (sp > XB_SPIN_CAP) { atomicAdd(&bar[XB_TMO], 1u); break; } }
    }
    nloc = mine > 0u ? mine : 1u; nx = cnt > 0u ? cnt : 1u;
}

__device__ __forceinline__ void xcd_barrier(const XcdBarrier& b) {
    asm volatile("s_waitcnt vmcnt(0)" ::: "memory");
    __syncthreads();
    if (threadIdx.x == 0) {
        unsigned* bar = b.bar; const unsigned bx = xb_xcc_id();
        __builtin_amdgcn_s_waitcnt(0);
        unsigned nloc = b.st[0], nx = b.st[1];
        if (nloc == 0u) { xcd_barrier_complete(bar, bx, nloc, nx); b.st[0] = nloc; b.st[1] = nx; }
        const unsigned old = xb_add(&bar[XB_XSUB(bx)], 1u);
        const unsigned gen = old / nloc;
        if (old + 1u == (gen + 1u) * nloc) {
            __builtin_amdgcn_fence(__ATOMIC_RELEASE, "agent");
            asm volatile("s_waitcnt vmcnt(0)" ::: "memory");
            const unsigned og = xb_add(&bar[XB_TOP], 1u);
            const unsigned tg = og / nx;
            if (og + 1u == (tg + 1u) * nx) xb_add(&bar[XB_TOPGEN], 1u);
            else XB_SPIN(xb_ld(&bar[XB_TOPGEN]) == tg, bar);
            __builtin_amdgcn_fence(__ATOMIC_ACQUIRE, "agent");
            xb_add(&bar[XB_XGEN(bx)], 1u);
            asm volatile("s_waitcnt vmcnt(0)" ::: "memory");
        } else {
            XB_SPIN(xb_ld(&bar[XB_XGEN(bx)]) == gen, bar);
            __builtin_amdgcn_fence(__ATOMIC_ACQUIRE, "agent");
            asm volatile("s_waitcnt vmcnt(0)" ::: "memory");
        }
    }
    __syncthreads();
}


__device__ __forceinline__ void phase_copy(const Params& p, int bid, int nb) {
    const int tix = otid();
    if (bid == 0) for (int i = tix; i < D; i += NT) p.h[(size_t)M * D + i] = 0;
}

__device__ __forceinline__ void phase_router_w(const Params& p, int bid, int nb) {
    const int tix = otid();
    for (int i = bid * NT + tix; i < 2 * D * NEXP; i += nb * NT) {
        const int c = i & 3, n = (i >> 2) & 15, q = (i >> 6) & 3, nt = (i >> 8) & 3, j = (i >> 10) & 127, l = i >> 17;
        p.Wr[i] = p.router_w[((size_t)l * D + 16 * j + 4 * q + c) * NEXP + 16 * nt + n];
    }
}
__device__ __forceinline__ void phase_lora_w(const Params& p, int bid, int nb) {
    const int tix = otid();
    for (int i = bid * NT + tix; i < 2 * 2 * 12 * 2 * 64 * 72; i += nb * NT) {
        const int r = i % 72, c = (i / 72) & 63, which = (i / (72 * 64)) & 1, hh = (i / (72 * 64 * 2)) % 12, n = (i / (72 * 64 * 2 * 12)) & 1, l = i / (72 * 64 * 2 * 12 * 2);
        const float* src = (which == 0 ? p.rw_w_up : p.rw_a_up) + ((size_t)(l * 2 + n) * 48) * 768 + hh * 64 + c;
        p.Lwa[i] = r < 48 ? f2bf(src[(size_t)r * 768]) : (bf16_t)0;
    }
    for (int i = bid * NT + tix; i < 2 * 12 * 64 * 104; i += nb * NT) {
        const int r = i % 104, c = (i / 104) & 63, hh = (i / (104 * 64)) % 12, l = i / (104 * 64 * 12);
        p.Lg[i] = r < 96 ? f2bf(p.rw_g_up[((size_t)l * 96 + r) * 768 + hh * 64 + c]) : (bf16_t)0;
    }
}
__device__ __forceinline__ void phase_adaln(const Params& p, float* lds, int bid, int nb) {
    const int tix = otid();
    float* cond = lds;
    float* red = lds + 5 * D;
    for (int i = tix; i < 5 * D; i += NT) { const int r = i / D, d = i % D; const float v = r < 4 ? p.c[r * D + d] : p.c_ctx[d]; cond[i] = v * sigmoidf_(v); }
    __syncthreads();
    const int tid = tix, cg = tid & 15, ks = tid >> 4, wid = tid >> 6, lane = tid & 63;
    const int nitems = 2 * (6 * D / 64);
    for (int it = bid; it < nitems; it += nb) {
        const int l = it / (6 * D / 64), c0 = (it % (6 * D / 64)) * 64 + cg * 4;
        const float* W = p.ada_w + (size_t)l * D * 6 * D + c0;
        float4 acc[5];
#pragma unroll
        for (int r = 0; r < 5; ++r) acc[r] = make_float4(0.f, 0.f, 0.f, 0.f);
#pragma unroll 8
        for (int k = ks; k < D; k += 32) {
            const float4 w = *(const float4*)(W + (size_t)k * 6 * D);
#pragma unroll
            for (int r = 0; r < 5; ++r) { const float cv = cond[r * D + k]; acc[r].x += cv * w.x; acc[r].y += cv * w.y; acc[r].z += cv * w.z; acc[r].w += cv * w.w; }
        }
#pragma unroll
        for (int r = 0; r < 5; ++r) {
            acc[r].x += bperm_f(lane ^ 16, acc[r].x); acc[r].x += bperm_f(lane ^ 32, acc[r].x);
            acc[r].y += bperm_f(lane ^ 16, acc[r].y); acc[r].y += bperm_f(lane ^ 32, acc[r].y);
            acc[r].z += bperm_f(lane ^ 16, acc[r].z); acc[r].z += bperm_f(lane ^ 32, acc[r].z);
            acc[r].w += bperm_f(lane ^ 16, acc[r].w); acc[r].w += bperm_f(lane ^ 32, acc[r].w);
        }
        __syncthreads();
        if (lane < 16) {
#pragma unroll
            for (int r = 0; r < 5; ++r) { float* q = red + ((wid * 16 + lane) * 20 + r * 4); q[0] = acc[r].x; q[1] = acc[r].y; q[2] = acc[r].z; q[3] = acc[r].w; }
        }
        __syncthreads();
        if (tid < 16 * 20) {
            const int cgi = tid / 20, rj = tid % 20, r = rj / 4, j = rj % 4;
            float s = 0.f;
#pragma unroll
            for (int w = 0; w < 8; ++w) s += red[(w * 16 + cgi) * 20 + rj];
            const int col = (it % (6 * D / 64)) * 64 + cgi * 4 + j;
            p.mod[(size_t)(l * 5 + r) * 6 * D + col] = s + p.ada_b[(size_t)l * 6 * D + col];
        }
    }
}

__device__ __forceinline__ void moe_tables(const Params& p, LAS int* tab, int lc);

__device__ __forceinline__ void moe_combine_row(const Params& p, const LAS int* tab, int lm  , int g, int lane, float4 (&v)[8]) {
    int slot[TOPK + 1]; float w[TOPK + 1];
#pragma unroll
    for (int k = 0; k < TOPK; ++k) { const int e = p.sel[g * TOPK + k]; slot[k] = tab[66 + e] + p.tpos[g * TOPK + k]; w[k] = p.selw[g * TOPK + k]; }
    slot[TOPK] = tab[66 + NEXP] + g; w[TOPK] = 1.0f;
    const float* gt = p.mod + (size_t)(lm * 5 + modrow(g)) * 6 * D + 5 * D;
#pragma unroll
    for (int i = 0; i < 8; ++i) {
        const int d = (i * 64 + lane) * 4; float a0 = 0.f, a1 = 0.f, a2 = 0.f, a3 = 0.f;
#pragma unroll
        for (int k = 0; k <= TOPK; ++k) { const uint2 y = *(const uint2*)(p.Y + (size_t)slot[k] * D + d);
            a0 += w[k] * __uint_as_float(y.x << 16); a1 += w[k] * __uint_as_float(y.x & 0xffff0000u); a2 += w[k] * __uint_as_float(y.y << 16); a3 += w[k] * __uint_as_float(y.y & 0xffff0000u); }
        const float4 g4 = *(const float4*)(gt + d);
        v[i].x += g4.x * a0; v[i].y += g4.y * a1; v[i].z += g4.z * a2; v[i].w += g4.w * a3;
    }
}

template <int WHICH>
__device__ __forceinline__ void phase_norm(const Params& p, float* lds, LAS int* tab, int l, int bid, int nb) {
    const bool comb = (WHICH == 0 && l > 0);
    if (comb) moe_tables(p, tab, l - 1);
    const int tix = otid();
    const int wid = tix >> 6, lane = tix & 63;
    const float* gam = (WHICH == 0 ? p.norm1_g : p.norm2_g) + (size_t)l * D;
    float* frow = lds + wid * D;
    for (int g = bid * 8 + wid; g < M; g += nb * 8) {
        const float* xr = (WHICH == 0 && l == 0) ? in_row(p, g) : p.xcur + (size_t)g * D;
        float4 v[8]; float ss = 0.f;
#pragma unroll
        for (int i = 0; i < 8; ++i) v[i] = *(const float4*)(xr + (i * 64 + lane) * 4);
        if (comb) { moe_combine_row(p, tab, l - 1, g, lane, v);
#pragma unroll
            for (int i = 0; i < 8; ++i) *(float4*)(p.xcur + (size_t)g * D + (i * 64 + lane) * 4) = v[i]; }
#pragma unroll
        for (int i = 0; i < 8; ++i) ss += v[i].x * v[i].x + v[i].y * v[i].y + v[i].z * v[i].z + v[i].w * v[i].w;
        ss = wave_sum(ss);
        const float rs = rsqrtf(ss * (1.0f / D) + 1e-6f);
        const float* mrow = p.mod + (size_t)(l * 5 + modrow(g)) * 6 * D;
        const float* sh = mrow + (WHICH == 0 ? 0 : 3) * D; const float* sc = mrow + (WHICH == 0 ? 1 : 4) * D;
#pragma unroll
        for (int i = 0; i < 8; ++i) {
            const int d = (i * 64 + lane) * 4;
            const float4 gg = *(const float4*)(gam + d), s4 = *(const float4*)(sh + d), c4 = *(const float4*)(sc + d);
            float4 o;
            o.x = v[i].x * rs * gg.x * (1.0f + c4.x) + s4.x; o.y = v[i].y * rs * gg.y * (1.0f + c4.y) + s4.y;
            o.z = v[i].z * rs * gg.z * (1.0f + c4.z) + s4.z; o.w = v[i].w * rs * gg.w * (1.0f + c4.w) + s4.w;
            uint2 pk; pk.x = (unsigned)f2bf(o.x) | ((unsigned)f2bf(o.y) << 16); pk.y = (unsigned)f2bf(o.z) | ((unsigned)f2bf(o.w) << 16);
            *(uint2*)(p.h + (size_t)g * D + d) = pk;
            if (WHICH == 1) *(float4*)(frow + d) = o;
        }
        if (WHICH == 1) {
            const float* rw = p.router_w + (size_t)l * D * NEXP + lane;
            float a0 = 0.f, a1 = 0.f, a2 = 0.f, a3 = 0.f;
            for (int k = 0; k < D; k += 4) {
                const float4 f = *(const float4*)(frow + k);
                a0 += f.x * rw[(size_t)(k + 0) * NEXP]; a1 += f.y * rw[(size_t)(k + 1) * NEXP]; a2 += f.z * rw[(size_t)(k + 2) * NEXP]; a3 += f.w * rw[(size_t)(k + 3) * NEXP];
            }
            const float score = 1.0f / (1.0f + expf(-((a0 + a1) + (a2 + a3))));
            float val = score + p.router_bias[l * NEXP + lane];
            int myidx[TOPK]; float mysc[TOPK]; float tot = 0.f;
#pragma unroll
            for (int k = 0; k < TOPK; ++k) {
                float bv = val; int bi = lane;
#pragma unroll
                for (int o = 32; o >= 1; o >>= 1) { const float ov = bperm_f(lane ^ o, bv); const int oi = bperm_i(lane ^ o, bi); if (ov > bv || (ov == bv && oi < bi)) { bv = ov; bi = oi; } }
                const float sc_k = bperm_f(bi, score);
                myidx[k] = bi; mysc[k] = sc_k; tot += sc_k;
                if (lane == bi) val = -INFINITY;
            }
            if (lane == 0) {
#pragma unroll
                for (int k = 0; k < TOPK; ++k) { p.sel[g * TOPK + k] = myidx[k]; p.selw[g * TOPK + k] = mysc[k] / tot * 2.5f; }
            }
        }
    }
}


namespace pg8 {
typedef short bf16x8 __attribute__((ext_vector_type(8)));
typedef float f32x4 __attribute__((ext_vector_type(4)));
typedef unsigned u32x4 __attribute__((ext_vector_type(4)));
constexpr int BM = 256, BK = 64, HALF = 128, HTB = HALF * BK * 2  , STAGE_BYTES = 8 * HTB, NXCD = 8, WGM = 8;
__device__ __forceinline__ int lds_byte(int r, int c) { const int st = (r >> 4) * 2 + (c >> 5), rr = r & 15, cc = c & 31, ob = rr * 64 + cc * 2; return st * 1024 + (ob ^ (((ob >> 9) & 1) << 5)); }
__device__ __forceinline__ void stage_rc(int b, int& R, int& C) { const int st = b / 1024, sb = b % 1024, swz = sb ^ (((sb >> 9) & 1) << 5); R = (st >> 1) * 16 + swz / 64; C = (st & 1) * 32 + (swz % 64) / 2; }
__device__ __forceinline__ int perm32(int rho) { const int n = rho >> 4, i = rho & 15; return 8 * (i >> 2) + 4 * n + (i & 3); }
typedef float cvt_f32x2 __attribute__((ext_vector_type(2)));
typedef __bf16 cvt_bf16x2 __attribute__((ext_vector_type(2)));
__device__ __forceinline__ unsigned cvt_pk_bf16(float lo, float hi) { const cvt_f32x2 v = {lo, hi}; const cvt_bf16x2 b = __builtin_convertvector(v, cvt_bf16x2); return __builtin_bit_cast(unsigned, b); }
struct Unit { int pm, pn, e, ord; };
template <bool PERM, class Sched, class Epi>
__device__ __forceinline__ void gemm_phase(LAS unsigned char* lds, const char* Abase, const int K, const Sched& S, const Epi& E) {
    const int tid = otid(), wid = __builtin_amdgcn_readfirstlane(tid >> 6), lane = tid & 63, wr = wid >> 2, wc = wid & 3, fr = lane & 15, fq = lane >> 4;
    const int nt = K / BK;
    unsigned voffB[2];
#pragma unroll
    for (int i = 0; i < 2; ++i) { int R, C; stage_rc(tid * 16 + i * 8192, R, C); const int Rb = PERM ? ((R & ~31) + perm32(R & 31)) : R; voffB[i] = (unsigned)(Rb * K + C) * 2u; }
    const size_t kstep = (size_t)(BK * 2);
    const size_t hstep = (size_t)HALF * K * 2;
    const unsigned ldsw = (unsigned)wid * 1024u;
    const int aoff = lds_byte(wr * 64 + fr, fq * 8), boff = lds_byte(wc * 32 + fr, fq * 8);
#define PG8_SA(b, h) (((b) * 2 + (h)) * HTB)
#define PG8_SB(b, h) ((4 + (b) * 2 + (h)) * HTB)
#define PG8_STAGE(bufoff, gbase, voff) do { _Pragma("unroll") for (int _i = 0; _i < 2; ++_i) \
        __builtin_amdgcn_global_load_lds((const unsigned*)((const char*)(gbase) + (voff)[_i]), (LAS unsigned*)(lds + (bufoff) + ldsw + _i * 8192), 16, 0, 0); } while (0)
#define PG8_LDA(dst, b, h) do { _Pragma("unroll") for (int m = 0; m < 4; ++m) _Pragma("unroll") for (int k = 0; k < 2; ++k) dst[m][k] = *(const LAS bf16x8*)(lds + PG8_SA(b, h) + aoff + m * 2048 + k * 1024); } while (0)
#define PG8_LDB(dst, b, h) do { _Pragma("unroll") for (int n = 0; n < 2; ++n) _Pragma("unroll") for (int k = 0; k < 2; ++k) dst[n][k] = *(const LAS bf16x8*)(lds + PG8_SB(b, h) + boff + n * 2048 + k * 1024); } while (0)
#define PG8_MMA(ai, bj, At, Bt) do { __builtin_amdgcn_s_setprio(1); _Pragma("unroll") for (int m = 0; m < 4; ++m) _Pragma("unroll") for (int n = 0; n < 2; ++n) _Pragma("unroll") for (int k = 0; k < 2; ++k) \
        acc[ai][bj][m][n] = __builtin_amdgcn_mfma_f32_16x16x32_bf16(Bt[n][k], At[m][k], acc[ai][bj][m][n], 0, 0, 0); __builtin_amdgcn_s_setprio(0); } while (0)
#define PG8_WAIT_V(n) asm volatile("s_waitcnt vmcnt(" #n ")" ::: "memory")
#define PG8_WAIT_L(n) asm volatile("s_waitcnt lgkmcnt(" #n ")" ::: "memory")
#define PG8_BAR __builtin_amdgcn_s_barrier()
#define PG8_SCHED __builtin_amdgcn_sched_barrier(0)
#define PG8_ROWS(u, v) do { const int _t = otid(); _Pragma("unroll") for (int _i = 0; _i < 2; ++_i) { int _R, _C; stage_rc(_t * 16 + _i * 8192, _R, _C); \
        _Pragma("unroll") for (int _h = 0; _h < 2; ++_h) v[_h][_i] = S.arow(u, _h * HALF + _R) + (unsigned)(_C * 2); } } while (0)
    Unit cur, nxt; int ui = 0;
    if (!S.next(0, cur)) return;
    f32x4 acc[2][2][4][2];
#pragma unroll
    for (int a = 0; a < 2; ++a)
#pragma unroll
        for (int b = 0; b < 2; ++b)
#pragma unroll
            for (int m = 0; m < 4; ++m)
#pragma unroll
                for (int n = 0; n < 2; ++n) acc[a][b][m][n] = (f32x4){0.f, 0.f, 0.f, 0.f};
    bf16x8 At[4][2], B0[2][2], B1[2][2];
    unsigned va[2][2];
    PG8_ROWS(cur, va);
    const char* cB = S.bptr(cur);
    PG8_STAGE(PG8_SB(0, 0), cB, voffB); PG8_STAGE(PG8_SA(0, 0), Abase, va[0]); PG8_STAGE(PG8_SB(0, 1), cB + hstep, voffB); PG8_STAGE(PG8_SA(0, 1), Abase, va[1]);
    if (wr == 1) PG8_BAR;
    PG8_WAIT_V(4); PG8_BAR;
    PG8_STAGE(PG8_SB(1, 0), cB + kstep, voffB); PG8_STAGE(PG8_SA(1, 0), Abase + kstep, va[0]); PG8_STAGE(PG8_SB(1, 1), cB + hstep + kstep, voffB);
    PG8_WAIT_V(6); PG8_BAR;
    for (;;) {
        const bool has_next = S.next(ui + 1, nxt);
        const char* nB = has_next ? S.bptr(nxt) : cB;
        for (int t = 0; t < nt; t += 2) {
            const bool last = (t == nt - 2);
            const char* a1 = Abase + (size_t)(t + 1) * kstep;
            const char* a2 = last ? Abase : Abase + (size_t)(t + 2) * kstep; const char* b2 = last ? nB : cB + (size_t)(t + 2) * kstep;
            const char* a3 = a2 + kstep; const char* b3 = b2 + kstep;
            PG8_LDB(B0, 0, 0); PG8_SCHED; PG8_LDA(At, 0, 0); PG8_STAGE(PG8_SA(1, 1), a1, va[1]);
            PG8_WAIT_L(8); PG8_BAR; PG8_WAIT_L(0); PG8_MMA(0, 0, At, B0); PG8_BAR; PG8_SCHED;
            if (last && has_next) { PG8_ROWS(nxt, va); }
            PG8_LDB(B1, 0, 1); PG8_STAGE(PG8_SB(0, 0), b2, voffB);
            PG8_BAR; PG8_WAIT_L(0); PG8_MMA(0, 1, At, B1); PG8_BAR;
            PG8_LDA(At, 0, 1); PG8_STAGE(PG8_SA(0, 0), a2, va[0]);
            PG8_BAR; PG8_WAIT_L(0); PG8_MMA(1, 0, At, B0); PG8_BAR; PG8_SCHED;
            PG8_STAGE(PG8_SB(0, 1), b2 + hstep, voffB);
            PG8_WAIT_V(6); PG8_BAR; PG8_MMA(1, 1, At, B1); PG8_BAR;
            PG8_LDB(B0, 1, 0); PG8_SCHED; PG8_LDA(At, 1, 0); PG8_STAGE(PG8_SA(0, 1), a2, va[1]);
            PG8_WAIT_L(8); PG8_BAR; PG8_WAIT_L(0); PG8_MMA(0, 0, At, B0); PG8_BAR; PG8_SCHED;
            PG8_LDB(B1, 1, 1); PG8_STAGE(PG8_SB(1, 0), b3, voffB);
            PG8_BAR; PG8_WAIT_L(0); PG8_MMA(0, 1, At, B1); PG8_BAR;
            PG8_LDA(At, 1, 1); PG8_STAGE(PG8_SA(1, 0), a3, va[0]);
            PG8_BAR; PG8_WAIT_L(0); PG8_MMA(1, 0, At, B0); PG8_BAR; PG8_SCHED;
            PG8_STAGE(PG8_SB(1, 1), b3 + hstep, voffB);
            PG8_WAIT_V(6); PG8_BAR; PG8_MMA(1, 1, At, B1); PG8_BAR;
        }
        E(acc, cur, wr, wc, fr, fq);
        if (!has_next) break;
#pragma unroll
        for (int a = 0; a < 2; ++a)
#pragma unroll
            for (int b = 0; b < 2; ++b)
#pragma unroll
                for (int m = 0; m < 4; ++m)
#pragma unroll
                    for (int n = 0; n < 2; ++n) acc[a][b][m][n] = (f32x4){0.f, 0.f, 0.f, 0.f};
        cur = nxt; cB = nB; ++ui;
    }
    PG8_WAIT_V(0);
    if (wr == 0) PG8_BAR;
    PG8_BAR;
#undef PG8_SA
#undef PG8_SB
#undef PG8_STAGE
#undef PG8_LDA
#undef PG8_LDB
#undef PG8_MMA
#undef PG8_WAIT_V
#undef PG8_WAIT_L
#undef PG8_BAR
#undef PG8_SCHED
#undef PG8_ROWS
}
struct DenseSched {
    int nM, nN, nwg, G, c; const char* Bt; unsigned rowbytes; int skipctx;
    __device__ __forceinline__ bool next(int i, Unit& u) const {
        const long L = (long)i * G + c; if (L >= nwg) return false;
        int wgid = (int)L; { const int q = nwg / NXCD, r = nwg % NXCD, xcd = wgid % NXCD, off = wgid / NXCD; wgid = (xcd < r ? xcd * (q + 1) : r * (q + 1) + (xcd - r) * q) + off; }
        const int nig = WGM * nN, gid = wgid / nig, fm = gid * WGM, gsz = (nM - fm) < WGM ? (nM - fm) : WGM;
        u.pm = fm + ((wgid % nig) % gsz); u.pn = (wgid % nig) / gsz; u.e = 0; u.ord = i; if (skipctx) u.pm = (u.pm >> 4) * 17 + 1 + (u.pm & 15); return true;
    }
    __device__ __forceinline__ unsigned arow(const Unit& u, int r) const { return (unsigned)(u.pm * BM + r) * rowbytes; }
    __device__ __forceinline__ const char* bptr(const Unit& u) const { return Bt + (size_t)u.pn * BM * rowbytes; }
};
}

struct CvTile { const float* src; bf16_t* dst; int ldn, nvalid, k0, n0, K, split; };
constexpr int CV_IN = 32 * 26, CV_OUT = 32 * 8, CV_PER_E = 32 * 2 + 32 * 2 + 8 * 8, CV_TOTAL = CV_IN + CV_OUT + 65 * CV_PER_E;
__device__ __forceinline__ CvTile cv_desc(const Params& p, int l, int it) {
    const int r1 = it - CV_IN, r2 = r1 - CV_OUT;
    const bool is_in = it < CV_IN, is_out = !is_in && r1 < CV_OUT;
    const int e = r2 >= 0 ? r2 / CV_PER_E : 0, re = r2 >= 0 ? r2 % CV_PER_E : 0;
    const bool is_gu = !is_in && !is_out && re < 128, up = re >= 64, is_dn = !is_in && !is_out && !is_gu;
    const int rg = re & 63, rd = re - 128;
    const float* sgu = e < NEXP ? (up ? p.exp_up : p.exp_gate) + ((size_t)l * NEXP + e) * D * DE : (up ? p.sh_up : p.sh_gate) + (size_t)l * D * DE;
    const float* sdn = e < NEXP ? p.exp_down + ((size_t)l * NEXP + e) * DE * D : p.sh_down + (size_t)l * DE * D;
    CvTile t;
    t.src = is_in ? p.w_in + (size_t)l * D * IN_COLS : (is_out ? p.w_out + (size_t)l * D * D : (is_gu ? sgu : sdn));
    t.dst = is_in ? p.WinT : (is_out ? p.WoutT : (is_gu ? p.WguT + (size_t)e * 1024 * D : p.WdnT + (size_t)e * D * DE));
    t.ldn = is_in ? IN_COLS : (is_gu ? DE : D); t.nvalid = t.ldn;
    t.k0 = (is_in ? it / 26 : (is_out ? r1 / 8 : (is_gu ? rg / 2 : rd / 8))) * 64;
    t.n0 = (is_in ? it % 26 : (is_out ? r1 % 8 : (is_gu ? rg % 2 : rd % 8))) * 256;
    t.K = is_dn ? DE : D; t.split = is_gu ? (up ? 2 : 1) : 0;
    return t;
}
__device__ __forceinline__ void cv_load(const CvTile& t, int tid, pg8::f32x4 (&v)[8]) {
    const int kp = tid >> 6, c4 = (tid & 63) * 4;
#pragma unroll
    for (int j = 0; j < 8; ++j) v[j] = (t.n0 + c4 < t.nvalid) ? *(const pg8::f32x4*)(t.src + (size_t)(t.k0 + 8 * kp + j) * t.ldn + t.n0 + c4) : (pg8::f32x4){0.f, 0.f, 0.f, 0.f};
}
__device__ __forceinline__ void cv_store(const CvTile& t, int tid, bf16_t* T  , const pg8::f32x4 (&v)[8]) {
    const int kp = tid >> 6, c4 = (tid & 63) * 4;
    uint4 o;
    o.x = pg8::cvt_pk_bf16(v[0][0], v[1][0]); o.y = pg8::cvt_pk_bf16(v[2][0], v[3][0]); o.z = pg8::cvt_pk_bf16(v[4][0], v[5][0]); o.w = pg8::cvt_pk_bf16(v[6][0], v[7][0]); *(uint4*)(T + (c4 + 0) * 72 + 8 * kp) = o;
    o.x = pg8::cvt_pk_bf16(v[0][1], v[1][1]); o.y = pg8::cvt_pk_bf16(v[2][1], v[3][1]); o.z = pg8::cvt_pk_bf16(v[4][1], v[5][1]); o.w = pg8::cvt_pk_bf16(v[6][1], v[7][1]); *(uint4*)(T + (c4 + 1) * 72 + 8 * kp) = o;
    o.x = pg8::cvt_pk_bf16(v[0][2], v[1][2]); o.y = pg8::cvt_pk_bf16(v[2][2], v[3][2]); o.z = pg8::cvt_pk_bf16(v[4][2], v[5][2]); o.w = pg8::cvt_pk_bf16(v[6][2], v[7][2]); *(uint4*)(T + (c4 + 2) * 72 + 8 * kp) = o;
    o.x = pg8::cvt_pk_bf16(v[0][3], v[1][3]); o.y = pg8::cvt_pk_bf16(v[2][3], v[3][3]); o.z = pg8::cvt_pk_bf16(v[4][3], v[5][3]); o.w = pg8::cvt_pk_bf16(v[6][3], v[7][3]); *(uint4*)(T + (c4 + 3) * 72 + 8 * kp) = o;
    lds_barrier();
#pragma unroll
    for (int j = 0; j < 4; ++j) {
        const int q = tid + 512 * j, nl = q >> 3, kc = q & 7, n = t.n0 + nl;
        const size_t drow = t.split == 0 ? (size_t)n : (size_t)((n >> 7) * 256 + (t.split == 2 ? 128 : 0) + (n & 127));
        *(uint4*)(t.dst + drow * t.K + t.k0 + kc * 8) = *(const uint4*)(T + nl * 72 + kc * 8);
    }
}
__device__ __forceinline__ void phase_convert(const Params& p, float* lds, int l, int bid, int nb) {
    const int tid = otid();
    bf16_t* T0 = (bf16_t*)lds; bf16_t* T1 = T0 + 256 * 72;
    pg8::f32x4 va[8], vb[8];
    __syncthreads();
    int it = bid;
    if (it < CV_TOTAL) cv_load(cv_desc(p, l, it), tid, va);
    for (; it < CV_TOTAL; it += 2 * nb) {
        const bool has1 = it + nb < CV_TOTAL, has2 = it + 2 * nb < CV_TOTAL;
        if (has1) cv_load(cv_desc(p, l, it + nb), tid, vb);
        cv_store(cv_desc(p, l, it), tid, T0, va);
        if (has2) cv_load(cv_desc(p, l, it + 2 * nb), tid, va);
        if (has1) cv_store(cv_desc(p, l, it + nb), tid, T1, vb);
    }
    __syncthreads();
}

struct EpiZ {
    bf16_t* z;
    __device__ __forceinline__ void operator()(const pg8::f32x4 (&acc)[2][2][4][2], const pg8::Unit& u, int wr, int wc, int fr, int fq) const {
        const int row0 = u.pm * 256 + wr * 64 + fr, col0 = u.pn * 256 + wc * 32 + 8 * fq;
#pragma unroll
        for (int ai = 0; ai < 2; ++ai)
#pragma unroll
            for (int m = 0; m < 4; ++m) { bf16_t* rowp = z + (size_t)(row0 + ai * 128 + m * 16) * ZLD + col0;
#pragma unroll
                for (int bj = 0; bj < 2; ++bj) { const pg8::f32x4 v0 = acc[ai][bj][m][0], v1 = acc[ai][bj][m][1];
                    pg8::u32x4 w; w.x = pg8::cvt_pk_bf16(v0[0], v0[1]); w.y = pg8::cvt_pk_bf16(v0[2], v0[3]); w.z = pg8::cvt_pk_bf16(v1[0], v1[1]); w.w = pg8::cvt_pk_bf16(v1[2], v1[3]);
                    *(pg8::u32x4*)(rowp + bj * 128) = w; } }
    }
};
struct EpiOut {
    float* xcur; const float* mod; int l; const float* xin; const float* cin;
    __device__ __forceinline__ void operator()(const pg8::f32x4 (&acc)[2][2][4][2], const pg8::Unit& u, int wr, int wc, int fr, int fq) const {
        const int row0 = u.pm * 256 + wr * 64 + fr, col0 = u.pn * 256 + wc * 32 + 4 * fq;
#pragma unroll
        for (int ai = 0; ai < 2; ++ai)
#pragma unroll
            for (int m = 0; m < 4; ++m) { const int g = row0 + ai * 128 + m * 16; float* xr = xcur + (size_t)g * D + col0; const float* gt = mod + (size_t)(l * 5 + modrow(g)) * 6 * D + 2 * D + col0;
                const int gb = g / TT, gs = g - gb * TT; const float* xs = l != 0 ? xr : (gs < LC ? cin + (size_t)(gb * LC + gs) * D : xin + (size_t)(gb * L + (gs - LC)) * D) + col0;
#pragma unroll
                for (int bj = 0; bj < 2; ++bj)
#pragma unroll
                    for (int n = 0; n < 2; ++n) { const int co = bj * 128 + n * 16; pg8::f32x4 x4 = *(const pg8::f32x4*)(xs + co); const pg8::f32x4 g4 = *(const pg8::f32x4*)(gt + co); x4 += g4 * acc[ai][bj][m][n]; *(pg8::f32x4*)(xr + co) = x4; } }
    }
};
__device__ __forceinline__ void phase_gemm_in(const Params& p, LAS unsigned char* stage, int bid, int nb) {
    pg8::DenseSched S; S.nM = M / 256; S.nN = ZLD / 256; S.nwg = S.nM * S.nN; S.G = nb; S.c = bid; S.Bt = (const char*)p.WinT; S.rowbytes = D * 2; S.skipctx = 0;
    EpiZ E; E.z = p.z;
    pg8::gemm_phase<true>(stage, (const char*)p.h, D, S, E);
}
__device__ __forceinline__ void phase_gemm_out(const Params& p, LAS unsigned char* stage, int l, int bid, int nb) {
    pg8::DenseSched S; S.skipctx = (l == 1); S.nM = S.skipctx ? NB * L / 256 : M / 256; S.nN = D / 256; S.nwg = S.nM * S.nN; S.G = nb; S.c = bid; S.Bt = (const char*)p.WoutT; S.rowbytes = D * 2;
    EpiOut E; E.xcur = p.xcur; E.mod = p.mod; E.l = l; E.xin = p.x; E.cin = p.ctx;
    pg8::gemm_phase<false>(stage, (const char*)p.mix, D, S, E);
}
__device__ __forceinline__ void phase_prep(const Params& p, float* lds, int l, int bid, int nb) {
    const int tix = otid();
    const int tid = tix;
    {
        float* cst = lds;
        __syncthreads();
        for (int i = tid; i < 1024; i += NT) { const int pos = i >> 4, f = i & 15; float sn, cs; sincosf((float)pos * expf(-(float)f * (9.210340371976184f / 16.0f)), &sn, &cs); cst[i] = cs; cst[1024 + i] = sn; }
        __syncthreads();
        const int lane = tid & 63, wid = tid >> 6;
        const int tl = lane >> 3, dv = lane & 7, axis = dv >> 2, half = (dv >> 1) & 1, f0 = 8 * (dv & 1);
        bf16_t* Tw = (bf16_t*)(lds + 2048) + wid * (64 * 72);
        for (int wt = bid * 8 + wid; wt < NB * 12 * (TT / 64); wt += nb * 8) {
            const int tile = wt % (TT / 64), bh = wt / (TT / 64), b = bh / 12, hh = bh % 12, s0 = tile * 64;
#pragma unroll 2
            for (int i = 0; i < 8; ++i) {
                const int s = s0 + 8 * i + tl; const bf16_t* zr = p.z + (size_t)(b * TT + s) * ZLD + ZB + hh * 64 + 8 * dv;
                const uint4 q8 = *(const uint4*)zr, k8 = *(const uint4*)(zr + 768), v8 = *(const uint4*)(zr + 1536);
                *(uint4*)(p.Qa + ((size_t)bh * TT + s) * 64 + 8 * dv) = q8;
                const unsigned vw[4] = {v8.x, v8.y, v8.z, v8.w};
#pragma unroll
                for (int e = 0; e < 4; ++e) { Tw[(8 * dv + 2 * e) * 72 + 8 * i + tl] = (bf16_t)(vw[e] & 0xffffu); Tw[(8 * dv + 2 * e + 1) * 72 + 8 * i + tl] = (bf16_t)(vw[e] >> 16); }
                uint4 ko = k8;
                if (s >= LC) {
                    const int t = s - LC, pos = axis == 0 ? (t >> 6) : (t & 63);
                    const unsigned qw[4] = {q8.x, q8.y, q8.z, q8.w}, kw[4] = {k8.x, k8.y, k8.z, k8.w};
                    unsigned qo[4], kq[4];
#pragma unroll
                    for (int e = 0; e < 4; ++e) {
                        const unsigned qpw = (unsigned)bperm_i(lane ^ 2, (int)qw[e]), kpw = (unsigned)bperm_i(lane ^ 2, (int)kw[e]);
                        const float c0 = cst[pos * 16 + f0 + 2 * e], s0f = cst[1024 + pos * 16 + f0 + 2 * e], c1 = cst[pos * 16 + f0 + 2 * e + 1], s1f = cst[1024 + pos * 16 + f0 + 2 * e + 1];
                        const float qa0 = bfl(qw[e]), qa1 = bfh(qw[e]), qb0 = bfl(qpw), qb1 = bfh(qpw), ka0 = bfl(kw[e]), ka1 = bfh(kw[e]), kb0 = bfl(kpw), kb1 = bfh(kpw);
                        const float sg = half == 0 ? -1.f : 1.f;
                        qo[e] = pg8::cvt_pk_bf16(qa0 * c0 + sg * qb0 * s0f, qa1 * c1 + sg * qb1 * s1f);
                        kq[e] = pg8::cvt_pk_bf16(ka0 * c0 + sg * kb0 * s0f, ka1 * c1 + sg * kb1 * s1f);
                    }
                    *(uint4*)(p.Qr + ((size_t)bh * L + t) * 64 + 8 * dv) = make_uint4(qo[0], qo[1], qo[2], qo[3]);
                    ko = make_uint4(kq[0], kq[1], kq[2], kq[3]);
                }
                *(uint4*)(p.Ka + ((((size_t)bh * (TT / 16) + (s >> 4)) * 2 + (dv >> 2)) * 16 + (s & 15)) * 32 + 8 * (dv & 3)) = ko;
            }
            __builtin_amdgcn_wave_barrier();
#pragma unroll 2
            for (int i = 0; i < 8; ++i) {
                const int item = i * 64 + lane, q4 = item & 3, d = (item >> 2) & 63, blk = item >> 8;
                const uint2 lo = *(const uint2*)(Tw + d * 72 + blk * 32 + 4 * q4), hi = *(const uint2*)(Tw + d * 72 + blk * 32 + 16 + 4 * q4);
                *(uint4*)(p.Vt + (((size_t)bh * (TT / 32) + tile * 2 + blk) * 64 + d) * 32 + 8 * q4) = make_uint4(lo.x, lo.y, hi.x, hi.y); }
            __builtin_amdgcn_wave_barrier();
        }
        __syncthreads();
    }
    const float* cw = p.conv_w + (size_t)l * 3 * 512;
    for (int i = bid * NT + tid; i < M * 64; i += nb * NT) {
        const int ch = (i & 63) * 8, g = i >> 6, s = g % TT;
        const bf16_t* zr = p.z + (size_t)g * ZLD + ch;
        const uint4 bg = *(const uint4*)zr, cg = *(const uint4*)(zr + 512), hv = *(const uint4*)(zr + 1024);
        uint4 cgp = make_uint4(0u, 0u, 0u, 0u), hp = cgp, cgn = cgp, hn = cgp;
        if (s != 0 && s != LC) { cgp = *(const uint4*)(zr + 512 - ZLD); hp = *(const uint4*)(zr + 1024 - ZLD); }
        if (s != LC - 1 && s != TT - 1) { cgn = *(const uint4*)(zr + 512 + ZLD); hn = *(const uint4*)(zr + 1024 + ZLD); }
        const float4 w0a = *(const float4*)(cw + ch), w0b = *(const float4*)(cw + ch + 4), w1a = *(const float4*)(cw + 512 + ch), w1b = *(const float4*)(cw + 512 + ch + 4), w2a = *(const float4*)(cw + 1024 + ch), w2b = *(const float4*)(cw + 1024 + ch + 4);
        const float w0[8] = {w0a.x, w0a.y, w0a.z, w0a.w, w0b.x, w0b.y, w0b.z, w0b.w}, w1[8] = {w1a.x, w1a.y, w1a.z, w1a.w, w1b.x, w1b.y, w1b.z, w1b.w}, w2[8] = {w2a.x, w2a.y, w2a.z, w2a.w, w2b.x, w2b.y, w2b.z, w2b.w};
        const unsigned bgw[4] = {bg.x, bg.y, bg.z, bg.w}, cgw[4] = {cg.x, cg.y, cg.z, cg.w}, hw[4] = {hv.x, hv.y, hv.z, hv.w}, cpw[4] = {cgp.x, cgp.y, cgp.z, cgp.w}, hpw[4] = {hp.x, hp.y, hp.z, hp.w}, cnw[4] = {cgn.x, cgn.y, cgn.z, cgn.w}, hnw[4] = {hn.x, hn.y, hn.z, hn.w};
        unsigned o[4];
#pragma unroll
        for (int e = 0; e < 4; ++e) {
            const float r0 = bfl(bgw[e]) * (w0[2 * e] * bfl(cpw[e]) * bfl(hpw[e]) + w1[2 * e] * bfl(cgw[e]) * bfl(hw[e]) + w2[2 * e] * bfl(cnw[e]) * bfl(hnw[e]));
            const float r1 = bfh(bgw[e]) * (w0[2 * e + 1] * bfh(cpw[e]) * bfh(hpw[e]) + w1[2 * e + 1] * bfh(cgw[e]) * bfh(hw[e]) + w2[2 * e + 1] * bfh(cnw[e]) * bfh(hnw[e]));
            o[e] = pg8::cvt_pk_bf16(r0, r1);
        }
        *(uint4*)(p.mix + (size_t)g * D + ch) = make_uint4(o[0], o[1], o[2], o[3]);
    }
}

typedef short rw_bf16x8 __attribute__((ext_vector_type(8)));
typedef float rw_f32x4 __attribute__((ext_vector_type(4)));
constexpr int RLD = 72, FLD = 68, GLD = 104;
constexpr int RW_UNITS = NB * 12 * (TT / 64) * 2;
template <int K> __device__ __forceinline__ void mm_t(rw_f32x4 (&acc)[2], const bf16_t* A, int lda, const bf16_t* Bt, int ldb, int rb, int ch, int fr, int q) {
#pragma unroll
    for (int ks = 0; ks < K / 32; ++ks) {
        const rw_bf16x8 a = *(const rw_bf16x8*)(A + (16 * rb + fr) * lda + 32 * ks + 8 * q);
#pragma unroll
        for (int nt = 0; nt < 2; ++nt) { const rw_bf16x8 b = *(const rw_bf16x8*)(Bt + (32 * ch + 16 * nt + fr) * ldb + 32 * ks + 8 * q); acc[nt] = __builtin_amdgcn_mfma_f32_16x16x32_bf16(b, a, acc[nt], 0, 0, 0); }
    }
}
__device__ __forceinline__ bool rw_map(int tid, int n, int hh, int& kind, int& c8, int& col, int& rg) {
    const int w = __builtin_amdgcn_readfirstlane(tid >> 6), ln = tid & 63; rg = ln & 7; const int cvl = ln >> 3;
    if (w < 3) { kind = w; c8 = cvl * 8; col = w * 768 + hh * 64 + c8; return true; }
    if (w < 5) { kind = w; c8 = cvl * 8; col = (w == 3 ? 2400 : 2496) + n * 48 + c8; return cvl < 6; }
    if (w < 7) { kind = 5; const int cg = (w - 5) * 8 + cvl; c8 = cg * 8; col = 2304 + c8; return n == 0 && cg < 12; }
    kind = 6; c8 = 0; col = 0; return false;
}
struct RwPre { uint4 raw[10]; float4 m0a, m0b, m1a, m1b; };
__device__ __forceinline__ void rwkv_prefetch(const Params& p, int l, int unit, int tid, RwPre& P) {
    const int n = unit & 1, ci = (unit >> 1) % (TT / 64), bh = (unit >> 1) / (TT / 64), b = bh / 12, hh = bh % 12;
    const int segb = ci < 4 ? 0 : LC, sege = ci < 4 ? LC : TT, s0 = ci * 64;
    int kind, c8, col, rg; const bool act = rw_map(tid, n, hh, kind, c8, col, rg);
#pragma unroll
    for (int i = 0; i < 10; ++i) P.raw[i] = make_uint4(0u, 0u, 0u, 0u);
    if (unit < RW_UNITS && act) {
        const int j0 = 8 * rg;
        const int ta = n == 0 ? s0 + j0 : s0 + 63 - j0 - 7;
        const bf16_t* zp = p.z + (size_t)(b * TT + ta) * ZLD + ZC + col;
#pragma unroll
        for (int i = 0; i < 10; ++i) { const int tk = ta - 1 + i; if (tk >= segb && tk < sege) P.raw[i] = *(const uint4*)(zp + (ptrdiff_t)(i - 1) * ZLD); }
        const float* mu = p.rw_shift + (size_t)l * 2 * RWC;
        P.m0a = *(const float4*)(mu + col); P.m0b = *(const float4*)(mu + col + 4); P.m1a = *(const float4*)(mu + RWC + col); P.m1b = *(const float4*)(mu + RWC + col + 4);
    }
}
__device__ __forceinline__ void rwkv_unit(const Params& p, unsigned char* Lb, int l, int unit, int unit_next, RwPre& P) {
    const int tid = otid(), wid = tid >> 6, lane = tid & 63, rb = wid & 3, ch = wid >> 2, fr = lane & 15, q = lane >> 4;
    const int n = unit & 1, ci = (unit >> 1) % (TT / 64), bh = (unit >> 1) / (TT / 64), b = bh / 12, hh = bh % 12;
    const int segb = ci < 4 ? 0 : LC, sege = ci < 4 ? LC : TT, s0 = ci * 64;
    float* rf = (float*)Lb; float* kf = rf + 64 * FLD; float* red = kf + 64 * FLD;
    bf16_t* Aw = (bf16_t*)(Lb + 36864); bf16_t* Aa = Aw + 64 * RLD; bf16_t* Bw = Aa + 64 * RLD; bf16_t* Ba = Bw + 64 * RLD; bf16_t* Ag = Ba + 64 * RLD; bf16_t* Bg = Ag + 64 * GLD;
    bf16_t* Rt = (bf16_t*)(Lb + 36864); bf16_t* Kt = (bf16_t*)(Lb + 46080); bf16_t* Bt = (bf16_t*)(Lb + 55296); bf16_t* kap = (bf16_t*)(Lb + 64512);
    bf16_t* KtT = (bf16_t*)(Lb + 73728); bf16_t* BtT = (bf16_t*)(Lb + 82944); bf16_t* kapT = (bf16_t*)(Lb + 92160); bf16_t* VT = (bf16_t*)(Lb + 101376);
    float* btot = (float*)(Lb + 110592); float* GCv = btot + 256;
    bf16_t* Akk = (bf16_t*)(Lb + 27648); bf16_t* Ark = (bf16_t*)(Lb + 111872); bf16_t* Arb = (bf16_t*)(Lb + 121088); bf16_t* XT = (bf16_t*)(Lb + 130304);
    bf16_t* const Ms[2] = {(bf16_t*)(Lb + 0), (bf16_t*)(Lb + 46080)}; bf16_t* const MTs[2] = {(bf16_t*)(Lb + 9216), (bf16_t*)(Lb + 55296)}; bf16_t* const Ts[2] = {(bf16_t*)(Lb + 18432), (bf16_t*)(Lb + 64512)};
    const float* mu = p.rw_shift + (size_t)l * 2 * RWC;
    lds_barrier();
    float4 cst[2][5];
#pragma unroll
    for (int nt = 0; nt < 2; ++nt) { const int c = hh * 64 + 32 * ch + 16 * nt + 4 * q;
        cst[nt][0] = *(const float4*)(p.rw_k_k + (size_t)l * 768 + c); cst[nt][1] = *(const float4*)(p.rw_k_a + (size_t)l * 768 + c); cst[nt][2] = *(const float4*)(p.rw_r_k + (size_t)l * 768 + c);
        cst[nt][3] = *(const float4*)(p.rw_w0 + ((size_t)l * 2 + n) * 768 + c); cst[nt][4] = *(const float4*)(p.rw_a0 + ((size_t)l * 2 + n) * 768 + c); }
    const uint4* srcw = (const uint4*)(p.Lwa + (size_t)((l * 2 + n) * 12 + hh) * 2 * 64 * 72);
    const uint4* srcg = (const uint4*)(p.Lg + (size_t)(l * 12 + hh) * 64 * 104);
    const uint4 wv0 = srcw[tid], wv1 = srcw[tid + 512], wv2 = tid < 128 ? srcw[tid + 1024] : make_uint4(0u, 0u, 0u, 0u);
    uint4 gv0 = make_uint4(0u, 0u, 0u, 0u), gv1 = gv0; if (n == 0) { gv0 = srcg[tid]; if (tid < 320) gv1 = srcg[tid + 512]; }
    {
        int kind, c8, col, rg;
        if (rw_map(tid, n, hh, kind, c8, col, rg)) {
            const int j0 = 8 * rg;
            const int ta = n == 0 ? s0 + j0 : s0 + 63 - j0 - 7;
            const float m0[8] = {P.m0a.x, P.m0a.y, P.m0a.z, P.m0a.w, P.m0b.x, P.m0b.y, P.m0b.z, P.m0b.w}, m1[8] = {P.m1a.x, P.m1a.y, P.m1a.z, P.m1a.w, P.m1b.x, P.m1b.y, P.m1b.z, P.m1b.w};
            unsigned vpk[8][4];
#pragma unroll
            for (int i = 0; i < 8; ++i) {
                const int tk = ta + i, j = n == 0 ? tk - s0 : s0 + 63 - tk;
                const uint4 pu = P.raw[i], cu = P.raw[i + 1], nu = P.raw[i + 2];
                const unsigned pw[4] = {pu.x, pu.y, pu.z, pu.w}, cw[4] = {cu.x, cu.y, cu.z, cu.w}, nw[4] = {nu.x, nu.y, nu.z, nu.w};
                float x[8];
#pragma unroll
                for (int e = 0; e < 4; ++e) { const float c0 = bfl(cw[e]), c1 = bfh(cw[e]);
                    x[2 * e] = c0 + m0[2 * e] * (bfl(pw[e]) - c0) + m1[2 * e] * (bfl(nw[e]) - c0); x[2 * e + 1] = c1 + m0[2 * e + 1] * (bfh(pw[e]) - c1) + m1[2 * e + 1] * (bfh(nw[e]) - c1); }
                if (kind == 0) { *(float4*)(rf + j * FLD + c8) = make_float4(x[0], x[1], x[2], x[3]); *(float4*)(rf + j * FLD + c8 + 4) = make_float4(x[4], x[5], x[6], x[7]); }
                else if (kind == 1) { *(float4*)(kf + j * FLD + c8) = make_float4(x[0], x[1], x[2], x[3]); *(float4*)(kf + j * FLD + c8 + 4) = make_float4(x[4], x[5], x[6], x[7]); }
                else if (kind == 2) {
#pragma unroll
                    for (int e = 0; e < 8; ++e) { const unsigned hbits = (unsigned)f2bf(x[e]); vpk[e][i >> 1] = (i & 1) ? (vpk[e][i >> 1] | (hbits << 16)) : hbits; }
                    if (n == 0) { uint4 o; o.x = pg8::cvt_pk_bf16(x[0], x[1]); o.y = pg8::cvt_pk_bf16(x[2], x[3]); o.z = pg8::cvt_pk_bf16(x[4], x[5]); o.w = pg8::cvt_pk_bf16(x[6], x[7]);
                        *(uint4*)(p.rw_vb + ((size_t)(bh * (TT / 64) + ci) * 64 + j) * 64 + c8) = o; } }
                else {
                    bf16_t* dst = kind == 3 ? Aw + j * RLD + c8 : (kind == 4 ? Aa + j * RLD + c8 : Ag + j * GLD + c8);
                    if (kind == 3) {
#pragma unroll
                        for (int e = 0; e < 8; ++e) x[e] = 1.0f - 2.0f * __builtin_amdgcn_rcpf(1.0f + __builtin_amdgcn_exp2f(2.8853900817779268f * x[e])); }
                    else if (kind == 5) {
#pragma unroll
                        for (int e = 0; e < 8; ++e) x[e] = __builtin_amdgcn_rcpf(1.0f + __builtin_amdgcn_exp2f(-1.4426950408889634f * x[e])); }
                    uint4 o; o.x = pg8::cvt_pk_bf16(x[0], x[1]); o.y = pg8::cvt_pk_bf16(x[2], x[3]); o.z = pg8::cvt_pk_bf16(x[4], x[5]); o.w = pg8::cvt_pk_bf16(x[6], x[7]); *(uint4*)dst = o;
                }
            }
            if (kind == 2) {
#pragma unroll
                for (int e = 0; e < 8; ++e) { uint4 o = make_uint4(vpk[e][0], vpk[e][1], vpk[e][2], vpk[e][3]);
                    if (n != 0) o = make_uint4((o.w << 16) | (o.w >> 16), (o.z << 16) | (o.z >> 16), (o.y << 16) | (o.y >> 16), (o.x << 16) | (o.x >> 16));
                    *(uint4*)(VT + (c8 + e) * RLD + j0) = o; }
            }
        }
    }
    for (int i = tid; i < 64 * 16; i += NT) { const int j = i >> 4, c = 48 + (i & 15); Aw[j * RLD + c] = 0; Aa[j * RLD + c] = 0; }
    { uint4* dw = (uint4*)Bw; dw[tid] = wv0; dw[tid + 512] = wv1; if (tid < 128) dw[tid + 1024] = wv2;
      if (n == 0) { uint4* dg = (uint4*)Bg; dg[tid] = gv0; if (tid < 320) dg[tid + 512] = gv1; } }
    rwkv_prefetch(p, l, unit_next, tid, P);
    lds_barrier();
    rw_f32x4 accw[2], acca[2], accg[2];
#pragma unroll
    for (int nt = 0; nt < 2; ++nt) { accw[nt] = (rw_f32x4){0.f, 0.f, 0.f, 0.f}; acca[nt] = accw[nt]; accg[nt] = accw[nt]; }
    mm_t<64>(accw, Aw, RLD, Bw, RLD, rb, ch, fr, q);
    mm_t<64>(acca, Aa, RLD, Ba, RLD, rb, ch, fr, q);
    if (n == 0) mm_t<96>(accg, Ag, GLD, Bg, GLD, rb, ch, fr, q);
    const int t = 16 * rb + fr, s = n == 0 ? s0 + t : s0 + 63 - t, g = b * TT + s;
    float kv[2][4], rv[2][4], kkr[2][4], av[2][4], lw[2][4], kd[2][4], G[2][4]; float ssq = 0.f, bon = 0.f;
#pragma unroll
    for (int nt = 0; nt < 2; ++nt) {
        const int c = 32 * ch + 16 * nt + 4 * q;
        const float4 k4 = *(const float4*)(kf + t * FLD + c), r4 = *(const float4*)(rf + t * FLD + c);
        const float4 kk4 = cst[nt][0], ka4 = cst[nt][1], rk4 = cst[nt][2], w04 = cst[nt][3], a04 = cst[nt][4];
        const float ke[4] = {k4.x, k4.y, k4.z, k4.w}, re[4] = {r4.x, r4.y, r4.z, r4.w}, kke[4] = {kk4.x, kk4.y, kk4.z, kk4.w}, kae[4] = {ka4.x, ka4.y, ka4.z, ka4.w}, rke[4] = {rk4.x, rk4.y, rk4.z, rk4.w}, w0e[4] = {w04.x, w04.y, w04.z, w04.w}, a0e[4] = {a04.x, a04.y, a04.z, a04.w};
#pragma unroll
        for (int j = 0; j < 4; ++j) {
            kv[nt][j] = ke[j]; rv[nt][j] = re[j]; kkr[nt][j] = ke[j] * kke[j]; ssq += kkr[nt][j] * kkr[nt][j];
            const float wpre = w0e[j] + accw[nt][j]; lw[nt][j] = -0.6065306597126334f * __builtin_amdgcn_rcpf(1.0f + __expf(-wpre));
            av[nt][j] = __builtin_amdgcn_rcpf(1.0f + __expf(-(a0e[j] + acca[nt][j])));
            kd[nt][j] = ke[j] * (1.0f + (av[nt][j] - 1.0f) * kae[j]); bon += re[j] * kd[nt][j] * rke[j];
            float x = lw[nt][j];
            x += __int_as_float(__builtin_amdgcn_update_dpp(0, __float_as_int(x), 0x111, 0xF, 0xF, true)); x += __int_as_float(__builtin_amdgcn_update_dpp(0, __float_as_int(x), 0x112, 0xF, 0xF, true));
            x += __int_as_float(__builtin_amdgcn_update_dpp(0, __float_as_int(x), 0x114, 0xF, 0xF, true)); x += __int_as_float(__builtin_amdgcn_update_dpp(0, __float_as_int(x), 0x118, 0xF, 0xF, true));
            G[nt][j] = x; if (fr == 15) btot[rb * 64 + c + j] = x;
        }
    }
    ssq += bperm_f(lane ^ 16, ssq); ssq += bperm_f(lane ^ 32, ssq); bon += bperm_f(lane ^ 16, bon); bon += bperm_f(lane ^ 32, bon);
    if (q == 0) { red[ch * 64 + t] = ssq; red[128 + ch * 64 + t] = bon; }
    lds_barrier();
    const float rnorm = 1.0f / fmaxf(sqrtf(red[t] + red[64 + t]), 1e-12f);
    if (ch == 0 && q == 0) p.bonus[((size_t)n * M + g) * 12 + hh] = red[128 + t] + red[192 + t];
    const size_t uoff = (size_t)unit * 4096;
#pragma unroll
    for (int nt = 0; nt < 2; ++nt)
#pragma unroll
        for (int j = 0; j < 4; ++j) { const int c = 32 * ch + 16 * nt + 4 * q + j; float pre = 0.f, tot = 0.f;
#pragma unroll
            for (int r2 = 0; r2 < 4; ++r2) { const float bt = btot[r2 * 64 + c]; tot += bt; if (r2 < rb) pre += bt; }
            G[nt][j] += pre; if (t == 63) GCv[c] = __expf(tot); }
#pragma unroll
    for (int nt = 0; nt < 2; ++nt) {
        const int c = 32 * ch + 16 * nt + 4 * q;
        float rt[4], kt[4], bt[4], kp[4];
#pragma unroll
        for (int j = 0; j < 4; ++j) { const float gam = __expf(G[nt][j]), ig = __expf(-G[nt][j]), gp = __expf(G[nt][j] - lw[nt][j]); const float kk = kkr[nt][j] * rnorm;
            rt[j] = rv[nt][j] * gam; kt[j] = kd[nt][j] * ig; bt[j] = kk * av[nt][j] * ig; kp[j] = kk * gp;
            KtT[(c + j) * RLD + t] = f2bf(kt[j]); BtT[(c + j) * RLD + t] = f2bf(bt[j]); kapT[(c + j) * RLD + t] = f2bf(kp[j]); }
        uint2 o; o.x = pg8::cvt_pk_bf16(rt[0], rt[1]); o.y = pg8::cvt_pk_bf16(rt[2], rt[3]); *(uint2*)(Rt + t * RLD + c) = o;
        o.x = pg8::cvt_pk_bf16(kt[0], kt[1]); o.y = pg8::cvt_pk_bf16(kt[2], kt[3]); *(uint2*)(Kt + t * RLD + c) = o;
        o.x = pg8::cvt_pk_bf16(bt[0], bt[1]); o.y = pg8::cvt_pk_bf16(bt[2], bt[3]); *(uint2*)(Bt + t * RLD + c) = o;
        o.x = pg8::cvt_pk_bf16(kp[0], kp[1]); o.y = pg8::cvt_pk_bf16(kp[2], kp[3]); *(uint2*)(kap + t * RLD + c) = o;
        if (n == 0) { o.x = pg8::cvt_pk_bf16(accg[nt][0], accg[nt][1]); o.y = pg8::cvt_pk_bf16(accg[nt][2], accg[nt][3]); *(uint2*)(p.rw_gb + ((size_t)(bh * (TT / 64) + ci) * 64 + t) * 64 + c) = o; }
    }
    lds_barrier();
#define RW_ZERO(a) do { a[0] = (rw_f32x4){0.f, 0.f, 0.f, 0.f}; a[1] = a[0]; } while (0)
#define RW_STORE_BF(dst, a) do { _Pragma("unroll") for (int _nt = 0; _nt < 2; ++_nt) { uint2 _o; _o.x = pg8::cvt_pk_bf16(a[_nt][0], a[_nt][1]); _o.y = pg8::cvt_pk_bf16(a[_nt][2], a[_nt][3]); \
        *(uint2*)((dst) + t * RLD + 32 * ch + 16 * _nt + 4 * q) = _o; } } while (0)
    { rw_f32x4 a1[2], a2[2], a3[2], a4[2], a5[2]; RW_ZERO(a1); RW_ZERO(a2); RW_ZERO(a3); RW_ZERO(a4); RW_ZERO(a5);
      mm_t<64>(a1, kap, RLD, Bt, RLD, rb, ch, fr, q);
      mm_t<64>(a2, Bt, RLD, kap, RLD, rb, ch, fr, q);
      mm_t<64>(a3, kap, RLD, Kt, RLD, rb, ch, fr, q);
      mm_t<64>(a4, Rt, RLD, Kt, RLD, rb, ch, fr, q);
      mm_t<64>(a5, Rt, RLD, Bt, RLD, rb, ch, fr, q);
      rw_f32x4 t1[2];
#pragma unroll
      for (int nt = 0; nt < 2; ++nt)
#pragma unroll
          for (int j = 0; j < 4; ++j) { const int cc = 32 * ch + 16 * nt + 4 * q + j;
              a1[nt][j] = cc < t ? -a1[nt][j] : 0.f; t1[nt][j] = a1[nt][j] + (cc == t ? 1.f : 0.f);
              a2[nt][j] = t < cc ? -a2[nt][j] : 0.f;
              a3[nt][j] = cc < t ? a3[nt][j] : 0.f; a4[nt][j] = cc <= t ? a4[nt][j] : 0.f; a5[nt][j] = cc <= t ? a5[nt][j] : 0.f; }
      RW_STORE_BF(Ms[0], a1); RW_STORE_BF(MTs[0], a2); RW_STORE_BF(Ts[0], t1); RW_STORE_BF(Akk, a3); RW_STORE_BF(Ark, a4); RW_STORE_BF(Arb, a5); }
    lds_barrier();
    { rw_f32x4 a1[2], a2[2], a3[2]; RW_ZERO(a1); RW_ZERO(a2); RW_ZERO(a3);
      mm_t<64>(a1, VT, RLD, Akk, RLD, rb, ch, fr, q);
      mm_t<64>(a2, Ms[0], RLD, MTs[0], RLD, rb, ch, fr, q);
      mm_t<64>(a3, MTs[0], RLD, Ms[0], RLD, rb, ch, fr, q);
      RW_STORE_BF(XT, a1); RW_STORE_BF(Ms[1], a2); RW_STORE_BF(MTs[1], a3); }
    lds_barrier();
#pragma unroll
    for (int k = 1; k <= 5; ++k) {
        const bf16_t* Tk = Ts[(k + 1) & 1]; bf16_t* Tn = Ts[k & 1];
        rw_f32x4 a1[2]; RW_ZERO(a1);
        mm_t<64>(a1, Tk, RLD, MTs[k & 1], RLD, rb, ch, fr, q);
#pragma unroll
        for (int nt = 0; nt < 2; ++nt) { const uint2 o = *(const uint2*)(Tk + t * RLD + 32 * ch + 16 * nt + 4 * q); a1[nt][0] += bfl(o.x); a1[nt][1] += bfh(o.x); a1[nt][2] += bfl(o.y); a1[nt][3] += bfh(o.y); }
        RW_STORE_BF(Tn, a1);
        if (k < 5) { rw_f32x4 a2[2], a3[2]; RW_ZERO(a2); RW_ZERO(a3);
            mm_t<64>(a2, Ms[k & 1], RLD, MTs[k & 1], RLD, rb, ch, fr, q);
            mm_t<64>(a3, MTs[k & 1], RLD, Ms[k & 1], RLD, rb, ch, fr, q);
            RW_STORE_BF(Ms[(k + 1) & 1], a2); RW_STORE_BF(MTs[(k + 1) & 1], a3); }
        lds_barrier();
    }
    { rw_f32x4 a1[2], a2[2]; RW_ZERO(a1); RW_ZERO(a2);
      mm_t<64>(a1, kapT, RLD, Ts[1], RLD, rb, ch, fr, q);
      mm_t<64>(a2, XT, RLD, Ts[1], RLD, rb, ch, fr, q);
      RW_STORE_BF(Ms[0], a1); RW_STORE_BF(MTs[0], a2); }
    lds_barrier();
    { const bf16_t* WT = Ms[0]; const bf16_t* U0T = MTs[0];
      rw_f32x4 a1[2]; RW_ZERO(a1); mm_t<64>(a1, BtT, RLD, WT, RLD, rb, ch, fr, q);
      { const float gc = GCv[t];
#pragma unroll
        for (int nt = 0; nt < 2; ++nt) { uint2 o; float e[4];
#pragma unroll
            for (int j = 0; j < 4; ++j) e[j] = gc * ((32 * ch + 16 * nt + 4 * q + j == t ? 1.f : 0.f) - a1[nt][j]);
            o.x = pg8::cvt_pk_bf16(e[0], e[1]); o.y = pg8::cvt_pk_bf16(e[2], e[3]); *(uint2*)(p.rw_P + uoff + t * 64 + 32 * ch + 16 * nt + 4 * q) = o; } }
      rw_f32x4 a2[2], a3[2]; RW_ZERO(a2); RW_ZERO(a3); mm_t<64>(a2, VT, RLD, KtT, RLD, rb, ch, fr, q); mm_t<64>(a3, U0T, RLD, BtT, RLD, rb, ch, fr, q);
#pragma unroll
      for (int nt = 0; nt < 2; ++nt) { const int c = 32 * ch + 16 * nt + 4 * q; const float4 gc4 = *(const float4*)(GCv + c);
          *(float4*)(p.rw_QT + uoff + t * 64 + c) = make_float4(gc4.x * (a2[nt][0] - a3[nt][0]), gc4.y * (a2[nt][1] - a3[nt][1]), gc4.z * (a2[nt][2] - a3[nt][2]), gc4.w * (a2[nt][3] - a3[nt][3])); }
      rw_f32x4 a4[2]; RW_ZERO(a4); mm_t<64>(a4, Arb, RLD, WT, RLD, rb, ch, fr, q);
#pragma unroll
      for (int nt = 0; nt < 2; ++nt) { const int c = 32 * ch + 16 * nt + 4 * q; const uint2 r2 = *(const uint2*)(Rt + t * RLD + c); uint2 o;
          o.x = pg8::cvt_pk_bf16(bfl(r2.x) - a4[nt][0], bfh(r2.x) - a4[nt][1]); o.y = pg8::cvt_pk_bf16(bfl(r2.y) - a4[nt][2], bfh(r2.y) - a4[nt][3]); *(uint2*)(p.rw_Ry + uoff + t * 64 + c) = o; }
      rw_f32x4 a5[2], a6[2]; RW_ZERO(a5); RW_ZERO(a6); mm_t<64>(a5, Ark, RLD, VT, RLD, rb, ch, fr, q); mm_t<64>(a6, Arb, RLD, U0T, RLD, rb, ch, fr, q);
#pragma unroll
      for (int nt = 0; nt < 2; ++nt) { const int c = 32 * ch + 16 * nt + 4 * q; *(float4*)(p.rw_Y0 + uoff + t * 64 + c) = make_float4(a5[nt][0] - a6[nt][0], a5[nt][1] - a6[nt][1], a5[nt][2] - a6[nt][2], a5[nt][3] - a6[nt][3]); } }
#undef RW_ZERO
#undef RW_STORE_BF
}

__device__ __forceinline__ void rwkv_chain(const Params& p, unsigned char* Lb, int chain) {
    const int tid = otid(), wid = tid >> 6, lane = tid & 63, rb = wid & 3, ch = wid >> 2, fr = lane & 15, q = lane >> 4;
    const int n = chain / 48, bh = chain % 48;
    bf16_t* HT[2] = {(bf16_t*)Lb, (bf16_t*)(Lb + 9216)};
    rw_f32x4 hacc[2];
    hacc[0] = (rw_f32x4){0.f, 0.f, 0.f, 0.f}; hacc[1] = hacc[0];
    __syncthreads();
    auto uoff_of = [&](int step) { const int ci = n == 0 ? step : (step < 4 ? 3 - step : (TT / 64 - 1) - (step - 4)); return (size_t)(((bh * (TT / 64) + ci) << 1) | n) * 4096; };
    struct Ops { rw_bf16x8 p0, p1; float4 q0, q1; };
    auto load_ops = [&](int step, Ops& o) { const size_t uo = uoff_of(step); const bf16_t* Pp = p.rw_P + uo + (16 * rb + fr) * 64 + 8 * q; o.p0 = *(const rw_bf16x8*)Pp; o.p1 = *(const rw_bf16x8*)(Pp + 32);
        o.q0 = *(const float4*)(p.rw_QT + uo + (32 * ch + fr) * 64 + 16 * rb + 4 * q); o.q1 = *(const float4*)(p.rw_QT + uo + (32 * ch + 16 + fr) * 64 + 16 * rb + 4 * q); };
    auto do_step = [&](int step, const Ops& o) {
        const size_t uoff = uoff_of(step);
        bf16_t* hb = HT[step & 1];
#pragma unroll
        for (int nt = 0; nt < 2; ++nt) { uint2 w; w.x = pg8::cvt_pk_bf16(hacc[nt][0], hacc[nt][1]); w.y = pg8::cvt_pk_bf16(hacc[nt][2], hacc[nt][3]);
            const int v = 32 * ch + 16 * nt + fr, k0 = 16 * rb + 4 * q;
            *(uint2*)(hb + v * RLD + k0) = w; *(uint2*)(p.rw_H0 + uoff + v * 64 + k0) = w; }
        lds_barrier();
#pragma unroll
        for (int nt = 0; nt < 2; ++nt) {
            const bf16_t* bp = hb + (32 * ch + 16 * nt + fr) * RLD + 8 * q;
            const rw_bf16x8 b0 = *(const rw_bf16x8*)bp, b1 = *(const rw_bf16x8*)(bp + 32);
            const float4 cq = nt == 0 ? o.q0 : o.q1;
            rw_f32x4 c = (rw_f32x4){cq.x, cq.y, cq.z, cq.w};
            c = __builtin_amdgcn_mfma_f32_16x16x32_bf16(o.p0, b0, c, 0, 0, 0);
            hacc[nt] = __builtin_amdgcn_mfma_f32_16x16x32_bf16(o.p1, b1, c, 0, 0, 0);
        }
    };
    Ops A, B; load_ops(0, A); load_ops(1, B);
    for (int step = 0; step < TT / 64; step += 2) {
        do_step(step, A); if (step + 2 < TT / 64) load_ops(step + 2, A);
        do_step(step + 1, B); if (step + 3 < TT / 64) load_ops(step + 3, B);
    }
}

__device__ __forceinline__ void rwkv_out(const Params& p, unsigned char* Lb, int l, int unit3) {
    const int tid = otid(), wid = tid >> 6, lane = tid & 63, rb = wid & 3, ch = wid >> 2, fr = lane & 15, q = lane >> 4;
    const int ci = unit3 % (TT / 64), bh = unit3 / (TT / 64), b = bh / 12, hh = bh % 12;
    float* red = (float*)Lb;
    const int t = 16 * rb + fr, g = b * TT + ci * 64 + t;
    rw_f32x4 y[2]; y[0] = (rw_f32x4){0.f, 0.f, 0.f, 0.f}; y[1] = y[0];
#pragma unroll
    for (int n = 0; n < 2; ++n) {
        const size_t uoff = (size_t)(((bh * (TT / 64) + ci) << 1) | n) * 4096;
        const int row = n == 0 ? t : 63 - t;
        const bf16_t* ap = p.rw_Ry + uoff + row * 64 + 8 * q;
        const rw_bf16x8 a0 = *(const rw_bf16x8*)ap, a1 = *(const rw_bf16x8*)(ap + 32);
#pragma unroll
        for (int nt = 0; nt < 2; ++nt) {
            const int c = 32 * ch + 16 * nt;
            const bf16_t* bp = p.rw_H0 + uoff + (c + fr) * 64 + 8 * q;
            const rw_bf16x8 b0 = *(const rw_bf16x8*)bp, b1 = *(const rw_bf16x8*)(bp + 32);
            const float4 y0 = *(const float4*)(p.rw_Y0 + uoff + row * 64 + c + 4 * q);
            rw_f32x4 acc = (rw_f32x4){y0.x, y0.y, y0.z, y0.w};
            acc = __builtin_amdgcn_mfma_f32_16x16x32_bf16(b0, a0, acc, 0, 0, 0);
            acc = __builtin_amdgcn_mfma_f32_16x16x32_bf16(b1, a1, acc, 0, 0, 0);
            y[nt] += acc;
        }
    }
    float s1 = 0.f, s2 = 0.f;
#pragma unroll
    for (int nt = 0; nt < 2; ++nt)
#pragma unroll
        for (int j = 0; j < 4; ++j) { s1 += y[nt][j]; s2 += y[nt][j] * y[nt][j]; }
    s1 += bperm_f(lane ^ 16, s1); s1 += bperm_f(lane ^ 32, s1); s2 += bperm_f(lane ^ 16, s2); s2 += bperm_f(lane ^ 32, s2);
    __syncthreads();
    if (q == 0) { red[ch * 64 + t] = s1; red[128 + ch * 64 + t] = s2; }
    __syncthreads();
    const float mean = (red[t] + red[64 + t]) * (1.0f / 64.0f), var = fmaxf((red[128 + t] + red[192 + t]) * (1.0f / 64.0f) - mean * mean, 0.f), rstd = rsqrtf(var + 64e-5f);
    const float bon = p.bonus[(size_t)g * 12 + hh] + p.bonus[((size_t)M + g) * 12 + hh];
    const float* gng = p.rw_gn_g + (size_t)l * 768 + hh * 64; const float* gnb = p.rw_gn_b + (size_t)l * 768 + hh * 64;
    const size_t coff = ((size_t)(bh * (TT / 64) + ci) * 64 + t) * 64;
#pragma unroll
    for (int nt = 0; nt < 2; ++nt) {
        const int c = 32 * ch + 16 * nt + 4 * q;
        const float4 gg = *(const float4*)(gng + c), gb = *(const float4*)(gnb + c);
        const uint2 vv = *(const uint2*)(p.rw_vb + coff + c), gt = *(const uint2*)(p.rw_gb + coff + c);
        const float o0 = ((y[nt][0] - mean) * rstd * gg.x + gb.x + bon * bfl(vv.x)) * bfl(gt.x), o1 = ((y[nt][1] - mean) * rstd * gg.y + gb.y + bon * bfh(vv.x)) * bfh(gt.x);
        const float o2 = ((y[nt][2] - mean) * rstd * gg.z + gb.z + bon * bfl(vv.y)) * bfl(gt.y), o3 = ((y[nt][3] - mean) * rstd * gg.w + gb.w + bon * bfh(vv.y)) * bfh(gt.y);
        uint2 o; o.x = pg8::cvt_pk_bf16(o0, o1); o.y = pg8::cvt_pk_bf16(o2, o3);
        *(uint2*)(p.mix + (size_t)g * D + 1280 + hh * 64 + c) = o;
    }
}

typedef short attn_bf16x8 __attribute__((ext_vector_type(8)));
typedef float attn_f32x4 __attribute__((ext_vector_type(4)));
constexpr int ATT_LAT = NB * 12 * 64 * 4, ATT_CTX = NB * 12 * (LC / 16), ATT_TASKS = ATT_LAT + ATT_CTX;
__device__ __forceinline__ attn_bf16x8 ld_frag16(const bf16_t* ptr) { return *(const attn_bf16x8*)ptr; }
__device__ __forceinline__ attn_bf16x8 ld_frag8x2(const bf16_t* p0, const bf16_t* p1) {
    const uint2 a = *(const uint2*)p0, b = *(const uint2*)p1; uint4 r; r.x = a.x; r.y = a.y; r.z = b.x; r.w = b.y; return *(const attn_bf16x8*)&r; }
struct AttnFrag { attn_bf16x8 k[2][2]; attn_bf16x8 v[4]; };
__device__ __forceinline__ void attn_load(AttnFrag& F, const bf16_t* Kh  , const bf16_t* Vh  , int s0  , int qi, int q) {
#pragma unroll
    for (int t = 0; t < 2; ++t)
#pragma unroll
        for (int ks = 0; ks < 2; ++ks) F.k[t][ks] = ld_frag16(Kh + ((size_t)(((s0 >> 4) + t) * 2 + ks) * 16 + qi) * 32 + 8 * q);
#pragma unroll
    for (int db = 0; db < 4; ++db) F.v[db] = ld_frag16(Vh + ((size_t)(s0 >> 5) * 64 + 16 * db + qi) * 32 + 8 * q);
}
__device__ __forceinline__ void attn_compute(const AttnFrag& F, const attn_bf16x8 (&qf)[2], int lane, float& m, float& l, attn_f32x4 (&oacc)[4],
                                             bool win, const float* brow  , unsigned vmask  , const int (&boff)[8]) {
    attn_f32x4 st[2];
#pragma unroll
    for (int t = 0; t < 2; ++t) {
        attn_f32x4 z4 = {0.f, 0.f, 0.f, 0.f};
        z4 = __builtin_amdgcn_mfma_f32_16x16x32_bf16(F.k[t][0], qf[0], z4, 0, 0, 0);
        st[t] = __builtin_amdgcn_mfma_f32_16x16x32_bf16(F.k[t][1], qf[1], z4, 0, 0, 0);
    }
    float sc[8]; float mx = -1e30f;
#pragma unroll
    for (int i = 0; i < 8; ++i) {
        float s = st[i >> 2][i & 3] * 0.18033688011112042f;
        if (win) s = ((vmask >> i) & 1u) ? s + brow[boff[i]] : -1e30f;
        sc[i] = s; mx = fmaxf(mx, s);
    }
    mx = fmaxf(mx, bperm_f(lane ^ 16, mx)); mx = fmaxf(mx, bperm_f(lane ^ 32, mx));
    if (__any(mx > m)) {
        const float mn = fmaxf(m, mx), alpha = __builtin_amdgcn_exp2f(m - mn);
        l *= alpha; m = mn;
#pragma unroll
        for (int db = 0; db < 4; ++db) oacc[db] *= alpha;
    }
    float ps = 0.f; float pv[8];
#pragma unroll
    for (int i = 0; i < 8; ++i) { pv[i] = __builtin_amdgcn_exp2f(sc[i] - m); ps += pv[i]; }
    l += ps;
    uint4 pk; pk.x = pg8::cvt_pk_bf16(pv[0], pv[1]); pk.y = pg8::cvt_pk_bf16(pv[2], pv[3]); pk.z = pg8::cvt_pk_bf16(pv[4], pv[5]); pk.w = pg8::cvt_pk_bf16(pv[6], pv[7]);
    const attn_bf16x8 pb = *(const attn_bf16x8*)&pk;
#pragma unroll
    for (int db = 0; db < 4; ++db) oacc[db] = __builtin_amdgcn_mfma_f32_16x16x32_bf16(F.v[db], pb, oacc[db], 0, 0, 0);
}
constexpr int ATT_LAT2 = NB * 12 * 64 * 2, ATT_CTX2 = NB * 12 * (LC / 32), ATT_TASKS2 = ATT_LAT2 + ATT_CTX2;
__device__ __forceinline__ void attn_task2(const Params& p, const float* rpbs  , int task) {
    const int lane = otid() & 63, qi = lane & 15, q = lane >> 4;
    const bool lat = task < ATT_LAT2;
    int bh, qrow = 0, qp;
    if (lat) { bh = task >> 7; const int rem = task & 127; qrow = rem >> 1; qp = rem & 1; }
    else { const int t2 = task - ATT_LAT2; bh = t2 >> 3; qp = t2 & 7; }
    const int b = bh / 12, hh = bh % 12;
    const bf16_t* Kh = p.Ka + (size_t)bh * TT * 64; const bf16_t* Vh = p.Vt + (size_t)bh * 64 * TT;
    int sq[2]; attn_bf16x8 qa[2][2], qr[2][2];
#pragma unroll
    for (int u = 0; u < 2; ++u) {
        sq[u] = lat ? LC + qrow * 64 + (2 * qp + u) * 16 + qi : (2 * qp + u) * 16 + qi;
        const bf16_t* qp0 = p.Qa + ((size_t)bh * TT + sq[u]) * 64 + 8 * q; qa[u][0] = ld_frag16(qp0); qa[u][1] = ld_frag16(qp0 + 32); qr[u][0] = qa[u][0]; qr[u][1] = qa[u][1];
        if (lat) { const bf16_t* qp1 = p.Qr + ((size_t)bh * L + (sq[u] - LC)) * 64 + 8 * q; qr[u][0] = ld_frag16(qp1); qr[u][1] = ld_frag16(qp1 + 32); }
    }
    const int krow0 = min(max(qrow - 4, 0), 56);
    bool need0[2], need1[2]; unsigned vm0[2], vm1[2]; int boff[2][8];
#pragma unroll
    for (int u = 0; u < 2; ++u) { const int qb = 2 * qp + u, qc = qb * 16 + qi, kcol0 = min(max(qc - 8, 0), 48);
        const int clo = min(max(qb * 16 - 8, 0), 48), chi = min(max(qb * 16 + 7, 0), 48) + 16; need0[u] = clo < 32; need1[u] = chi > 32; vm0[u] = 0u; vm1[u] = 0u;
#pragma unroll
        for (int i = 0; i < 8; ++i) { const int kc = 16 * (i >> 2) + 4 * q + (i & 3); boff[u][i] = kc - qc + 15; vm0[u] |= ((unsigned)(kc - kcol0) < 16u ? 1u : 0u) << i; vm1[u] |= ((unsigned)(kc + 32 - kcol0) < 16u ? 1u : 0u) << i; } }
    const bool cb0 = need0[0] || need0[1], cb1 = need1[0] || need1[1]; const int ncb = (cb0 && cb1) ? 2 : 1, cbo = cb0 ? 0 : 1;
    const int nsteps = lat ? 8 + 8 * ncb : 8;
    float m[2] = {-1e30f, -1e30f}, l[2] = {0.f, 0.f}; attn_f32x4 oacc[2][4];
#pragma unroll
    for (int u = 0; u < 2; ++u)
#pragma unroll
        for (int db = 0; db < 4; ++db) oacc[u][db] = (attn_f32x4){0.f, 0.f, 0.f, 0.f};
#define ATT_S0(s, s0v, krv, cbv) do { if ((s) < 8) { s0v = (s) * 32; krv = 0; cbv = 0; } else { const int _w = (s) - 8; krv = ncb == 2 ? (_w >> 1) : _w; cbv = ncb == 2 ? (_w & 1) : cbo; s0v = LC + (krow0 + krv) * 64 + cbv * 32; } } while (0)
#define ATT_LOAD(F, s) do { int _s0, _kr, _cb; ATT_S0((s), _s0, _kr, _cb); attn_load(F, Kh, Vh, _s0, qi, q); } while (0)
#define ATT_COMP(F, s) do { int _s0, _kr, _cb; ATT_S0((s), _s0, _kr, _cb); const bool _w = (s) >= 8; const float* _br = rpbs + hh * 465 + (krow0 + _kr - qrow + 7) * 31; \
        _Pragma("unroll") for (int u = 0; u < 2; ++u) if (!_w || (_cb == 0 ? need0[u] : need1[u])) attn_compute(F, _w ? qr[u] : qa[u], lane, m[u], l[u], oacc[u], _w, _br + _cb * 32, _cb ? vm1[u] : vm0[u], boff[u]); } while (0)
    AttnFrag FA, FB;
    ATT_LOAD(FA, 0);
    for (int s = 0; s < nsteps; s += 2) {
        ATT_LOAD(FB, s + 1);
        ATT_COMP(FA, s);
        if (s + 2 < nsteps) ATT_LOAD(FA, s + 2);
        ATT_COMP(FB, s + 1);
    }
#undef ATT_S0
#undef ATT_LOAD
#undef ATT_COMP
#pragma unroll
    for (int u = 0; u < 2; ++u) {
        float lt = l[u]; lt += bperm_f(lane ^ 16, lt); lt += bperm_f(lane ^ 32, lt);
        const float rinv = 1.0f / lt;
        bf16_t* op = p.mix + (size_t)(b * TT + sq[u]) * D + 512 + hh * 64 + 4 * q;
#pragma unroll
        for (int db = 0; db < 4; ++db) { uint2 w; w.x = pg8::cvt_pk_bf16(oacc[u][db][0] * rinv, oacc[u][db][1] * rinv); w.y = pg8::cvt_pk_bf16(oacc[u][db][2] * rinv, oacc[u][db][3] * rinv); *(uint2*)(op + 16 * db) = w; }
    }
}

constexpr int RT_LD = 2052;
__device__ __forceinline__ void phase_router(const Params& p, unsigned char* Lb, int l, int bid, int nb) {
    const int tix = otid(), wid = tix >> 6, lane = tix & 63;
    float* At = (float*)Lb;
    float* Pp = At + 16 * RT_LD;
    int* ent = (int*)(Pp + 2 * 16 * 64);
    int* lcnt = ent + 480 * 4; int* lbase = lcnt + 64;
    const float* gam = p.norm2_g + (size_t)l * D;
    __syncthreads();
    if (tix < 64) lcnt[tix] = 0;
    int nloc = 0;
    const bool latonly = (l == 1);
    for (int tile = bid; tile < (latonly ? NB * L / 16 : M / 16); tile += nb, ++nloc) {
        const int g0 = latonly ? (tile >> 8) * TT + LC + (tile & 255) * 16 : tile * 16;
        __syncthreads();
#pragma unroll 1
        for (int rr = 0; rr < 2; ++rr) {
            const int r = 2 * wid + rr, g = g0 + r;
            const float* xr = p.xcur + (size_t)g * D;
            float4 v[8]; float ss = 0.f;
#pragma unroll
            for (int i = 0; i < 8; ++i) { v[i] = *(const float4*)(xr + (i * 64 + lane) * 4); ss += v[i].x * v[i].x + v[i].y * v[i].y + v[i].z * v[i].z + v[i].w * v[i].w; }
            ss = wave_sum(ss);
            const float rs = rsqrtf(ss * (1.0f / D) + 1e-6f);
            const float* mrow = p.mod + (size_t)(l * 5 + modrow(g)) * 6 * D; const float* sh = mrow + 3 * D; const float* sc = mrow + 4 * D;
#pragma unroll
            for (int i = 0; i < 8; ++i) {
                const int d = (i * 64 + lane) * 4;
                const float4 gg = *(const float4*)(gam + d), s4 = *(const float4*)(sh + d), c4 = *(const float4*)(sc + d);
                float4 o;
                o.x = v[i].x * rs * gg.x * (1.0f + c4.x) + s4.x; o.y = v[i].y * rs * gg.y * (1.0f + c4.y) + s4.y; o.z = v[i].z * rs * gg.z * (1.0f + c4.z) + s4.z; o.w = v[i].w * rs * gg.w * (1.0f + c4.w) + s4.w;
                uint2 pk; pk.x = pg8::cvt_pk_bf16(o.x, o.y); pk.y = pg8::cvt_pk_bf16(o.z, o.w);
                *(uint2*)(p.h + (size_t)g * D + d) = pk;
                *(float4*)(At + r * RT_LD + d) = o;
            }
        }
        __syncthreads();
        {
            const int nt = wid & 3, kh = wid >> 2, fr = lane & 15, q = lane >> 4;
            pg8::f32x4 acc = {0.f, 0.f, 0.f, 0.f};
            const float* wp = p.Wr + (((size_t)(l * 128 + kh * 64) * 4 + nt) * 64 + lane) * 4;
            const float* ap = At + fr * RT_LD + kh * 1024 + 4 * q;
#pragma unroll 16
            for (int j = 0; j < 64; ++j) {
                const float4 a4 = *(const float4*)(ap + 16 * j), b4 = *(const float4*)(wp + (size_t)j * 1024);
                acc = __builtin_amdgcn_mfma_f32_16x16x4f32(a4.x, b4.x, acc, 0, 0, 0); acc = __builtin_amdgcn_mfma_f32_16x16x4f32(a4.y, b4.y, acc, 0, 0, 0);
                acc = __builtin_amdgcn_mfma_f32_16x16x4f32(a4.z, b4.z, acc, 0, 0, 0); acc = __builtin_amdgcn_mfma_f32_16x16x4f32(a4.w, b4.w, acc, 0, 0, 0);
            }
#pragma unroll
            for (int jj = 0; jj < 4; ++jj) Pp[(kh * 16 + 4 * q + jj) * 64 + 16 * nt + fr] = acc[jj];
        }
        __syncthreads();
#pragma unroll 1
        for (int rr = 0; rr < 2; ++rr) {
            const int r = 2 * wid + rr, g = g0 + r;
            const float score = 1.0f / (1.0f + expf(-(Pp[r * 64 + lane] + Pp[(16 + r) * 64 + lane])));
            float val = score + p.router_bias[l * NEXP + lane];
            int myidx[TOPK]; float mysc[TOPK]; float tot = 0.f;
#pragma unroll
            for (int k = 0; k < TOPK; ++k) {
                float bv = val; int bi = lane;
#pragma unroll
                for (int o = 32; o >= 1; o >>= 1) { const float ov = bperm_f(lane ^ o, bv); const int oi = bperm_i(lane ^ o, bi); if (ov > bv || (ov == bv && oi < bi)) { bv = ov; bi = oi; } }
                const float sc_k = bperm_f(bi, score);
                myidx[k] = bi; mysc[k] = sc_k; tot += sc_k;
                if (lane == bi) val = -INFINITY;
            }
            if (lane < TOPK) {
                int e = myidx[0]; float w = mysc[0];
#pragma unroll
                for (int k = 1; k < TOPK; ++k) if (lane == k) { e = myidx[k]; w = mysc[k]; }
                w = w / tot * 2.5f;
                p.sel[g * TOPK + lane] = e; p.selw[g * TOPK + lane] = w;
                const int lp = atomicAdd(&lcnt[e], 1);
                int* en = ent + ((nloc * 16 + r) * TOPK + lane) * 4; en[0] = e; en[1] = __float_as_int(w); en[2] = g * 8 + lane; en[3] = lp;
            }
        }
    }
    __syncthreads();
    if (tix < 64) lbase[tix] = lcnt[tix] ? atomicAdd(p.cnt + l * NEXP + tix, lcnt[tix]) : 0;
    __syncthreads();
    for (int i = tix; i < nloc * 16 * TOPK; i += NT) {
        const int e = ent[i * 4], gk = ent[i * 4 + 2], pos = lbase[e] + ent[i * 4 + 3];
        p.ltok[(size_t)e * LCAP + pos] = gk >> 3; p.lw[(size_t)e * LCAP + pos] = __int_as_float(ent[i * 4 + 1]); p.tpos[(gk >> 3) * TOPK + (gk & 7)] = pos;
    }
}

constexpr int MAXU = 17;
__device__ __forceinline__ void moe_tables(const Params& p, LAS int* tab, int lc) {
    const int tix = otid();
    __syncthreads();
    if (tix == 0) { int ts = 0, of = 0;
        for (int e = 0; e < NEXP; ++e) { const int c = __hip_atomic_load(p.cnt + lc * NEXP + e, __ATOMIC_RELAXED, __HIP_MEMORY_SCOPE_AGENT); tab[e] = ts; tab[66 + e] = of; tab[132 + e] = c; ts += (c + 255) / 256; of += (c + 255) / 256 * 256; }
        tab[NEXP] = ts; tab[66 + NEXP] = of; ts += M / 256; of += M;
        tab[65] = ts; tab[66 + 65] = of; }
    __syncthreads();
}
struct MoeSched {
    const LAS int* tab; const LAS unsigned* rowtab; int NPN, G, c, total; unsigned rowbytes; const char* Bt; size_t bstride;
    __device__ __forceinline__ bool next(int i, pg8::Unit& u) const {
        const int Lq = i * G + c; if (Lq >= total) return false;
        const int rt = Lq / NPN; u.pn = Lq - rt * NPN;
        int lo = 0, hi = 64;
        while (lo < hi) { const int mid = (lo + hi + 1) >> 1; if (tab[mid] <= rt) lo = mid; else hi = mid - 1; }
        u.e = lo; u.pm = rt - tab[lo]; u.ord = i; return true;
    }
    __device__ __forceinline__ unsigned arow(const pg8::Unit& u, int r) const { return rowtab[u.ord * 256 + r] * rowbytes; }
    __device__ __forceinline__ const char* bptr(const pg8::Unit& u) const { return Bt + (size_t)u.e * bstride + (size_t)u.pn * 256 * rowbytes; }
};
struct EpiGU {
    bf16_t* U; const LAS int* tab;
    __device__ __forceinline__ void operator()(const pg8::f32x4 (&acc)[2][2][4][2], const pg8::Unit& u, int wr, int wc, int fr, int fq) const {
        const int cn = (u.e < NEXP ? tab[132 + u.e] : M), off = tab[66 + u.e], col0 = u.pn * 128 + wc * 32 + 8 * fq;
#pragma unroll
        for (int ai = 0; ai < 2; ++ai)
#pragma unroll
            for (int m = 0; m < 4; ++m) { const int i = u.pm * 256 + ai * 128 + wr * 64 + m * 16 + fr;
                if (i < cn) { float o[8];
#pragma unroll
                    for (int n = 0; n < 2; ++n)
#pragma unroll
                        for (int j = 0; j < 4; ++j) { const float gv = acc[ai][0][m][n][j], uv = acc[ai][1][m][n][j]; o[n * 4 + j] = gv * __builtin_amdgcn_rcpf(1.0f + __expf(-gv)) * uv; }
                    pg8::u32x4 w; w.x = pg8::cvt_pk_bf16(o[0], o[1]); w.y = pg8::cvt_pk_bf16(o[2], o[3]); w.z = pg8::cvt_pk_bf16(o[4], o[5]); w.w = pg8::cvt_pk_bf16(o[6], o[7]);
                    *(pg8::u32x4*)(U + (size_t)(off + i) * DE + col0) = w; } }
    }
};
struct EpiDown {
    bf16_t* Y; const LAS int* tab;
    __device__ __forceinline__ void operator()(const pg8::f32x4 (&acc)[2][2][4][2], const pg8::Unit& u, int wr, int wc, int fr, int fq) const {
        const int cn = (u.e < NEXP ? tab[132 + u.e] : M), off = tab[66 + u.e], col0 = u.pn * 256 + wc * 32 + 8 * fq;
#pragma unroll
        for (int ai = 0; ai < 2; ++ai)
#pragma unroll
            for (int m = 0; m < 4; ++m) { const int i = u.pm * 256 + ai * 128 + wr * 64 + m * 16 + fr;
                if (i < cn) { bf16_t* rowp = Y + (size_t)(off + i) * D + col0;
#pragma unroll
                    for (int bj = 0; bj < 2; ++bj) { const pg8::f32x4 v0 = acc[ai][bj][m][0], v1 = acc[ai][bj][m][1];
                        pg8::u32x4 w; w.x = pg8::cvt_pk_bf16(v0[0], v0[1]); w.y = pg8::cvt_pk_bf16(v0[2], v0[3]); w.z = pg8::cvt_pk_bf16(v1[0], v1[1]); w.w = pg8::cvt_pk_bf16(v1[2], v1[3]);
                        *(pg8::u32x4*)(rowp + bj * 128) = w; } } }
    }
};
template <bool DOWN>
__device__ __forceinline__ void phase_gemm_moe(const Params& p, LAS unsigned char* stage, LAS int* tab, LAS unsigned* rowtab, int l, int bid, int nb) {
    const int tix = otid();
    moe_tables(p, tab, l);
    MoeSched S; S.tab = tab; S.rowtab = rowtab; S.NPN = DOWN ? 8 : 4; S.G = nb; S.c = (nb % 8 == 0) ? (bid % 8) * (nb / 8) + bid / 8 : bid; S.total = tab[65] * S.NPN;
    S.rowbytes = DOWN ? DE * 2 : D * 2; S.Bt = DOWN ? (const char*)p.WdnT : (const char*)p.WguT; S.bstride = DOWN ? (size_t)D * DE * 2 : (size_t)1024 * D * 2;
    for (int i = 0; i < MAXU; ++i) { pg8::Unit u; if (!S.next(i, u)) break;
        if (tix < 256) { const int idx = u.pm * 256 + tix, cn = (u.e < NEXP ? tab[132 + u.e] : M); unsigned v;
            if (DOWN) v = (unsigned)(tab[66 + u.e] + idx); else v = idx < cn ? (u.e < NEXP ? (unsigned)p.ltok[(size_t)u.e * LCAP + idx] : (unsigned)idx) : (unsigned)M;
            rowtab[i * 256 + tix] = v; } }
    __syncthreads();
    if (DOWN) { EpiDown E; E.Y = p.Y; E.tab = tab; pg8::gemm_phase<true>(stage, (const char*)p.U, DE, S, E); }
    else { EpiGU E; E.U = p.U; E.tab = tab; pg8::gemm_phase<true>(stage, (const char*)p.h, D, S, E); }
}
__device__ __forceinline__ void phase_final(const Params& p, LAS int* tab, int bid, int nb) {
    moe_tables(p, tab, 1);
    const int tix = otid();
    const int wid = tix >> 6, lane = tix & 63;
    for (int r = bid * 8 + wid; r < NB * L; r += nb * 8) {
        const int b = r / L, t = r % L; const float* xr = p.xcur + (size_t)(b * TT + LC + t) * D;
        float4 v[8]; float ss = 0.f;
#pragma unroll
        for (int i = 0; i < 8; ++i) v[i] = *(const float4*)(xr + (i * 64 + lane) * 4);
        moe_combine_row(p, tab, 1, b * TT + LC + t, lane, v);
#pragma unroll
        for (int i = 0; i < 8; ++i) ss += v[i].x * v[i].x + v[i].y * v[i].y + v[i].z * v[i].z + v[i].w * v[i].w;
        ss = wave_sum(ss); const float rs = rsqrtf(ss * (1.0f / D) + 1e-6f);
#pragma unroll
        for (int i = 0; i < 8; ++i) { const int d = (i * 64 + lane) * 4; const float4 gg = *(const float4*)(p.final_g + d);
            float4 o; o.x = v[i].x * rs * gg.x; o.y = v[i].y * rs * gg.y; o.z = v[i].z * rs * gg.z; o.w = v[i].w * rs * gg.w;
            *(float4*)(p.out + (size_t)r * D + d) = o; }
    }
}


constexpr int LDS_BYTES = 160 * 1024;
extern __shared__ __attribute__((aligned(16))) unsigned char dyn_lds_raw[];
__device__ __forceinline__ LAS unsigned char* lds_las(unsigned off) { asm volatile("" : "+s"(off)); return (LAS unsigned char*)(unsigned long)off; }
__device__ __forceinline__ int obid() { int b = blockIdx.x; asm volatile("" : "+s"(b)); return b; }
__device__ __forceinline__ int onb() { int b = gridDim.x; asm volatile("" : "+s"(b)); return b; }
typedef const __attribute__((address_space(4))) Params* KParams;
__device__ __forceinline__ KParams kp_opaque(KParams q) { asm volatile("" : "+s"(q)); return q; }
#define PPH (*(const Params*)kp_opaque(kp))
__global__ __launch_bounds__(512, 2) void mega(Params p_byval) {
    const KParams kp = (KParams)__builtin_amdgcn_kernarg_segment_ptr();
    if (threadIdx.x == 0) *(uint4*)dyn_lds_raw = make_uint4(0u, 0u, 0u, 0u);
    __syncthreads();
    XcdBarrier bar = xcd_barrier_post(PPH.bar, (volatile LAS unsigned*)dyn_lds_raw);
    const unsigned lds0 = (unsigned)(unsigned long long)(LAS unsigned char*)dyn_lds_raw;
#define LDSB ((unsigned char*)lds_las(lds0 + 1024u))
#define lds ((float*)LDSB)
#define stage (lds_las(lds0 + 1024u))
#define tab ((LAS int*)lds_las(lds0 + 1024u + 131072u))
#define rowtab ((LAS unsigned*)lds_las(lds0 + 1024u + 131072u + 1024u))
#define bid (obid())
#define nb (onb())
    phase_copy(PPH, bid, nb);
    phase_router_w(PPH, bid, nb);
    phase_lora_w(PPH, bid, nb);
    phase_adaln(PPH, lds, bid, nb);
    xcd_barrier(bar);
#pragma unroll 1
    for (int l = 0; l < 2; ++l) {
        phase_norm<0>(PPH, lds, tab, l, bid, nb);
        phase_convert(PPH, lds, l, bid, nb);
        xcd_barrier(bar);
        phase_gemm_in(PPH, stage, bid, nb);
        xcd_barrier(bar);
        phase_prep(PPH, lds, l, bid, nb);
        { const int b1 = obid(), n1 = onb(); RwPre pre; rwkv_prefetch(PPH, l, b1, otid(), pre); for (int unit = b1; unit < RW_UNITS; unit += n1) rwkv_unit(PPH, LDSB, l, unit, unit + n1, pre); }
        xcd_barrier(bar);
        { const int tix = otid(), wid = __builtin_amdgcn_readfirstlane(tix >> 6); const int bid_l = obid(), nb_l = onb();
          float* const rp_l = lds + 32768;
          { const Params& pr = PPH; for (int i = tix; i < 12 * 465; i += NT) rp_l[i] = pr.rpb[(size_t)l * 12 * 465 + i] * 1.4426950408889634f; }
          __syncthreads();
          if (bid_l < 96) rwkv_chain(PPH, LDSB, bid_l);
          { const int wt = nb_l > 96 ? 96 + 2 * (nb_l - 96) : nb_l, w0 = nb_l > 96 ? (bid_l < 96 ? bid_l : 96 + 2 * (bid_l - 96)) : bid_l, w1 = nb_l > 96 ? (bid_l < 96 ? bid_l + 1 : 96 + 2 * (bid_l - 95)) : bid_l + 1;
            const int lo = (int)((long)w0 * ATT_LAT2 / wt), hi = (int)((long)w1 * ATT_LAT2 / wt); for (int task = lo + wid; task < hi; task += 8) attn_task2(PPH, rp_l, task); }
          if (l == 0) for (int task = ATT_LAT2 + bid_l * 8 + wid; task < ATT_TASKS2; task += nb_l * 8) attn_task2(PPH, rp_l, task); }
        xcd_barrier(bar);
        { const int b1 = obid(), n1 = onb(); for (int u3 = b1; u3 < RW_UNITS / 2; u3 += n1) if (l == 0 || u3 % (TT / 64) >= 4) rwkv_out(PPH, LDSB, l, u3); }
        xcd_barrier(bar);
        phase_gemm_out(PPH, stage, l, bid, nb);
        xcd_barrier(bar);
        phase_router(PPH, LDSB, l, bid, nb);
        xcd_barrier(bar);
        phase_gemm_moe<false>(PPH, stage, tab, rowtab, l, bid, nb);
        xcd_barrier(bar);
        phase_gemm_moe<true>(PPH, stage, tab, rowtab, l, bid, nb);
        xcd_barrier(bar);
    }
    phase_final(PPH, tab, bid, nb);
}

#undef bid
#undef nb
#undef LDSB
#undef lds
#undef stage
#undef tab
#undef rowtab
extern "C" void kernel_launch(void* const* d_in, const int* in_sizes, int n_in, void* d_out, int out_size, void* d_ws, size_t ws_size, hipStream_t stream) {
    static int grid = 0;
    if (grid == 0) {
        int dev = 0, cus = 0, per_cu = 0;
        if (hipGetDevice(&dev) != hipSuccess || hipDeviceGetAttribute(&cus, hipDeviceAttributeMultiprocessorCount, dev) != hipSuccess) { grid = -1; return; }
        if (hipFuncSetAttribute((const void*)mega, hipFuncAttributeMaxDynamicSharedMemorySize, LDS_BYTES) != hipSuccess) { grid = -1; return; }
        if (hipOccupancyMaxActiveBlocksPerMultiprocessor(&per_cu, (const void*)mega, NT, LDS_BYTES) != hipSuccess || per_cu < 1) { grid = -1; return; }
        (void)hipGetLastError();
        grid = cus;
        if (grid < 96) { grid = -1; return; }
    }
    if (grid < 0) return;
    Params p{};
    const float** pf = (const float**)&p;
    for (int i = 0; i < 32; ++i) pf[i] = (const float*)d_in[i];
    p.out = (float*)d_out;
    char* w = (char*)d_ws; size_t o = 0;
    auto take = [&](size_t bytes) { char* r = w + o; o += (bytes + 255) & ~(size_t)255; return r; };
    p.bar = (unsigned*)take(XCD_BAR_WORDS * 4 + 2 * NEXP * 4);
    p.cnt = (int*)(p.bar + XCD_BAR_WORDS);
    p.mod = (float*)take((size_t)2 * 5 * 6 * D * 4);
    p.xcur = (float*)take((size_t)M * D * 4);
    p.h = (bf16_t*)take((size_t)(M + 1) * D * 2);
    p.mix = (bf16_t*)take((size_t)M * D * 2);
    p.z = (bf16_t*)take((size_t)M * ZLD * 2);
    p.Y = p.z;
    p.streams = (float*)take((size_t)M * SSTR * 4);
    p.bonus = (float*)take((size_t)2 * M * 12 * 4);
    { char* sb = (char*)p.streams; const size_t U = (size_t)RW_UNITS * 4096;
      p.rw_P = (bf16_t*)sb; sb += U * 2; p.rw_Ry = (bf16_t*)sb; sb += U * 2; p.rw_H0 = (bf16_t*)sb; sb += U * 2; p.rw_QT = (float*)sb; sb += U * 4; p.rw_Y0 = (float*)sb; sb += U * 4;
      p.rw_vb = (bf16_t*)sb; sb += U; p.rw_gb = (bf16_t*)sb; sb += U; }
    p.ydir = (float*)take((size_t)2 * M * 768 * 4);
    p.tpos = (int*)take((size_t)M * TOPK * 4);
    p.sel = (int*)take((size_t)M * TOPK * 4);
    p.selw = (float*)take((size_t)M * TOPK * 4);
    p.ltok = (int*)take((size_t)NEXP * LCAP * 4);
    p.lw = (float*)take((size_t)NEXP * LCAP * 4);
    p.U = (bf16_t*)take((size_t)(UROWS + M) * DE * 2);
    p.WinT = (bf16_t*)take((size_t)ZLD * D * 2);
    p.WoutT = (bf16_t*)take((size_t)D * D * 2);
    p.WguT = (bf16_t*)take((size_t)65 * 1024 * D * 2);
    p.WdnT = (bf16_t*)take((size_t)65 * D * DE * 2);
    p.Qa = (bf16_t*)take((size_t)NB * 12 * TT * 64 * 2);
    p.Qr = (bf16_t*)take((size_t)NB * 12 * L * 64 * 2);
    p.Ka = (bf16_t*)take((size_t)NB * 12 * TT * 64 * 2);
    p.Vt = (bf16_t*)take((size_t)NB * 12 * 64 * TT * 2);
    p.Wr = (float*)take((size_t)2 * D * NEXP * 4);
    p.Lwa = (bf16_t*)take((size_t)2 * 2 * 12 * 2 * 64 * 72 * 2);
    p.Lg = (bf16_t*)take((size_t)2 * 12 * 64 * 104 * 2);
    if (o > ws_size) return;
    if (hipMemsetAsync(p.bar, 0, XCD_BAR_WORDS * sizeof(unsigned) + 2 * NEXP * 4, stream) != hipSuccess) return;
    hipLaunchKernelGGL(mega, dim3(grid), dim3(NT), LDS_BYTES, stream, p);
}
```

```cpp
#include <hip/hip_runtime.h>
#include <stdint.h>

typedef unsigned short bf16_t;

constexpr int D = 2048, NB = 4, L = 4096, LC = 256, TT = L + LC, M = NB * TT;
constexpr int IN_COLS = 6432, ZLD = 6656;
constexpr int ZA = 0, ZB = 1536, ZC = 3840, RWC = 2592;
constexpr int NEXP = 64, TOPK = 6, DE = 512;
constexpr int NSTR = 10, SSTR = NSTR * 768;
constexpr int LCAP = M;
constexpr int UROWS = M * TOPK + NEXP * 256;
constexpr int NT = 512;

struct Params {
    const float *x, *c, *ctx, *c_ctx, *norm1_g, *norm2_g, *ada_w, *ada_b, *w_in, *conv_w, *rpb, *rw_shift, *rw_w0, *rw_w_up, *rw_a0, *rw_a_up, *rw_g_up,
        *rw_k_k, *rw_k_a, *rw_r_k, *rw_gn_g, *rw_gn_b, *w_out, *router_w, *router_bias, *exp_gate, *exp_up, *exp_down, *sh_gate, *sh_up, *sh_down, *final_g;
    float* out;
    unsigned* bar; float* mod; float* xcur; bf16_t* h; bf16_t* z; bf16_t* mix; float* streams; float* bonus; float* ydir;
    int* sel; float* selw; int* cnt; int* ltok; float* lw; bf16_t* U; bf16_t *WinT, *WoutT, *WguT, *WdnT; bf16_t *Qa, *Qr, *Ka, *Vt; bf16_t* Y; int* tpos; bf16_t *rw_P, *rw_Ry, *rw_H0, *rw_vb, *rw_gb; float *rw_QT, *rw_Y0; float* Wr; bf16_t *Lwa, *Lg;
};

__device__ __forceinline__ float bf2f(bf16_t b) { return __uint_as_float(((unsigned)b) << 16); }
__device__ __forceinline__ bf16_t f2bf(float f) { unsigned u = __float_as_uint(f); u += 0x7FFFu + ((u >> 16) & 1u); return (bf16_t)(u >> 16); }
__device__ __forceinline__ float sigmoidf_(float x) { return 1.0f / (1.0f + __expf(-x)); }
template <int CTRL, int RMASK> __device__ __forceinline__ float dpp_f(float old, float v) { return __int_as_float(__builtin_amdgcn_update_dpp(__float_as_int(old), __float_as_int(v), CTRL, RMASK, 0xF, false)); }
__device__ __forceinline__ float wave_sum(float v) {
    v += dpp_f<0xB1, 0xF>(0.f, v);
    v += dpp_f<0x4E, 0xF>(0.f, v);
    v += dpp_f<0x141, 0xF>(0.f, v);
    v += dpp_f<0x140, 0xF>(0.f, v);
    v += dpp_f<0x142, 0xA>(0.f, v);
    v += dpp_f<0x143, 0xC>(0.f, v);
    return __int_as_float(__builtin_amdgcn_readlane(__float_as_int(v), 63));
}
__device__ __forceinline__ float wave_max(float v) {
    v = fmaxf(v, dpp_f<0xB1, 0xF>(v, v));
    v = fmaxf(v, dpp_f<0x4E, 0xF>(v, v));
    v = fmaxf(v, dpp_f<0x141, 0xF>(v, v));
    v = fmaxf(v, dpp_f<0x140, 0xF>(v, v));
    v = fmaxf(v, dpp_f<0x142, 0xA>(v, v));
    v = fmaxf(v, dpp_f<0x143, 0xC>(v, v));
    return __int_as_float(__builtin_amdgcn_readlane(__float_as_int(v), 63));
}
__device__ __forceinline__ float bperm_f(int srclane, float v) { return __int_as_float(__builtin_amdgcn_ds_bpermute(srclane << 2, __float_as_int(v))); }
__device__ __forceinline__ int bperm_i(int srclane, int v) { return __builtin_amdgcn_ds_bpermute(srclane << 2, v); }
__device__ __forceinline__ int otid() { int t = threadIdx.x; asm volatile("" : "+v"(t)); return t; }
__device__ __forceinline__ void lds_barrier() { asm volatile("s_waitcnt lgkmcnt(0)" ::: "memory"); __builtin_amdgcn_s_barrier(); asm volatile("" ::: "memory"); }
__device__ __forceinline__ float bfl(unsigned u) { return __uint_as_float(u << 16); }
__device__ __forceinline__ float bfh(unsigned u) { return __uint_as_float(u & 0xffff0000u); }
__device__ __forceinline__ const float* in_row(const Params& p, int g) { const int b = g / TT, s = g - b * TT; return s < LC ? p.ctx + (size_t)(b * LC + s) * D : p.x + (size_t)(b * L + (s - LC)) * D; }
__device__ __forceinline__ int modrow(int g) { const int b = g / TT, s = g - b * TT; return s < LC ? 4 : b; }

#define XB_TMO      128
#define XB_XCNT(j)  (256  + 64 * (j))
#define XB_XSUB(j)  (1280 + 64 * (j))
#define XB_XGEN(j)  (2304 + 64 * (j))
#define XB_TOP      3328
#define XB_TOPGEN   3392
#define XCD_BAR_WORDS 3456
#define XB_SPIN_CAP (1u << 22)
#define LAS __attribute__((address_space(3)))

__device__ __forceinline__ unsigned xb_ld(unsigned* p)              { return __hip_atomic_load(p, __ATOMIC_RELAXED, __HIP_MEMORY_SCOPE_AGENT); }
__device__ __forceinline__ unsigned xb_add(unsigned* p, unsigned v) { return __hip_atomic_fetch_add(p, v, __ATOMIC_RELAXED, __HIP_MEMORY_SCOPE_AGENT); }
__device__ __forceinline__ unsigned xb_xcc_id() { return (unsigned)__builtin_amdgcn_s_getreg((3 << 11) | 20) & 0xFu; }
#define XB_SPIN(cond, bar) do { unsigned _sp = 0; while (cond) { __builtin_amdgcn_s_sleep(1); \
    if ((++_sp & 255u) == 0u) { if (xb_ld(&(bar)[XB_TMO])) break; if (_sp > XB_SPIN_CAP) { atomicAdd(&(bar)[XB_TMO], 1u); break; } } } } while (0)

struct XcdBarrier {
    unsigned* bar; unsigned x;
    volatile LAS unsigned* st;
};

__device__ __forceinline__ XcdBarrier xcd_barrier_post(unsigned* bar, volatile LAS unsigned* st) {
    XcdBarrier b; b.bar = bar; b.x = xb_xcc_id(); b.st = st;
    if (threadIdx.x == 0) (void)xb_add(&bar[XB_XCNT(b.x)], 1u);
    return b;
}
__device__ __forceinline__ void xcd_barrier_complete(unsigned* bar, unsigned x, unsigned& nloc, unsigned& nx) {
    const unsigned G = gridDim.x * gridDim.y * gridDim.z;
    unsigned sum, cnt, mine, sp = 0u;
    for (;;) {
        sum = 0u; cnt = 0u; mine = 0u;
#pragma unroll
        for (unsigned j = 0; j < 16; ++j) { const unsigned c = xb_ld(&bar[XB_XCNT(j)]); sum += c; cnt += (c > 0u) ? 1u : 0u; mine = (j == x) ? c : mine; }
        if (sum == G) break;
        __builtin_amdgcn_s_sleep(1);
        if ((++sp & 255u) == 0u) { if (xb_ld(&bar[XB_TMO])) break; if (sp > XB_SPIN_CAP) { atomicAdd(&bar[XB_TMO], 1u); break; } }
    }
    nloc = mine > 0u ? mine : 1u; nx = cnt > 0u ? cnt : 1u;
}

__device__ __forceinline__ void xcd_barrier(const XcdBarrier& b) {
    asm volatile("s_waitcnt vmcnt(0)" ::: "memory");
    __syncthreads();
    if (threadIdx.x == 0) {
        unsigned* bar = b.bar; const unsigned bx = xb_xcc_id();
        __builtin_amdgcn_s_waitcnt(0);
        unsigned nloc = b.st[0], nx = b.st[1];
        if (nloc == 0u) { xcd_barrier_complete(bar, bx, nloc, nx); b.st[0] = nloc; b.st[1] = nx; }
        const unsigned old = xb_add(&bar[XB_XSUB(bx)], 1u);
        const unsigned gen = old / nloc;
        if (old + 1u == (gen + 1u) * nloc) {
            __builtin_amdgcn_fence(__ATOMIC_RELEASE, "agent");
            asm volatile("s_waitcnt vmcnt(0)" ::: "memory");
            const unsigned og = xb_add(&bar[XB_TOP], 1u);
            const unsigned tg = og / nx;
            if (og + 1u == (tg + 1u) * nx) xb_add(&bar[XB_TOPGEN], 1u);
            else XB_SPIN(xb_ld(&bar[XB_TOPGEN]) == tg, bar);
            __builtin_amdgcn_fence(__ATOMIC_ACQUIRE, "agent");
            xb_add(&bar[XB_XGEN(bx)], 1u);
            asm volatile("s_waitcnt vmcnt(0)" ::: "memory");
        } else {
            XB_SPIN(xb_ld(&bar[XB_XGEN(bx)]) == gen, bar);
            __builtin_amdgcn_fence(__ATOMIC_ACQUIRE, "agent");
            asm volatile("s_waitcnt vmcnt(0)" ::: "memory");
        }
    }
    __syncthreads();
}


__device__ __forceinline__ void phase_copy(const Params& p, int bid, int nb) {
    const int tix = otid();
    if (bid == 0) for (int i = tix; i < D; i += NT) p.h[(size_t)M * D + i] = 0;
}

__device__ __forceinline__ void phase_router_w(const Params& p, int bid, int nb) {
    const int tix = otid();
    for (int i = bid * NT + tix; i < 2 * D * NEXP; i += nb * NT) {
        const int c = i & 3, n = (i >> 2) & 15, q = (i >> 6) & 3, nt = (i >> 8) & 3, j = (i >> 10) & 127, l = i >> 17;
        p.Wr[i] = p.router_w[((size_t)l * D + 16 * j + 4 * q + c) * NEXP + 16 * nt + n];
    }
}
__device__ __forceinline__ void phase_lora_w(const Params& p, int bid, int nb) {
    const int tix = otid();
    for (int i = bid * NT + tix; i < 2 * 2 * 12 * 2 * 64 * 72; i += nb * NT) {
        const int r = i % 72, c = (i / 72) & 63, which = (i / (72 * 64)) & 1, hh = (i / (72 * 64 * 2)) % 12, n = (i / (72 * 64 * 2 * 12)) & 1, l = i / (72 * 64 * 2 * 12 * 2);
        const float* src = (which == 0 ? p.rw_w_up : p.rw_a_up) + ((size_t)(l * 2 + n) * 48) * 768 + hh * 64 + c;
        p.Lwa[i] = r < 48 ? f2bf(src[(size_t)r * 768]) : (bf16_t)0;
    }
    for (int i = bid * NT + tix; i < 2 * 12 * 64 * 104; i += nb * NT) {
        const int r = i % 104, c = (i / 104) & 63, hh = (i / (104 * 64)) % 12, l = i / (104 * 64 * 12);
        p.Lg[i] = r < 96 ? f2bf(p.rw_g_up[((size_t)l * 96 + r) * 768 + hh * 64 + c]) : (bf16_t)0;
    }
}
__device__ __forceinline__ void phase_adaln(const Params& p, float* lds, int bid, int nb) {
    const int tix = otid();
    float* cond = lds;
    float* red = lds + 5 * D;
    for (int i = tix; i < 5 * D; i += NT) { const int r = i / D, d = i % D; const float v = r < 4 ? p.c[r * D + d] : p.c_ctx[d]; cond[i] = v * sigmoidf_(v); }
    __syncthreads();
    const int tid = tix, cg = tid & 15, ks = tid >> 4, wid = tid >> 6, lane = tid & 63;
    const int nitems = 2 * (6 * D / 64);
    for (int it = bid; it < nitems; it += nb) {
        const int l = it / (6 * D / 64), c0 = (it % (6 * D / 64)) * 64 + cg * 4;
        const float* W = p.ada_w + (size_t)l * D * 6 * D + c0;
        float4 acc[5];
#pragma unroll
        for (int r = 0; r < 5; ++r) acc[r] = make_float4(0.f, 0.f, 0.f, 0.f);
#pragma unroll 8
        for (int k = ks; k < D; k += 32) {
            const float4 w = *(const float4*)(W + (size_t)k * 6 * D);
#pragma unroll
            for (int r = 0; r < 5; ++r) { const float cv = cond[r * D + k]; acc[r].x += cv * w.x; acc[r].y += cv * w.y; acc[r].z += cv * w.z; acc[r].w += cv * w.w; }
        }
#pragma unroll
        for (int r = 0; r < 5; ++r) {
            acc[r].x += bperm_f(lane ^ 16, acc[r].x); acc[r].x += bperm_f(lane ^ 32, acc[r].x);
            acc[r].y += bperm_f(lane ^ 16, acc[r].y); acc[r].y += bperm_f(lane ^ 32, acc[r].y);
            acc[r].z += bperm_f(lane ^ 16, acc[r].z); acc[r].z += bperm_f(lane ^ 32, acc[r].z);
            acc[r].w += bperm_f(lane ^ 16, acc[r].w); acc[r].w += bperm_f(lane ^ 32, acc[r].w);
        }
        __syncthreads();
        if (lane < 16) {
#pragma unroll
            for (int r = 0; r < 5; ++r) { float* q = red + ((wid * 16 + lane) * 20 + r * 4); q[0] = acc[r].x; q[1] = acc[r].y; q[2] = acc[r].z; q[3] = acc[r].w; }
        }
        __syncthreads();
        if (tid < 16 * 20) {
            const int cgi = tid / 20, rj = tid % 20, r = rj / 4, j = rj % 4;
            float s = 0.f;
#pragma unroll
            for (int w = 0; w < 8; ++w) s += red[(w * 16 + cgi) * 20 + rj];
            const int col = (it % (6 * D / 64)) * 64 + cgi * 4 + j;
            p.mod[(size_t)(l * 5 + r) * 6 * D + col] = s + p.ada_b[(size_t)l * 6 * D + col];
        }
    }
}

__device__ __forceinline__ void moe_tables(const Params& p, LAS int* tab, int lc);

struct CombPre { int e[TOPK], tp[TOPK]; float w[TOPK]; };
__device__ __forceinline__ void comb_prefetch(const Params& p, int g, CombPre& c) {
#pragma unroll
    for (int k = 0; k < TOPK; ++k) { c.e[k] = p.sel[g * TOPK + k]; c.tp[k] = p.tpos[g * TOPK + k]; c.w[k] = p.selw[g * TOPK + k]; }
}
__device__ __forceinline__ void moe_combine_row(const Params& p, const LAS int* tab, int lm  , int g, int lane, const CombPre& c, float4 (&v)[8]) {
    int slot[TOPK + 1]; float w[TOPK + 1];
#pragma unroll
    for (int k = 0; k < TOPK; ++k) { slot[k] = tab[66 + c.e[k]] + c.tp[k]; w[k] = c.w[k]; }
    slot[TOPK] = tab[66 + NEXP] + g; w[TOPK] = 1.0f;
    const float* gt = p.mod + (size_t)(lm * 5 + modrow(g)) * 6 * D + 5 * D;
#pragma unroll
    for (int i = 0; i < 8; ++i) {
        const int d = (i * 64 + lane) * 4; float a0 = 0.f, a1 = 0.f, a2 = 0.f, a3 = 0.f;
#pragma unroll
        for (int k = 0; k <= TOPK; ++k) { const uint2 y = *(const uint2*)(p.Y + (size_t)slot[k] * D + d);
            a0 += w[k] * __uint_as_float(y.x << 16); a1 += w[k] * __uint_as_float(y.x & 0xffff0000u); a2 += w[k] * __uint_as_float(y.y << 16); a3 += w[k] * __uint_as_float(y.y & 0xffff0000u); }
        const float4 g4 = *(const float4*)(gt + d);
        v[i].x += g4.x * a0; v[i].y += g4.y * a1; v[i].z += g4.z * a2; v[i].w += g4.w * a3;
    }
}

template <int WHICH>
__device__ __forceinline__ void phase_norm(const Params& p, float* lds, LAS int* tab, int l, int bid, int nb) {
    const bool comb = (WHICH == 0 && l > 0);
    if (comb) moe_tables(p, tab, l - 1);
    const int tix = otid();
    const int wid = tix >> 6, lane = tix & 63;
    const float* gam = (WHICH == 0 ? p.norm1_g : p.norm2_g) + (size_t)l * D;
    float* frow = lds + wid * D;
    float4 vn[8]; CombPre cn;
    { const int g = bid * 8 + wid; if (g < M) { const float* xr = (WHICH == 0 && l == 0) ? in_row(p, g) : p.xcur + (size_t)g * D;
#pragma unroll
        for (int i = 0; i < 8; ++i) vn[i] = *(const float4*)(xr + (i * 64 + lane) * 4);
        if (comb) comb_prefetch(p, g, cn); } }
    for (int g = bid * 8 + wid; g < M; g += nb * 8) {
        float4 v[8]; float ss = 0.f; CombPre cc;
#pragma unroll
        for (int i = 0; i < 8; ++i) v[i] = vn[i];
        if (comb) cc = cn;
        { const int gn = g + nb * 8; if (gn < M) { const float* xr = (WHICH == 0 && l == 0) ? in_row(p, gn) : p.xcur + (size_t)gn * D;
#pragma unroll
            for (int i = 0; i < 8; ++i) vn[i] = *(const float4*)(xr + (i * 64 + lane) * 4);
            if (comb) comb_prefetch(p, gn, cn); } }
        if (comb) { moe_combine_row(p, tab, l - 1, g, lane, cc, v);
#pragma unroll
            for (int i = 0; i < 8; ++i) *(float4*)(p.xcur + (size_t)g * D + (i * 64 + lane) * 4) = v[i]; }
#pragma unroll
        for (int i = 0; i < 8; ++i) ss += v[i].x * v[i].x + v[i].y * v[i].y + v[i].z * v[i].z + v[i].w * v[i].w;
        ss = wave_sum(ss);
        const float rs = rsqrtf(ss * (1.0f / D) + 1e-6f);
        const float* mrow = p.mod + (size_t)(l * 5 + modrow(g)) * 6 * D;
        const float* sh = mrow + (WHICH == 0 ? 0 : 3) * D; const float* sc = mrow + (WHICH == 0 ? 1 : 4) * D;
#pragma unroll
        for (int i = 0; i < 8; ++i) {
            const int d = (i * 64 + lane) * 4;
            const float4 gg = *(const float4*)(gam + d), s4 = *(const float4*)(sh + d), c4 = *(const float4*)(sc + d);
            float4 o;
            o.x = v[i].x * rs * gg.x * (1.0f + c4.x) + s4.x; o.y = v[i].y * rs * gg.y * (1.0f + c4.y) + s4.y;
            o.z = v[i].z * rs * gg.z * (1.0f + c4.z) + s4.z; o.w = v[i].w * rs * gg.w * (1.0f + c4.w) + s4.w;
            uint2 pk; pk.x = (unsigned)f2bf(o.x) | ((unsigned)f2bf(o.y) << 16); pk.y = (unsigned)f2bf(o.z) | ((unsigned)f2bf(o.w) << 16);
            *(uint2*)(p.h + (size_t)g * D + d) = pk;
            if (WHICH == 1) *(float4*)(frow + d) = o;
        }
        if (WHICH == 1) {
            const float* rw = p.router_w + (size_t)l * D * NEXP + lane;
            float a0 = 0.f, a1 = 0.f, a2 = 0.f, a3 = 0.f;
            for (int k = 0; k < D; k += 4) {
                const float4 f = *(const float4*)(frow + k);
                a0 += f.x * rw[(size_t)(k + 0) * NEXP]; a1 += f.y * rw[(size_t)(k + 1) * NEXP]; a2 += f.z * rw[(size_t)(k + 2) * NEXP]; a3 += f.w * rw[(size_t)(k + 3) * NEXP];
            }
            const float score = 1.0f / (1.0f + expf(-((a0 + a1) + (a2 + a3))));
            float val = score + p.router_bias[l * NEXP + lane];
            int myidx[TOPK]; float mysc[TOPK]; float tot = 0.f;
#pragma unroll
            for (int k = 0; k < TOPK; ++k) {
                float bv = val; int bi = lane;
#pragma unroll
                for (int o = 32; o >= 1; o >>= 1) { const float ov = bperm_f(lane ^ o, bv); const int oi = bperm_i(lane ^ o, bi); if (ov > bv || (ov == bv && oi < bi)) { bv = ov; bi = oi; } }
                const float sc_k = bperm_f(bi, score);
                myidx[k] = bi; mysc[k] = sc_k; tot += sc_k;
                if (lane == bi) val = -INFINITY;
            }
            if (lane == 0) {
#pragma unroll
                for (int k = 0; k < TOPK; ++k) { p.sel[g * TOPK + k] = myidx[k]; p.selw[g * TOPK + k] = mysc[k] / tot * 2.5f; }
            }
        }
    }
}


namespace pg8 {
typedef short bf16x8 __attribute__((ext_vector_type(8)));
typedef float f32x4 __attribute__((ext_vector_type(4)));
typedef unsigned u32x4 __attribute__((ext_vector_type(4)));
constexpr int BM = 256, BK = 64, HALF = 128, HTB = HALF * BK * 2  , STAGE_BYTES = 8 * HTB, NXCD = 8, WGM = 8;
__device__ __forceinline__ int lds_byte(int r, int c) { const int st = (r >> 4) * 2 + (c >> 5), rr = r & 15, cc = c & 31, ob = rr * 64 + cc * 2; return st * 1024 + (ob ^ (((ob >> 9) & 1) << 5)); }
__device__ __forceinline__ void stage_rc(int b, int& R, int& C) { const int st = b / 1024, sb = b % 1024, swz = sb ^ (((sb >> 9) & 1) << 5); R = (st >> 1) * 16 + swz / 64; C = (st & 1) * 32 + (swz % 64) / 2; }
__device__ __forceinline__ int perm32(int rho) { const int n = rho >> 4, i = rho & 15; return 8 * (i >> 2) + 4 * n + (i & 3); }
typedef float cvt_f32x2 __attribute__((ext_vector_type(2)));
typedef __bf16 cvt_bf16x2 __attribute__((ext_vector_type(2)));
__device__ __forceinline__ unsigned cvt_pk_bf16(float lo, float hi) { const cvt_f32x2 v = {lo, hi}; const cvt_bf16x2 b = __builtin_convertvector(v, cvt_bf16x2); return __builtin_bit_cast(unsigned, b); }
struct Unit { int pm, pn, e, ord; };
template <bool PERM, class Sched, class Epi>
__device__ __forceinline__ void gemm_phase(LAS unsigned char* lds, const char* Abase, const int K, const Sched& S, const Epi& E) {
    const int tid = otid(), wid = __builtin_amdgcn_readfirstlane(tid >> 6), lane = tid & 63, wr = wid >> 2, wc = wid & 3, fr = lane & 15, fq = lane >> 4;
    const int nt = K / BK;
    unsigned voffB[2];
#pragma unroll
    for (int i = 0; i < 2; ++i) { int R, C; stage_rc(tid * 16 + i * 8192, R, C); const int Rb = PERM ? ((R & ~31) + perm32(R & 31)) : R; voffB[i] = (unsigned)(Rb * K + C) * 2u; }
    const size_t kstep = (size_t)(BK * 2);
    const size_t hstep = (size_t)HALF * K * 2;
    const unsigned ldsw = (unsigned)wid * 1024u;
    const int aoff = lds_byte(wr * 64 + fr, fq * 8), boff = lds_byte(wc * 32 + fr, fq * 8);
#define PG8_SA(b, h) (((b) * 2 + (h)) * HTB)
#define PG8_SB(b, h) ((4 + (b) * 2 + (h)) * HTB)
#define PG8_STAGE(bufoff, gbase, voff) do { _Pragma("unroll") for (int _i = 0; _i < 2; ++_i) \
        __builtin_amdgcn_global_load_lds((const unsigned*)((const char*)(gbase) + (voff)[_i]), (LAS unsigned*)(lds + (bufoff) + ldsw + _i * 8192), 16, 0, 0); } while (0)
#define PG8_LDA(dst, b, h) do { _Pragma("unroll") for (int m = 0; m < 4; ++m) _Pragma("unroll") for (int k = 0; k < 2; ++k) dst[m][k] = *(const LAS bf16x8*)(lds + PG8_SA(b, h) + aoff + m * 2048 + k * 1024); } while (0)
#define PG8_LDB(dst, b, h) do { _Pragma("unroll") for (int n = 0; n < 2; ++n) _Pragma("unroll") for (int k = 0; k < 2; ++k) dst[n][k] = *(const LAS bf16x8*)(lds + PG8_SB(b, h) + boff + n * 2048 + k * 1024); } while (0)
#define PG8_MMA(ai, bj, At, Bt) do { __builtin_amdgcn_s_setprio(1); _Pragma("unroll") for (int m = 0; m < 4; ++m) _Pragma("unroll") for (int n = 0; n < 2; ++n) _Pragma("unroll") for (int k = 0; k < 2; ++k) \
        acc[ai][bj][m][n] = __builtin_amdgcn_mfma_f32_16x16x32_bf16(Bt[n][k], At[m][k], acc[ai][bj][m][n], 0, 0, 0); __builtin_amdgcn_s_setprio(0); } while (0)
#define PG8_WAIT_V(n) asm volatile("s_waitcnt vmcnt(" #n ")" ::: "memory")
#define PG8_WAIT_L(n) asm volatile("s_waitcnt lgkmcnt(" #n ")" ::: "memory")
#define PG8_BAR __builtin_amdgcn_s_barrier()
#define PG8_SCHED __builtin_amdgcn_sched_barrier(0)
#define PG8_ROWS(u, v) do { const int _t = otid(); _Pragma("unroll") for (int _i = 0; _i < 2; ++_i) { int _R, _C; stage_rc(_t * 16 + _i * 8192, _R, _C); \
        _Pragma("unroll") for (int _h = 0; _h < 2; ++_h) v[_h][_i] = S.arow(u, _h * HALF + _R) + (unsigned)(_C * 2); } } while (0)
    Unit cur, nxt; int ui = 0;
    if (!S.next(0, cur)) return;
    f32x4 acc[2][2][4][2];
#pragma unroll
    for (int a = 0; a < 2; ++a)
#pragma unroll
        for (int b = 0; b < 2; ++b)
#pragma unroll
            for (int m = 0; m < 4; ++m)
#pragma unroll
                for (int n = 0; n < 2; ++n) acc[a][b][m][n] = (f32x4){0.f, 0.f, 0.f, 0.f};
    bf16x8 At[4][2], B0[2][2], B1[2][2];
    unsigned va[2][2];
    PG8_ROWS(cur, va);
    const char* cB = S.bptr(cur);
    PG8_STAGE(PG8_SB(0, 0), cB, voffB); PG8_STAGE(PG8_SA(0, 0), Abase, va[0]); PG8_STAGE(PG8_SB(0, 1), cB + hstep, voffB); PG8_STAGE(PG8_SA(0, 1), Abase, va[1]);
    if (wr == 1) PG8_BAR;
    PG8_WAIT_V(4); PG8_BAR;
    PG8_STAGE(PG8_SB(1, 0), cB + kstep, voffB); PG8_STAGE(PG8_SA(1, 0), Abase + kstep, va[0]); PG8_STAGE(PG8_SB(1, 1), cB + hstep + kstep, voffB);
    PG8_WAIT_V(6); PG8_BAR;
    for (;;) {
        const bool has_next = S.next(ui + 1, nxt);
        const char* nB = has_next ? S.bptr(nxt) : cB;
        for (int t = 0; t < nt; t += 2) {
            const bool last = (t == nt - 2);
            const char* a1 = Abase + (size_t)(t + 1) * kstep;
            const char* a2 = last ? Abase : Abase + (size_t)(t + 2) * kstep; const char* b2 = last ? nB : cB + (size_t)(t + 2) * kstep;
            const char* a3 = a2 + kstep; const char* b3 = b2 + kstep;
            PG8_LDB(B0, 0, 0); PG8_SCHED; PG8_LDA(At, 0, 0); PG8_STAGE(PG8_SA(1, 1), a1, va[1]);
            PG8_WAIT_L(8); PG8_BAR; PG8_WAIT_L(0); PG8_MMA(0, 0, At, B0); PG8_BAR; PG8_SCHED;
            if (last && has_next) { PG8_ROWS(nxt, va); }
            PG8_LDB(B1, 0, 1); PG8_STAGE(PG8_SB(0, 0), b2, voffB);
            PG8_BAR; PG8_WAIT_L(0); PG8_MMA(0, 1, At, B1); PG8_BAR;
            PG8_LDA(At, 0, 1); PG8_STAGE(PG8_SA(0, 0), a2, va[0]);
            PG8_BAR; PG8_WAIT_L(0); PG8_MMA(1, 0, At, B0); PG8_BAR; PG8_SCHED;
            PG8_STAGE(PG8_SB(0, 1), b2 + hstep, voffB);
            PG8_WAIT_V(6); PG8_BAR; PG8_MMA(1, 1, At, B1); PG8_BAR;
            PG8_LDB(B0, 1, 0); PG8_SCHED; PG8_LDA(At, 1, 0); PG8_STAGE(PG8_SA(0, 1), a2, va[1]);
            PG8_WAIT_L(8); PG8_BAR; PG8_WAIT_L(0); PG8_MMA(0, 0, At, B0); PG8_BAR; PG8_SCHED;
            PG8_LDB(B1, 1, 1); PG8_STAGE(PG8_SB(1, 0), b3, voffB);
            PG8_BAR; PG8_WAIT_L(0); PG8_MMA(0, 1, At, B1); PG8_BAR;
            PG8_LDA(At, 1, 1); PG8_STAGE(PG8_SA(1, 0), a3, va[0]);
            PG8_BAR; PG8_WAIT_L(0); PG8_MMA(1, 0, At, B0); PG8_BAR; PG8_SCHED;
            PG8_STAGE(PG8_SB(1, 1), b3 + hstep, voffB);
            PG8_WAIT_V(6); PG8_BAR; PG8_MMA(1, 1, At, B1); PG8_BAR;
        }
        E(acc, cur, wr, wc, fr, fq);
        if (!has_next) break;
#pragma unroll
        for (int a = 0; a < 2; ++a)
#pragma unroll
            for (int b = 0; b < 2; ++b)
#pragma unroll
                for (int m = 0; m < 4; ++m)
#pragma unroll
                    for (int n = 0; n < 2; ++n) acc[a][b][m][n] = (f32x4){0.f, 0.f, 0.f, 0.f};
        cur = nxt; cB = nB; ++ui;
    }
    PG8_WAIT_V(0);
    if (wr == 0) PG8_BAR;
    PG8_BAR;
#undef PG8_SA
#undef PG8_SB
#undef PG8_STAGE
#undef PG8_LDA
#undef PG8_LDB
#undef PG8_MMA
#undef PG8_WAIT_V
#undef PG8_WAIT_L
#undef PG8_BAR
#undef PG8_SCHED
#undef PG8_ROWS
}
struct DenseSched {
    int nM, nN, nwg, G, c; const char* Bt; unsigned rowbytes; int skipctx;
    __device__ __forceinline__ bool next(int i, Unit& u) const {
        const long L = (long)i * G + c; if (L >= nwg) return false;
        int wgid = (int)L; { const int q = nwg / NXCD, r = nwg % NXCD, xcd = wgid % NXCD, off = wgid / NXCD; wgid = (xcd < r ? xcd * (q + 1) : r * (q + 1) + (xcd - r) * q) + off; }
        const int nig = WGM * nN, gid = wgid / nig, fm = gid * WGM, gsz = (nM - fm) < WGM ? (nM - fm) : WGM;
        u.pm = fm + ((wgid % nig) % gsz); u.pn = (wgid % nig) / gsz; u.e = 0; u.ord = i; if (skipctx) u.pm = (u.pm >> 4) * 17 + 1 + (u.pm & 15); return true;
    }
    __device__ __forceinline__ unsigned arow(const Unit& u, int r) const { return (unsigned)(u.pm * BM + r) * rowbytes; }
    __device__ __forceinline__ const char* bptr(const Unit& u) const { return Bt + (size_t)u.pn * BM * rowbytes; }
};
}

struct CvTile { const float* src; bf16_t* dst; int ldn, nvalid, k0, n0, K, split; };
constexpr int CV_IN = 32 * 26, CV_OUT = 32 * 8, CV_PER_E = 32 * 2 + 32 * 2 + 8 * 8, CV_TOTAL = CV_IN + CV_OUT + 65 * CV_PER_E;
__device__ __forceinline__ CvTile cv_desc(const Params& p, int l, int it) {
    const int r1 = it - CV_IN, r2 = r1 - CV_OUT;
    const bool is_in = it < CV_IN, is_out = !is_in && r1 < CV_OUT;
    const int e = r2 >= 0 ? r2 / CV_PER_E : 0, re = r2 >= 0 ? r2 % CV_PER_E : 0;
    const bool is_gu = !is_in && !is_out && re < 128, up = re >= 64, is_dn = !is_in && !is_out && !is_gu;
    const int rg = re & 63, rd = re - 128;
    const float* sgu = e < NEXP ? (up ? p.exp_up : p.exp_gate) + ((size_t)l * NEXP + e) * D * DE : (up ? p.sh_up : p.sh_gate) + (size_t)l * D * DE;
    const float* sdn = e < NEXP ? p.exp_down + ((size_t)l * NEXP + e) * DE * D : p.sh_down + (size_t)l * DE * D;
    CvTile t;
    t.src = is_in ? p.w_in + (size_t)l * D * IN_COLS : (is_out ? p.w_out + (size_t)l * D * D : (is_gu ? sgu : sdn));
    t.dst = is_in ? p.WinT : (is_out ? p.WoutT : (is_gu ? p.WguT + (size_t)e * 1024 * D : p.WdnT + (size_t)e * D * DE));
    t.ldn = is_in ? IN_COLS : (is_gu ? DE : D); t.nvalid = t.ldn;
    t.k0 = (is_in ? it / 26 : (is_out ? r1 / 8 : (is_gu ? rg / 2 : rd / 8))) * 64;
    t.n0 = (is_in ? it % 26 : (is_out ? r1 % 8 : (is_gu ? rg % 2 : rd % 8))) * 256;
    t.K = is_dn ? DE : D; t.split = is_gu ? (up ? 2 : 1) : 0;
    return t;
}
__device__ __forceinline__ void cv_load(const CvTile& t, int tid, pg8::f32x4 (&v)[8]) {
    const int kp = tid >> 6, c4 = (tid & 63) * 4;
#pragma unroll
    for (int j = 0; j < 8; ++j) v[j] = (t.n0 + c4 < t.nvalid) ? *(const pg8::f32x4*)(t.src + (size_t)(t.k0 + 8 * kp + j) * t.ldn + t.n0 + c4) : (pg8::f32x4){0.f, 0.f, 0.f, 0.f};
}
__device__ __forceinline__ void cv_store(const CvTile& t, int tid, bf16_t* T  , const pg8::f32x4 (&v)[8]) {
    const int kp = tid >> 6, c4 = (tid & 63) * 4;
    uint4 o;
    o.x = pg8::cvt_pk_bf16(v[0][0], v[1][0]); o.y = pg8::cvt_pk_bf16(v[2][0], v[3][0]); o.z = pg8::cvt_pk_bf16(v[4][0], v[5][0]); o.w = pg8::cvt_pk_bf16(v[6][0], v[7][0]); *(uint4*)(T + (c4 + 0) * 72 + 8 * kp) = o;
    o.x = pg8::cvt_pk_bf16(v[0][1], v[1][1]); o.y = pg8::cvt_pk_bf16(v[2][1], v[3][1]); o.z = pg8::cvt_pk_bf16(v[4][1], v[5][1]); o.w = pg8::cvt_pk_bf16(v[6][1], v[7][1]); *(uint4*)(T + (c4 + 1) * 72 + 8 * kp) = o;
    o.x = pg8::cvt_pk_bf16(v[0][2], v[1][2]); o.y = pg8::cvt_pk_bf16(v[2][2], v[3][2]); o.z = pg8::cvt_pk_bf16(v[4][2], v[5][2]); o.w = pg8::cvt_pk_bf16(v[6][2], v[7][2]); *(uint4*)(T + (c4 + 2) * 72 + 8 * kp) = o;
    o.x = pg8::cvt_pk_bf16(v[0][3], v[1][3]); o.y = pg8::cvt_pk_bf16(v[2][3], v[3][3]); o.z = pg8::cvt_pk_bf16(v[4][3], v[5][3]); o.w = pg8::cvt_pk_bf16(v[6][3], v[7][3]); *(uint4*)(T + (c4 + 3) * 72 + 8 * kp) = o;
    lds_barrier();
#pragma unroll
    for (int j = 0; j < 4; ++j) {
        const int q = tid + 512 * j, nl = q >> 3, kc = q & 7, n = t.n0 + nl;
        const size_t drow = t.split == 0 ? (size_t)n : (size_t)((n >> 7) * 256 + (t.split == 2 ? 128 : 0) + (n & 127));
        *(uint4*)(t.dst + drow * t.K + t.k0 + kc * 8) = *(const uint4*)(T + nl * 72 + kc * 8);
    }
}
__device__ __forceinline__ void phase_convert(const Params& p, float* lds, int l, int bid, int nb) {
    const int tid = otid();
    bf16_t* T0 = (bf16_t*)lds; bf16_t* T1 = T0 + 256 * 72;
    pg8::f32x4 va[8], vb[8];
    __syncthreads();
    int it = bid;
    if (it < CV_TOTAL) cv_load(cv_desc(p, l, it), tid, va);
    for (; it < CV_TOTAL; it += 2 * nb) {
        const bool has1 = it + nb < CV_TOTAL, has2 = it + 2 * nb < CV_TOTAL;
        if (has1) cv_load(cv_desc(p, l, it + nb), tid, vb);
        cv_store(cv_desc(p, l, it), tid, T0, va);
        if (has2) cv_load(cv_desc(p, l, it + 2 * nb), tid, va);
        if (has1) cv_store(cv_desc(p, l, it + nb), tid, T1, vb);
    }
    __syncthreads();
}

struct EpiZ {
    bf16_t* z;
    __device__ __forceinline__ void operator()(const pg8::f32x4 (&acc)[2][2][4][2], const pg8::Unit& u, int wr, int wc, int fr, int fq) const {
        const int row0 = u.pm * 256 + wr * 64 + fr, col0 = u.pn * 256 + wc * 32 + 8 * fq;
#pragma unroll
        for (int ai = 0; ai < 2; ++ai)
#pragma unroll
            for (int m = 0; m < 4; ++m) { bf16_t* rowp = z + (size_t)(row0 + ai * 128 + m * 16) * ZLD + col0;
#pragma unroll
                for (int bj = 0; bj < 2; ++bj) { const pg8::f32x4 v0 = acc[ai][bj][m][0], v1 = acc[ai][bj][m][1];
                    pg8::u32x4 w; w.x = pg8::cvt_pk_bf16(v0[0], v0[1]); w.y = pg8::cvt_pk_bf16(v0[2], v0[3]); w.z = pg8::cvt_pk_bf16(v1[0], v1[1]); w.w = pg8::cvt_pk_bf16(v1[2], v1[3]);
                    *(pg8::u32x4*)(rowp + bj * 128) = w; } }
    }
};
struct EpiOut {
    float* xcur; const float* mod; int l; const float* xin; const float* cin;
    __device__ __forceinline__ void operator()(const pg8::f32x4 (&acc)[2][2][4][2], const pg8::Unit& u, int wr, int wc, int fr, int fq) const {
        const int row0 = u.pm * 256 + wr * 64 + fr, col0 = u.pn * 256 + wc * 32 + 4 * fq;
#pragma unroll
        for (int ai = 0; ai < 2; ++ai)
#pragma unroll
            for (int m = 0; m < 4; ++m) { const int g = row0 + ai * 128 + m * 16; float* xr = xcur + (size_t)g * D + col0; const float* gt = mod + (size_t)(l * 5 + modrow(g)) * 6 * D + 2 * D + col0;
                const int gb = g / TT, gs = g - gb * TT; const float* xs = l != 0 ? xr : (gs < LC ? cin + (size_t)(gb * LC + gs) * D : xin + (size_t)(gb * L + (gs - LC)) * D) + col0;
#pragma unroll
                for (int bj = 0; bj < 2; ++bj)
#pragma unroll
                    for (int n = 0; n < 2; ++n) { const int co = bj * 128 + n * 16; pg8::f32x4 x4 = *(const pg8::f32x4*)(xs + co); const pg8::f32x4 g4 = *(const pg8::f32x4*)(gt + co); x4 += g4 * acc[ai][bj][m][n]; *(pg8::f32x4*)(xr + co) = x4; } }
    }
};
__device__ __forceinline__ void phase_gemm_in(const Params& p, LAS unsigned char* stage, int bid, int nb) {
    pg8::DenseSched S; S.nM = M / 256; S.nN = ZLD / 256; S.nwg = S.nM * S.nN; S.G = nb; S.c = bid; S.Bt = (const char*)p.WinT; S.rowbytes = D * 2; S.skipctx = 0;
    EpiZ E; E.z = p.z;
    pg8::gemm_phase<true>(stage, (const char*)p.h, D, S, E);
}
__device__ __forceinline__ void phase_gemm_out(const Params& p, LAS unsigned char* stage, int l, int bid, int nb) {
    pg8::DenseSched S; S.skipctx = (l == 1); S.nM = S.skipctx ? NB * L / 256 : M / 256; S.nN = D / 256; S.nwg = S.nM * S.nN; S.G = nb; S.c = bid; S.Bt = (const char*)p.WoutT; S.rowbytes = D * 2;
    EpiOut E; E.xcur = p.xcur; E.mod = p.mod; E.l = l; E.xin = p.x; E.cin = p.ctx;
    pg8::gemm_phase<false>(stage, (const char*)p.mix, D, S, E);
}
__device__ __forceinline__ void phase_prep(const Params& p, float* lds, int l, int bid, int nb) {
    const int tix = otid();
    const int tid = tix;
    {
        float* cst = lds;
        __syncthreads();
        for (int i = tid; i < 1024; i += NT) { const int pos = i >> 4, f = i & 15; float sn, cs; sincosf((float)pos * expf(-(float)f * (9.210340371976184f / 16.0f)), &sn, &cs); cst[i] = cs; cst[1024 + i] = sn; }
        __syncthreads();
        const int lane = tid & 63, wid = tid >> 6;
        const int tl = lane >> 3, dv = lane & 7, axis = dv >> 2, half = (dv >> 1) & 1, f0 = 8 * (dv & 1);
        bf16_t* Tw = (bf16_t*)(lds + 2048) + wid * (64 * 72);
        for (int wt = bid * 8 + wid; wt < NB * 12 * (TT / 64); wt += nb * 8) {
            const int tile = wt % (TT / 64), bh = wt / (TT / 64), b = bh / 12, hh = bh % 12, s0 = tile * 64;
#pragma unroll 2
            for (int i = 0; i < 8; ++i) {
                const int s = s0 + 8 * i + tl; const bf16_t* zr = p.z + (size_t)(b * TT + s) * ZLD + ZB + hh * 64 + 8 * dv;
                const uint4 q8 = *(const uint4*)zr, k8 = *(const uint4*)(zr + 768), v8 = *(const uint4*)(zr + 1536);
                *(uint4*)(p.Qa + ((size_t)bh * TT + s) * 64 + 8 * dv) = q8;
                const unsigned vw[4] = {v8.x, v8.y, v8.z, v8.w};
#pragma unroll
                for (int e = 0; e < 4; ++e) { Tw[(8 * dv + 2 * e) * 72 + 8 * i + tl] = (bf16_t)(vw[e] & 0xffffu); Tw[(8 * dv + 2 * e + 1) * 72 + 8 * i + tl] = (bf16_t)(vw[e] >> 16); }
                uint4 ko = k8;
                if (s >= LC) {
                    const int t = s - LC, pos = axis == 0 ? (t >> 6) : (t & 63);
                    const unsigned qw[4] = {q8.x, q8.y, q8.z, q8.w}, kw[4] = {k8.x, k8.y, k8.z, k8.w};
                    unsigned qo[4], kq[4];
#pragma unroll
                    for (int e = 0; e < 4; ++e) {
                        const unsigned qpw = (unsigned)bperm_i(lane ^ 2, (int)qw[e]), kpw = (unsigned)bperm_i(lane ^ 2, (int)kw[e]);
                        const float c0 = cst[pos * 16 + f0 + 2 * e], s0f = cst[1024 + pos * 16 + f0 + 2 * e], c1 = cst[pos * 16 + f0 + 2 * e + 1], s1f = cst[1024 + pos * 16 + f0 + 2 * e + 1];
                        const float qa0 = bfl(qw[e]), qa1 = bfh(qw[e]), qb0 = bfl(qpw), qb1 = bfh(qpw), ka0 = bfl(kw[e]), ka1 = bfh(kw[e]), kb0 = bfl(kpw), kb1 = bfh(kpw);
                        const float sg = half == 0 ? -1.f : 1.f;
                        qo[e] = pg8::cvt_pk_bf16(qa0 * c0 + sg * qb0 * s0f, qa1 * c1 + sg * qb1 * s1f);
                        kq[e] = pg8::cvt_pk_bf16(ka0 * c0 + sg * kb0 * s0f, ka1 * c1 + sg * kb1 * s1f);
                    }
                    *(uint4*)(p.Qr + ((size_t)bh * L + t) * 64 + 8 * dv) = make_uint4(qo[0], qo[1], qo[2], qo[3]);
                    ko = make_uint4(kq[0], kq[1], kq[2], kq[3]);
                }
                *(uint4*)(p.Ka + ((((size_t)bh * (TT / 16) + (s >> 4)) * 2 + (dv >> 2)) * 16 + (s & 15)) * 32 + 8 * (dv & 3)) = ko;
            }
            __builtin_amdgcn_wave_barrier();
#pragma unroll 2
            for (int i = 0; i < 8; ++i) {
                const int item = i * 64 + lane, q4 = item & 3, d = (item >> 2) & 63, blk = item >> 8;
                const uint2 lo = *(const uint2*)(Tw + d * 72 + blk * 32 + 4 * q4), hi = *(const uint2*)(Tw + d * 72 + blk * 32 + 16 + 4 * q4);
                *(uint4*)(p.Vt + (((size_t)bh * (TT / 32) + tile * 2 + blk) * 64 + d) * 32 + 8 * q4) = make_uint4(lo.x, lo.y, hi.x, hi.y); }
            __builtin_amdgcn_wave_barrier();
        }
        __syncthreads();
    }
    const float* cw = p.conv_w + (size_t)l * 3 * 512;
    for (int i = bid * NT + tid; i < M * 64; i += nb * NT) {
        const int ch = (i & 63) * 8, g = i >> 6, s = g % TT;
        const bf16_t* zr = p.z + (size_t)g * ZLD + ch;
        const uint4 bg = *(const uint4*)zr, cg = *(const uint4*)(zr + 512), hv = *(const uint4*)(zr + 1024);
        uint4 cgp = make_uint4(0u, 0u, 0u, 0u), hp = cgp, cgn = cgp, hn = cgp;
        if (s != 0 && s != LC) { cgp = *(const uint4*)(zr + 512 - ZLD); hp = *(const uint4*)(zr + 1024 - ZLD); }
        if (s != LC - 1 && s != TT - 1) { cgn = *(const uint4*)(zr + 512 + ZLD); hn = *(const uint4*)(zr + 1024 + ZLD); }
        const float4 w0a = *(const float4*)(cw + ch), w0b = *(const float4*)(cw + ch + 4), w1a = *(const float4*)(cw + 512 + ch), w1b = *(const float4*)(cw + 512 + ch + 4), w2a = *(const float4*)(cw + 1024 + ch), w2b = *(const float4*)(cw + 1024 + ch + 4);
        const float w0[8] = {w0a.x, w0a.y, w0a.z, w0a.w, w0b.x, w0b.y, w0b.z, w0b.w}, w1[8] = {w1a.x, w1a.y, w1a.z, w1a.w, w1b.x, w1b.y, w1b.z, w1b.w}, w2[8] = {w2a.x, w2a.y, w2a.z, w2a.w, w2b.x, w2b.y, w2b.z, w2b.w};
        const unsigned bgw[4] = {bg.x, bg.y, bg.z, bg.w}, cgw[4] = {cg.x, cg.y, cg.z, cg.w}, hw[4] = {hv.x, hv.y, hv.z, hv.w}, cpw[4] = {cgp.x, cgp.y, cgp.z, cgp.w}, hpw[4] = {hp.x, hp.y, hp.z, hp.w}, cnw[4] = {cgn.x, cgn.y, cgn.z, cgn.w}, hnw[4] = {hn.x, hn.y, hn.z, hn.w};
        unsigned o[4];
#pragma unroll
        for (int e = 0; e < 4; ++e) {
            const float r0 = bfl(bgw[e]) * (w0[2 * e] * bfl(cpw[e]) * bfl(hpw[e]) + w1[2 * e] * bfl(cgw[e]) * bfl(hw[e]) + w2[2 * e] * bfl(cnw[e]) * bfl(hnw[e]));
            const float r1 = bfh(bgw[e]) * (w0[2 * e + 1] * bfh(cpw[e]) * bfh(hpw[e]) + w1[2 * e + 1] * bfh(cgw[e]) * bfh(hw[e]) + w2[2 * e + 1] * bfh(cnw[e]) * bfh(hnw[e]));
            o[e] = pg8::cvt_pk_bf16(r0, r1);
        }
        *(uint4*)(p.mix + (size_t)g * D + ch) = make_uint4(o[0], o[1], o[2], o[3]);
    }
}

typedef short rw_bf16x8 __attribute__((ext_vector_type(8)));
typedef float rw_f32x4 __attribute__((ext_vector_type(4)));
constexpr int RLD = 72, FLD = 68, GLD = 104;
constexpr int RW_UNITS = NB * 12 * (TT / 64) * 2;
template <int K> __device__ __forceinline__ void mm_t(rw_f32x4 (&acc)[2], const bf16_t* A, int lda, const bf16_t* Bt, int ldb, int rb, int ch, int fr, int q) {
#pragma unroll
    for (int ks = 0; ks < K / 32; ++ks) {
        const rw_bf16x8 a = *(const rw_bf16x8*)(A + (16 * rb + fr) * lda + 32 * ks + 8 * q);
#pragma unroll
        for (int nt = 0; nt < 2; ++nt) { const rw_bf16x8 b = *(const rw_bf16x8*)(Bt + (32 * ch + 16 * nt + fr) * ldb + 32 * ks + 8 * q); acc[nt] = __builtin_amdgcn_mfma_f32_16x16x32_bf16(b, a, acc[nt], 0, 0, 0); }
    }
}
__device__ __forceinline__ bool rw_map(int tid, int n, int hh, int& kind, int& c8, int& col, int& rg) {
    const int w = __builtin_amdgcn_readfirstlane(tid >> 6), ln = tid & 63; rg = ln & 7; const int cvl = ln >> 3;
    if (w < 3) { kind = w; c8 = cvl * 8; col = w * 768 + hh * 64 + c8; return true; }
    if (w < 5) { kind = w; c8 = cvl * 8; col = (w == 3 ? 2400 : 2496) + n * 48 + c8; return cvl < 6; }
    if (w < 7) { kind = 5; const int cg = (w - 5) * 8 + cvl; c8 = cg * 8; col = 2304 + c8; return n == 0 && cg < 12; }
    kind = 6; c8 = 0; col = 0; return false;
}
struct RwPre { uint4 raw[10]; float4 m0a, m0b, m1a, m1b; };
__device__ __forceinline__ void rwkv_prefetch(const Params& p, int l, int unit, int tid, RwPre& P) {
    const int n = unit & 1, ci = (unit >> 1) % (TT / 64), bh = (unit >> 1) / (TT / 64), b = bh / 12, hh = bh % 12;
    const int segb = ci < 4 ? 0 : LC, sege = ci < 4 ? LC : TT, s0 = ci * 64;
    int kind, c8, col, rg; const bool act = rw_map(tid, n, hh, kind, c8, col, rg);
#pragma unroll
    for (int i = 0; i < 10; ++i) P.raw[i] = make_uint4(0u, 0u, 0u, 0u);
    if (unit < RW_UNITS && act) {
        const int j0 = 8 * rg;
        const int ta = n == 0 ? s0 + j0 : s0 + 63 - j0 - 7;
        const bf16_t* zp = p.z + (size_t)(b * TT + ta) * ZLD + ZC + col;
#pragma unroll
        for (int i = 0; i < 10; ++i) { const int tk = ta - 1 + i; if (tk >= segb && tk < sege) P.raw[i] = *(const uint4*)(zp + (ptrdiff_t)(i - 1) * ZLD); }
        const float* mu = p.rw_shift + (size_t)l * 2 * RWC;
        P.m0a = *(const float4*)(mu + col); P.m0b = *(const float4*)(mu + col + 4); P.m1a = *(const float4*)(mu + RWC + col); P.m1b = *(const float4*)(mu + RWC + col + 4);
    }
}
__device__ __forceinline__ void rwkv_unit(const Params& p, unsigned char* Lb, int l, int unit, int unit_next, RwPre& P) {
    const int tid = otid(), wid = tid >> 6, lane = tid & 63, rb = wid & 3, ch = wid >> 2, fr = lane & 15, q = lane >> 4;
    const int n = unit & 1, ci = (unit >> 1) % (TT / 64), bh = (unit >> 1) / (TT / 64), b = bh / 12, hh = bh % 12;
    const int segb = ci < 4 ? 0 : LC, sege = ci < 4 ? LC : TT, s0 = ci * 64;
    float* rf = (float*)Lb; float* kf = rf + 64 * FLD; float* red = kf + 64 * FLD;
    bf16_t* Aw = (bf16_t*)(Lb + 36864); bf16_t* Aa = Aw + 64 * RLD; bf16_t* Bw = Aa + 64 * RLD; bf16_t* Ba = Bw + 64 * RLD; bf16_t* Ag = Ba + 64 * RLD; bf16_t* Bg = Ag + 64 * GLD;
    bf16_t* Rt = (bf16_t*)(Lb + 36864); bf16_t* Kt = (bf16_t*)(Lb + 46080); bf16_t* Bt = (bf16_t*)(Lb + 55296); bf16_t* kap = (bf16_t*)(Lb + 64512);
    bf16_t* KtT = (bf16_t*)(Lb + 73728); bf16_t* BtT = (bf16_t*)(Lb + 82944); bf16_t* kapT = (bf16_t*)(Lb + 92160); bf16_t* VT = (bf16_t*)(Lb + 101376);
    float* btot = (float*)(Lb + 110592); float* GCv = btot + 256;
    bf16_t* Akk = (bf16_t*)(Lb + 27648); bf16_t* Ark = (bf16_t*)(Lb + 111872); bf16_t* Arb = (bf16_t*)(Lb + 121088); bf16_t* XT = (bf16_t*)(Lb + 130304);
    bf16_t* const Ms[2] = {(bf16_t*)(Lb + 0), (bf16_t*)(Lb + 46080)}; bf16_t* const MTs[2] = {(bf16_t*)(Lb + 9216), (bf16_t*)(Lb + 55296)}; bf16_t* const Ts[2] = {(bf16_t*)(Lb + 18432), (bf16_t*)(Lb + 64512)};
    const float* mu = p.rw_shift + (size_t)l * 2 * RWC;
    lds_barrier();
    float4 cst[2][5];
#pragma unroll
    for (int nt = 0; nt < 2; ++nt) { const int c = hh * 64 + 32 * ch + 16 * nt + 4 * q;
        cst[nt][0] = *(const float4*)(p.rw_k_k + (size_t)l * 768 + c); cst[nt][1] = *(const float4*)(p.rw_k_a + (size_t)l * 768 + c); cst[nt][2] = *(const float4*)(p.rw_r_k + (size_t)l * 768 + c);
        cst[nt][3] = *(const float4*)(p.rw_w0 + ((size_t)l * 2 + n) * 768 + c); cst[nt][4] = *(const float4*)(p.rw_a0 + ((size_t)l * 2 + n) * 768 + c); }
    const uint4* srcw = (const uint4*)(p.Lwa + (size_t)((l * 2 + n) * 12 + hh) * 2 * 64 * 72);
    const uint4* srcg = (const uint4*)(p.Lg + (size_t)(l * 12 + hh) * 64 * 104);
    const uint4 wv0 = srcw[tid], wv1 = srcw[tid + 512], wv2 = tid < 128 ? srcw[tid + 1024] : make_uint4(0u, 0u, 0u, 0u);
    uint4 gv0 = make_uint4(0u, 0u, 0u, 0u), gv1 = gv0; if (n == 0) { gv0 = srcg[tid]; if (tid < 320) gv1 = srcg[tid + 512]; }
    {
        int kind, c8, col, rg;
        if (rw_map(tid, n, hh, kind, c8, col, rg)) {
            const int j0 = 8 * rg;
            const int ta = n == 0 ? s0 + j0 : s0 + 63 - j0 - 7;
            const float m0[8] = {P.m0a.x, P.m0a.y, P.m0a.z, P.m0a.w, P.m0b.x, P.m0b.y, P.m0b.z, P.m0b.w}, m1[8] = {P.m1a.x, P.m1a.y, P.m1a.z, P.m1a.w, P.m1b.x, P.m1b.y, P.m1b.z, P.m1b.w};
            unsigned vpk[8][4];
#pragma unroll
            for (int i = 0; i < 8; ++i) {
                const int tk = ta + i, j = n == 0 ? tk - s0 : s0 + 63 - tk;
                const uint4 pu = P.raw[i], cu = P.raw[i + 1], nu = P.raw[i + 2];
                const unsigned pw[4] = {pu.x, pu.y, pu.z, pu.w}, cw[4] = {cu.x, cu.y, cu.z, cu.w}, nw[4] = {nu.x, nu.y, nu.z, nu.w};
                float x[8];
#pragma unroll
                for (int e = 0; e < 4; ++e) { const float c0 = bfl(cw[e]), c1 = bfh(cw[e]);
                    x[2 * e] = c0 + m0[2 * e] * (bfl(pw[e]) - c0) + m1[2 * e] * (bfl(nw[e]) - c0); x[2 * e + 1] = c1 + m0[2 * e + 1] * (bfh(pw[e]) - c1) + m1[2 * e + 1] * (bfh(nw[e]) - c1); }
                if (kind == 0) { *(float4*)(rf + j * FLD + c8) = make_float4(x[0], x[1], x[2], x[3]); *(float4*)(rf + j * FLD + c8 + 4) = make_float4(x[4], x[5], x[6], x[7]); }
                else if (kind == 1) { *(float4*)(kf + j * FLD + c8) = make_float4(x[0], x[1], x[2], x[3]); *(float4*)(kf + j * FLD + c8 + 4) = make_float4(x[4], x[5], x[6], x[7]); }
                else if (kind == 2) {
#pragma unroll
                    for (int e = 0; e < 8; ++e) { const unsigned hbits = (unsigned)f2bf(x[e]); vpk[e][i >> 1] = (i & 1) ? (vpk[e][i >> 1] | (hbits << 16)) : hbits; }
                    if (n == 0) { uint4 o; o.x = pg8::cvt_pk_bf16(x[0], x[1]); o.y = pg8::cvt_pk_bf16(x[2], x[3]); o.z = pg8::cvt_pk_bf16(x[4], x[5]); o.w = pg8::cvt_pk_bf16(x[6], x[7]);
                        *(uint4*)(p.rw_vb + ((size_t)(bh * (TT / 64) + ci) * 64 + j) * 64 + c8) = o; } }
                else {
                    bf16_t* dst = kind == 3 ? Aw + j * RLD + c8 : (kind == 4 ? Aa + j * RLD + c8 : Ag + j * GLD + c8);
                    if (kind == 3) {
#pragma unroll
                        for (int e = 0; e < 8; ++e) x[e] = 1.0f - 2.0f * __builtin_amdgcn_rcpf(1.0f + __builtin_amdgcn_exp2f(2.8853900817779268f * x[e])); }
                    else if (kind == 5) {
#pragma unroll
                        for (int e = 0; e < 8; ++e) x[e] = __builtin_amdgcn_rcpf(1.0f + __builtin_amdgcn_exp2f(-1.4426950408889634f * x[e])); }
                    uint4 o; o.x = pg8::cvt_pk_bf16(x[0], x[1]); o.y = pg8::cvt_pk_bf16(x[2], x[3]); o.z = pg8::cvt_pk_bf16(x[4], x[5]); o.w = pg8::cvt_pk_bf16(x[6], x[7]); *(uint4*)dst = o;
                }
            }
            if (kind == 2) {
#pragma unroll
                for (int e = 0; e < 8; ++e) { uint4 o = make_uint4(vpk[e][0], vpk[e][1], vpk[e][2], vpk[e][3]);
                    if (n != 0) o = make_uint4((o.w << 16) | (o.w >> 16), (o.z << 16) | (o.z >> 16), (o.y << 16) | (o.y >> 16), (o.x << 16) | (o.x >> 16));
                    *(uint4*)(VT + (c8 + e) * RLD + j0) = o; }
            }
        }
    }
    for (int i = tid; i < 64 * 16; i += NT) { const int j = i >> 4, c = 48 + (i & 15); Aw[j * RLD + c] = 0; Aa[j * RLD + c] = 0; }
    { uint4* dw = (uint4*)Bw; dw[tid] = wv0; dw[tid + 512] = wv1; if (tid < 128) dw[tid + 1024] = wv2;
      if (n == 0) { uint4* dg = (uint4*)Bg; dg[tid] = gv0; if (tid < 320) dg[tid + 512] = gv1; } }
    rwkv_prefetch(p, l, unit_next, tid, P);
    lds_barrier();
    rw_f32x4 accw[2], acca[2], accg[2];
#pragma unroll
    for (int nt = 0; nt < 2; ++nt) { accw[nt] = (rw_f32x4){0.f, 0.f, 0.f, 0.f}; acca[nt] = accw[nt]; accg[nt] = accw[nt]; }
    mm_t<64>(accw, Aw, RLD, Bw, RLD, rb, ch, fr, q);
    mm_t<64>(acca, Aa, RLD, Ba, RLD, rb, ch, fr, q);
    if (n == 0) mm_t<96>(accg, Ag, GLD, Bg, GLD, rb, ch, fr, q);
    const int t = 16 * rb + fr, s = n == 0 ? s0 + t : s0 + 63 - t, g = b * TT + s;
    float kv[2][4], rv[2][4], kkr[2][4], av[2][4], lw[2][4], kd[2][4], G[2][4]; float ssq = 0.f, bon = 0.f;
#pragma unroll
    for (int nt = 0; nt < 2; ++nt) {
        const int c = 32 * ch + 16 * nt + 4 * q;
        const float4 k4 = *(const float4*)(kf + t * FLD + c), r4 = *(const float4*)(rf + t * FLD + c);
        const float4 kk4 = cst[nt][0], ka4 = cst[nt][1], rk4 = cst[nt][2], w04 = cst[nt][3], a04 = cst[nt][4];
        const float ke[4] = {k4.x, k4.y, k4.z, k4.w}, re[4] = {r4.x, r4.y, r4.z, r4.w}, kke[4] = {kk4.x, kk4.y, kk4.z, kk4.w}, kae[4] = {ka4.x, ka4.y, ka4.z, ka4.w}, rke[4] = {rk4.x, rk4.y, rk4.z, rk4.w}, w0e[4] = {w04.x, w04.y, w04.z, w04.w}, a0e[4] = {a04.x, a04.y, a04.z, a04.w};
#pragma unroll
        for (int j = 0; j < 4; ++j) {
            kv[nt][j] = ke[j]; rv[nt][j] = re[j]; kkr[nt][j] = ke[j] * kke[j]; ssq += kkr[nt][j] * kkr[nt][j];
            const float wpre = w0e[j] + accw[nt][j]; lw[nt][j] = -0.6065306597126334f * __builtin_amdgcn_rcpf(1.0f + __expf(-wpre));
            av[nt][j] = __builtin_amdgcn_rcpf(1.0f + __expf(-(a0e[j] + acca[nt][j])));
            kd[nt][j] = ke[j] * (1.0f + (av[nt][j] - 1.0f) * kae[j]); bon += re[j] * kd[nt][j] * rke[j];
            float x = lw[nt][j];
            x += __int_as_float(__builtin_amdgcn_update_dpp(0, __float_as_int(x), 0x111, 0xF, 0xF, true)); x += __int_as_float(__builtin_amdgcn_update_dpp(0, __float_as_int(x), 0x112, 0xF, 0xF, true));
            x += __int_as_float(__builtin_amdgcn_update_dpp(0, __float_as_int(x), 0x114, 0xF, 0xF, true)); x += __int_as_float(__builtin_amdgcn_update_dpp(0, __float_as_int(x), 0x118, 0xF, 0xF, true));
            G[nt][j] = x; if (fr == 15) btot[rb * 64 + c + j] = x;
        }
    }
    ssq += bperm_f(lane ^ 16, ssq); ssq += bperm_f(lane ^ 32, ssq); bon += bperm_f(lane ^ 16, bon); bon += bperm_f(lane ^ 32, bon);
    if (q == 0) { red[ch * 64 + t] = ssq; red[128 + ch * 64 + t] = bon; }
    lds_barrier();
    const float rnorm = 1.0f / fmaxf(sqrtf(red[t] + red[64 + t]), 1e-12f);
    if (ch == 0 && q == 0) p.bonus[((size_t)n * M + g) * 12 + hh] = red[128 + t] + red[192 + t];
    const size_t uoff = (size_t)unit * 4096;
#pragma unroll
    for (int nt = 0; nt < 2; ++nt)
#pragma unroll
        for (int j = 0; j < 4; ++j) { const int c = 32 * ch + 16 * nt + 4 * q + j; float pre = 0.f, tot = 0.f;
#pragma unroll
            for (int r2 = 0; r2 < 4; ++r2) { const float bt = btot[r2 * 64 + c]; tot += bt; if (r2 < rb) pre += bt; }
            G[nt][j] += pre; if (t == 63) GCv[c] = __expf(tot); }
#pragma unroll
    for (int nt = 0; nt < 2; ++nt) {
        const int c = 32 * ch + 16 * nt + 4 * q;
        float rt[4], kt[4], bt[4], kp[4];
#pragma unroll
        for (int j = 0; j < 4; ++j) { const float gam = __expf(G[nt][j]), ig = __expf(-G[nt][j]), gp = __expf(G[nt][j] - lw[nt][j]); const float kk = kkr[nt][j] * rnorm;
            rt[j] = rv[nt][j] * gam; kt[j] = kd[nt][j] * ig; bt[j] = kk * av[nt][j] * ig; kp[j] = kk * gp;
            KtT[(c + j) * RLD + t] = f2bf(kt[j]); BtT[(c + j) * RLD + t] = f2bf(bt[j]); kapT[(c + j) * RLD + t] = f2bf(kp[j]); }
        uint2 o; o.x = pg8::cvt_pk_bf16(rt[0], rt[1]); o.y = pg8::cvt_pk_bf16(rt[2], rt[3]); *(uint2*)(Rt + t * RLD + c) = o;
        o.x = pg8::cvt_pk_bf16(kt[0], kt[1]); o.y = pg8::cvt_pk_bf16(kt[2], kt[3]); *(uint2*)(Kt + t * RLD + c) = o;
        o.x = pg8::cvt_pk_bf16(bt[0], bt[1]); o.y = pg8::cvt_pk_bf16(bt[2], bt[3]); *(uint2*)(Bt + t * RLD + c) = o;
        o.x = pg8::cvt_pk_bf16(kp[0], kp[1]); o.y = pg8::cvt_pk_bf16(kp[2], kp[3]); *(uint2*)(kap + t * RLD + c) = o;
        if (n == 0) { o.x = pg8::cvt_pk_bf16(accg[nt][0], accg[nt][1]); o.y = pg8::cvt_pk_bf16(accg[nt][2], accg[nt][3]); *(uint2*)(p.rw_gb + ((size_t)(bh * (TT / 64) + ci) * 64 + t) * 64 + c) = o; }
    }
    lds_barrier();
#define RW_ZERO(a) do { a[0] = (rw_f32x4){0.f, 0.f, 0.f, 0.f}; a[1] = a[0]; } while (0)
#define RW_STORE_BF(dst, a) do { _Pragma("unroll") for (int _nt = 0; _nt < 2; ++_nt) { uint2 _o; _o.x = pg8::cvt_pk_bf16(a[_nt][0], a[_nt][1]); _o.y = pg8::cvt_pk_bf16(a[_nt][2], a[_nt][3]); \
        *(uint2*)((dst) + t * RLD + 32 * ch + 16 * _nt + 4 * q) = _o; } } while (0)
    { rw_f32x4 a1[2], a2[2], a3[2], a4[2], a5[2]; RW_ZERO(a1); RW_ZERO(a2); RW_ZERO(a3); RW_ZERO(a4); RW_ZERO(a5);
      mm_t<64>(a1, kap, RLD, Bt, RLD, rb, ch, fr, q);
      mm_t<64>(a2, Bt, RLD, kap, RLD, rb, ch, fr, q);
      mm_t<64>(a3, kap, RLD, Kt, RLD, rb, ch, fr, q);
      mm_t<64>(a4, Rt, RLD, Kt, RLD, rb, ch, fr, q);
      mm_t<64>(a5, Rt, RLD, Bt, RLD, rb, ch, fr, q);
      rw_f32x4 t1[2];
#pragma unroll
      for (int nt = 0; nt < 2; ++nt)
#pragma unroll
          for (int j = 0; j < 4; ++j) { const int cc = 32 * ch + 16 * nt + 4 * q + j;
              a1[nt][j] = cc < t ? -a1[nt][j] : 0.f; t1[nt][j] = a1[nt][j] + (cc == t ? 1.f : 0.f);
              a2[nt][j] = t < cc ? -a2[nt][j] : 0.f;
              a3[nt][j] = cc < t ? a3[nt][j] : 0.f; a4[nt][j] = cc <= t ? a4[nt][j] : 0.f; a5[nt][j] = cc <= t ? a5[nt][j] : 0.f; }
      RW_STORE_BF(Ms[0], a1); RW_STORE_BF(MTs[0], a2); RW_STORE_BF(Ts[0], t1); RW_STORE_BF(Akk, a3); RW_STORE_BF(Ark, a4); RW_STORE_BF(Arb, a5); }
    lds_barrier();
    { rw_f32x4 a1[2], a2[2], a3[2]; RW_ZERO(a1); RW_ZERO(a2); RW_ZERO(a3);
      mm_t<64>(a1, VT, RLD, Akk, RLD, rb, ch, fr, q);
      mm_t<64>(a2, Ms[0], RLD, MTs[0], RLD, rb, ch, fr, q);
      mm_t<64>(a3, MTs[0], RLD, Ms[0], RLD, rb, ch, fr, q);
      RW_STORE_BF(XT, a1); RW_STORE_BF(Ms[1], a2); RW_STORE_BF(MTs[1], a3); }
    lds_barrier();
#pragma unroll
    for (int k = 1; k <= 5; ++k) {
        const bf16_t* Tk = Ts[(k + 1) & 1]; bf16_t* Tn = Ts[k & 1];
        rw_f32x4 a1[2]; RW_ZERO(a1);
        mm_t<64>(a1, Tk, RLD, MTs[k & 1], RLD, rb, ch, fr, q);
#pragma unroll
        for (int nt = 0; nt < 2; ++nt) { const uint2 o = *(const uint2*)(Tk + t * RLD + 32 * ch + 16 * nt + 4 * q); a1[nt][0] += bfl(o.x); a1[nt][1] += bfh(o.x); a1[nt][2] += bfl(o.y); a1[nt][3] += bfh(o.y); }
        RW_STORE_BF(Tn, a1);
        if (k < 5) { rw_f32x4 a2[2], a3[2]; RW_ZERO(a2); RW_ZERO(a3);
            mm_t<64>(a2, Ms[k & 1], RLD, MTs[k & 1], RLD, rb, ch, fr, q);
            mm_t<64>(a3, MTs[k & 1], RLD, Ms[k & 1], RLD, rb, ch, fr, q);
            RW_STORE_BF(Ms[(k + 1) & 1], a2); RW_STORE_BF(MTs[(k + 1) & 1], a3); }
        lds_barrier();
    }
    { rw_f32x4 a1[2], a2[2]; RW_ZERO(a1); RW_ZERO(a2);
      mm_t<64>(a1, kapT, RLD, Ts[1], RLD, rb, ch, fr, q);
      mm_t<64>(a2, XT, RLD, Ts[1], RLD, rb, ch, fr, q);
      RW_STORE_BF(Ms[0], a1); RW_STORE_BF(MTs[0], a2); }
    lds_barrier();
    { const bf16_t* WT = Ms[0]; const bf16_t* U0T = MTs[0];
      rw_f32x4 a1[2]; RW_ZERO(a1); mm_t<64>(a1, BtT, RLD, WT, RLD, rb, ch, fr, q);
      { const float gc = GCv[t];
#pragma unroll
        for (int nt = 0; nt < 2; ++nt) { uint2 o; float e[4];
#pragma unroll
            for (int j = 0; j < 4; ++j) e[j] = gc * ((32 * ch + 16 * nt + 4 * q + j == t ? 1.f : 0.f) - a1[nt][j]);
            o.x = pg8::cvt_pk_bf16(e[0], e[1]); o.y = pg8::cvt_pk_bf16(e[2], e[3]); *(uint2*)(p.rw_P + uoff + t * 64 + 32 * ch + 16 * nt + 4 * q) = o; } }
      rw_f32x4 a2[2], a3[2]; RW_ZERO(a2); RW_ZERO(a3); mm_t<64>(a2, VT, RLD, KtT, RLD, rb, ch, fr, q); mm_t<64>(a3, U0T, RLD, BtT, RLD, rb, ch, fr, q);
#pragma unroll
      for (int nt = 0; nt < 2; ++nt) { const int c = 32 * ch + 16 * nt + 4 * q; const float4 gc4 = *(const float4*)(GCv + c);
          *(float4*)(p.rw_QT + uoff + t * 64 + c) = make_float4(gc4.x * (a2[nt][0] - a3[nt][0]), gc4.y * (a2[nt][1] - a3[nt][1]), gc4.z * (a2[nt][2] - a3[nt][2]), gc4.w * (a2[nt][3] - a3[nt][3])); }
      rw_f32x4 a4[2]; RW_ZERO(a4); mm_t<64>(a4, Arb, RLD, WT, RLD, rb, ch, fr, q);
#pragma unroll
      for (int nt = 0; nt < 2; ++nt) { const int c = 32 * ch + 16 * nt + 4 * q; const uint2 r2 = *(const uint2*)(Rt + t * RLD + c); uint2 o;
          o.x = pg8::cvt_pk_bf16(bfl(r2.x) - a4[nt][0], bfh(r2.x) - a4[nt][1]); o.y = pg8::cvt_pk_bf16(bfl(r2.y) - a4[nt][2], bfh(r2.y) - a4[nt][3]); *(uint2*)(p.rw_Ry + uoff + t * 64 + c) = o; }
      rw_f32x4 a5[2], a6[2]; RW_ZERO(a5); RW_ZERO(a6); mm_t<64>(a5, Ark, RLD, VT, RLD, rb, ch, fr, q); mm_t<64>(a6, Arb, RLD, U0T, RLD, rb, ch, fr, q);
#pragma unroll
      for (int nt = 0; nt < 2; ++nt) { const int c = 32 * ch + 16 * nt + 4 * q; *(float4*)(p.rw_Y0 + uoff + t * 64 + c) = make_float4(a5[nt][0] - a6[nt][0], a5[nt][1] - a6[nt][1], a5[nt][2] - a6[nt][2], a5[nt][3] - a6[nt][3]); } }
#undef RW_ZERO
#undef RW_STORE_BF
}

__device__ __forceinline__ void rwkv_chain(const Params& p, unsigned char* Lb, int chain) {
    const int tid = otid(), wid = tid >> 6, lane = tid & 63, rb = wid & 3, ch = wid >> 2, fr = lane & 15, q = lane >> 4;
    const int n = chain / 48, bh = chain % 48;
    bf16_t* HT[2] = {(bf16_t*)Lb, (bf16_t*)(Lb + 9216)};
    rw_f32x4 hacc[2];
    hacc[0] = (rw_f32x4){0.f, 0.f, 0.f, 0.f}; hacc[1] = hacc[0];
    __syncthreads();
    auto uoff_of = [&](int step) { const int ci = n == 0 ? step : (step < 4 ? 3 - step : (TT / 64 - 1) - (step - 4)); return (size_t)(((bh * (TT / 64) + ci) << 1) | n) * 4096; };
    struct Ops { rw_bf16x8 p0, p1; float4 q0, q1; };
    auto load_ops = [&](int step, Ops& o) { const size_t uo = uoff_of(step); const bf16_t* Pp = p.rw_P + uo + (16 * rb + fr) * 64 + 8 * q; o.p0 = *(const rw_bf16x8*)Pp; o.p1 = *(const rw_bf16x8*)(Pp + 32);
        o.q0 = *(const float4*)(p.rw_QT + uo + (32 * ch + fr) * 64 + 16 * rb + 4 * q); o.q1 = *(const float4*)(p.rw_QT + uo + (32 * ch + 16 + fr) * 64 + 16 * rb + 4 * q); };
    auto do_step = [&](int step, const Ops& o) {
        const size_t uoff = uoff_of(step);
        bf16_t* hb = HT[step & 1];
#pragma unroll
        for (int nt = 0; nt < 2; ++nt) { uint2 w; w.x = pg8::cvt_pk_bf16(hacc[nt][0], hacc[nt][1]); w.y = pg8::cvt_pk_bf16(hacc[nt][2], hacc[nt][3]);
            const int v = 32 * ch + 16 * nt + fr, k0 = 16 * rb + 4 * q;
            *(uint2*)(hb + v * RLD + k0) = w; *(uint2*)(p.rw_H0 + uoff + v * 64 + k0) = w; }
        lds_barrier();
#pragma unroll
        for (int nt = 0; nt < 2; ++nt) {
            const bf16_t* bp = hb + (32 * ch + 16 * nt + fr) * RLD + 8 * q;
            const rw_bf16x8 b0 = *(const rw_bf16x8*)bp, b1 = *(const rw_bf16x8*)(bp + 32);
            const float4 cq = nt == 0 ? o.q0 : o.q1;
            rw_f32x4 c = (rw_f32x4){cq.x, cq.y, cq.z, cq.w};
            c = __builtin_amdgcn_mfma_f32_16x16x32_bf16(o.p0, b0, c, 0, 0, 0);
            hacc[nt] = __builtin_amdgcn_mfma_f32_16x16x32_bf16(o.p1, b1, c, 0, 0, 0);
        }
    };
    Ops A, B; load_ops(0, A); load_ops(1, B);
    for (int step = 0; step < TT / 64; step += 2) {
        do_step(step, A); if (step + 2 < TT / 64) load_ops(step + 2, A);
        do_step(step + 1, B); if (step + 3 < TT / 64) load_ops(step + 3, B);
    }
}

__device__ __forceinline__ void rwkv_out(const Params& p, unsigned char* Lb, int l, int unit3) {
    const int tid = otid(), wid = tid >> 6, lane = tid & 63, rb = wid & 3, ch = wid >> 2, fr = lane & 15, q = lane >> 4;
    const int ci = unit3 % (TT / 64), bh = unit3 / (TT / 64), b = bh / 12, hh = bh % 12;
    float* red = (float*)Lb;
    const int t = 16 * rb + fr, g = b * TT + ci * 64 + t;
    rw_f32x4 y[2]; y[0] = (rw_f32x4){0.f, 0.f, 0.f, 0.f}; y[1] = y[0];
#pragma unroll
    for (int n = 0; n < 2; ++n) {
        const size_t uoff = (size_t)(((bh * (TT / 64) + ci) << 1) | n) * 4096;
        const int row = n == 0 ? t : 63 - t;
        const bf16_t* ap = p.rw_Ry + uoff + row * 64 + 8 * q;
        const rw_bf16x8 a0 = *(const rw_bf16x8*)ap, a1 = *(const rw_bf16x8*)(ap + 32);
#pragma unroll
        for (int nt = 0; nt < 2; ++nt) {
            const int c = 32 * ch + 16 * nt;
            const bf16_t* bp = p.rw_H0 + uoff + (c + fr) * 64 + 8 * q;
            const rw_bf16x8 b0 = *(const rw_bf16x8*)bp, b1 = *(const rw_bf16x8*)(bp + 32);
            const float4 y0 = *(const float4*)(p.rw_Y0 + uoff + row * 64 + c + 4 * q);
            rw_f32x4 acc = (rw_f32x4){y0.x, y0.y, y0.z, y0.w};
            acc = __builtin_amdgcn_mfma_f32_16x16x32_bf16(b0, a0, acc, 0, 0, 0);
            acc = __builtin_amdgcn_mfma_f32_16x16x32_bf16(b1, a1, acc, 0, 0, 0);
            y[nt] += acc;
        }
    }
    float s1 = 0.f, s2 = 0.f;
#pragma unroll
    for (int nt = 0; nt < 2; ++nt)
#pragma unroll
        for (int j = 0; j < 4; ++j) { s1 += y[nt][j]; s2 += y[nt][j] * y[nt][j]; }
    s1 += bperm_f(lane ^ 16, s1); s1 += bperm_f(lane ^ 32, s1); s2 += bperm_f(lane ^ 16, s2); s2 += bperm_f(lane ^ 32, s2);
    __syncthreads();
    if (q == 0) { red[ch * 64 + t] = s1; red[128 + ch * 64 + t] = s2; }
    __syncthreads();
    const float mean = (red[t] + red[64 + t]) * (1.0f / 64.0f), var = fmaxf((red[128 + t] + red[192 + t]) * (1.0f / 64.0f) - mean * mean, 0.f), rstd = rsqrtf(var + 64e-5f);
    const float bon = p.bonus[(size_t)g * 12 + hh] + p.bonus[((size_t)M + g) * 12 + hh];
    const float* gng = p.rw_gn_g + (size_t)l * 768 + hh * 64; const float* gnb = p.rw_gn_b + (size_t)l * 768 + hh * 64;
    const size_t coff = ((size_t)(bh * (TT / 64) + ci) * 64 + t) * 64;
#pragma unroll
    for (int nt = 0; nt < 2; ++nt) {
        const int c = 32 * ch + 16 * nt + 4 * q;
        const float4 gg = *(const float4*)(gng + c), gb = *(const float4*)(gnb + c);
        const uint2 vv = *(const uint2*)(p.rw_vb + coff + c), gt = *(const uint2*)(p.rw_gb + coff + c);
        const float o0 = ((y[nt][0] - mean) * rstd * gg.x + gb.x + bon * bfl(vv.x)) * bfl(gt.x), o1 = ((y[nt][1] - mean) * rstd * gg.y + gb.y + bon * bfh(vv.x)) * bfh(gt.x);
        const float o2 = ((y[nt][2] - mean) * rstd * gg.z + gb.z + bon * bfl(vv.y)) * bfl(gt.y), o3 = ((y[nt][3] - mean) * rstd * gg.w + gb.w + bon * bfh(vv.y)) * bfh(gt.y);
        uint2 o; o.x = pg8::cvt_pk_bf16(o0, o1); o.y = pg8::cvt_pk_bf16(o2, o3);
        *(uint2*)(p.mix + (size_t)g * D + 1280 + hh * 64 + c) = o;
    }
}

typedef short attn_bf16x8 __attribute__((ext_vector_type(8)));
typedef float attn_f32x4 __attribute__((ext_vector_type(4)));
constexpr int ATT_LAT = NB * 12 * 64 * 4, ATT_CTX = NB * 12 * (LC / 16), ATT_TASKS = ATT_LAT + ATT_CTX;
__device__ __forceinline__ attn_bf16x8 ld_frag16(const bf16_t* ptr) { return *(const attn_bf16x8*)ptr; }
__device__ __forceinline__ attn_bf16x8 ld_frag8x2(const bf16_t* p0, const bf16_t* p1) {
    const uint2 a = *(const uint2*)p0, b = *(const uint2*)p1; uint4 r; r.x = a.x; r.y = a.y; r.z = b.x; r.w = b.y; return *(const attn_bf16x8*)&r; }
struct AttnFrag { attn_bf16x8 k[2][2]; attn_bf16x8 v[4]; };
__device__ __forceinline__ void attn_load(AttnFrag& F, const bf16_t* Kh  , const bf16_t* Vh  , int s0  , int qi, int q) {
#pragma unroll
    for (int t = 0; t < 2; ++t)
#pragma unroll
        for (int ks = 0; ks < 2; ++ks) F.k[t][ks] = ld_frag16(Kh + ((size_t)(((s0 >> 4) + t) * 2 + ks) * 16 + qi) * 32 + 8 * q);
#pragma unroll
    for (int db = 0; db < 4; ++db) F.v[db] = ld_frag16(Vh + ((size_t)(s0 >> 5) * 64 + 16 * db + qi) * 32 + 8 * q);
}
__device__ __forceinline__ void attn_compute(const AttnFrag& F, const attn_bf16x8 (&qf)[2], int lane, float& m, float& l, attn_f32x4 (&oacc)[4],
                                             bool win, const float* brow  , unsigned vmask  , const int (&boff)[8]) {
    attn_f32x4 st[2];
#pragma unroll
    for (int t = 0; t < 2; ++t) {
        attn_f32x4 z4 = {0.f, 0.f, 0.f, 0.f};
        z4 = __builtin_amdgcn_mfma_f32_16x16x32_bf16(F.k[t][0], qf[0], z4, 0, 0, 0);
        st[t] = __builtin_amdgcn_mfma_f32_16x16x32_bf16(F.k[t][1], qf[1], z4, 0, 0, 0);
    }
    float sc[8]; float mx = -1e30f;
#pragma unroll
    for (int i = 0; i < 8; ++i) {
        float s = st[i >> 2][i & 3] * 0.18033688011112042f;
        if (win) s = ((vmask >> i) & 1u) ? s + brow[boff[i]] : -1e30f;
        sc[i] = s; mx = fmaxf(mx, s);
    }
    mx = fmaxf(mx, bperm_f(lane ^ 16, mx)); mx = fmaxf(mx, bperm_f(lane ^ 32, mx));
    if (__any(mx > m)) {
        const float mn = fmaxf(m, mx), alpha = __builtin_amdgcn_exp2f(m - mn);
        l *= alpha; m = mn;
#pragma unroll
        for (int db = 0; db < 4; ++db) oacc[db] *= alpha;
    }
    float ps = 0.f; float pv[8];
#pragma unroll
    for (int i = 0; i < 8; ++i) { pv[i] = __builtin_amdgcn_exp2f(sc[i] - m); ps += pv[i]; }
    l += ps;
    uint4 pk; pk.x = pg8::cvt_pk_bf16(pv[0], pv[1]); pk.y = pg8::cvt_pk_bf16(pv[2], pv[3]); pk.z = pg8::cvt_pk_bf16(pv[4], pv[5]); pk.w = pg8::cvt_pk_bf16(pv[6], pv[7]);
    const attn_bf16x8 pb = *(const attn_bf16x8*)&pk;
#pragma unroll
    for (int db = 0; db < 4; ++db) oacc[db] = __builtin_amdgcn_mfma_f32_16x16x32_bf16(F.v[db], pb, oacc[db], 0, 0, 0);
}
constexpr int ATT_LAT2 = NB * 12 * 64 * 2, ATT_CTX2 = NB * 12 * (LC / 32), ATT_TASKS2 = ATT_LAT2 + ATT_CTX2;
__device__ __forceinline__ void attn_task2(const Params& p, const float* rpbs  , int task) {
    const int lane = otid() & 63, qi = lane & 15, q = lane >> 4;
    const bool lat = task < ATT_LAT2;
    int bh, qrow = 0, qp;
    if (lat) { bh = task >> 7; const int rem = task & 127; qrow = rem >> 1; qp = rem & 1; }
    else { const int t2 = task - ATT_LAT2; bh = t2 >> 3; qp = t2 & 7; }
    const int b = bh / 12, hh = bh % 12;
    const bf16_t* Kh = p.Ka + (size_t)bh * TT * 64; const bf16_t* Vh = p.Vt + (size_t)bh * 64 * TT;
    int sq[2]; attn_bf16x8 qa[2][2], qr[2][2];
#pragma unroll
    for (int u = 0; u < 2; ++u) {
        sq[u] = lat ? LC + qrow * 64 + (2 * qp + u) * 16 + qi : (2 * qp + u) * 16 + qi;
        const bf16_t* qp0 = p.Qa + ((size_t)bh * TT + sq[u]) * 64 + 8 * q; qa[u][0] = ld_frag16(qp0); qa[u][1] = ld_frag16(qp0 + 32); qr[u][0] = qa[u][0]; qr[u][1] = qa[u][1];
        if (lat) { const bf16_t* qp1 = p.Qr + ((size_t)bh * L + (sq[u] - LC)) * 64 + 8 * q; qr[u][0] = ld_frag16(qp1); qr[u][1] = ld_frag16(qp1 + 32); }
    }
    const int krow0 = min(max(qrow - 4, 0), 56);
    bool need0[2], need1[2]; unsigned vm0[2], vm1[2]; int boff[2][8];
#pragma unroll
    for (int u = 0; u < 2; ++u) { const int qb = 2 * qp + u, qc = qb * 16 + qi, kcol0 = min(max(qc - 8, 0), 48);
        const int clo = min(max(qb * 16 - 8, 0), 48), chi = min(max(qb * 16 + 7, 0), 48) + 16; need0[u] = clo < 32; need1[u] = chi > 32; vm0[u] = 0u; vm1[u] = 0u;
#pragma unroll
        for (int i = 0; i < 8; ++i) { const int kc = 16 * (i >> 2) + 4 * q + (i & 3); boff[u][i] = kc - qc + 15; vm0[u] |= ((unsigned)(kc - kcol0) < 16u ? 1u : 0u) << i; vm1[u] |= ((unsigned)(kc + 32 - kcol0) < 16u ? 1u : 0u) << i; } }
    const bool cb0 = need0[0] || need0[1], cb1 = need1[0] || need1[1]; const int ncb = (cb0 && cb1) ? 2 : 1, cbo = cb0 ? 0 : 1;
    const int nsteps = lat ? 8 + 8 * ncb : 8;
    float m[2] = {-1e30f, -1e30f}, l[2] = {0.f, 0.f}; attn_f32x4 oacc[2][4];
#pragma unroll
    for (int u = 0; u < 2; ++u)
#pragma unroll
        for (int db = 0; db < 4; ++db) oacc[u][db] = (attn_f32x4){0.f, 0.f, 0.f, 0.f};
#define ATT_S0(s, s0v, krv, cbv) do { if ((s) < 8) { s0v = (s) * 32; krv = 0; cbv = 0; } else { const int _w = (s) - 8; krv = ncb == 2 ? (_w >> 1) : _w; cbv = ncb == 2 ? (_w & 1) : cbo; s0v = LC + (krow0 + krv) * 64 + cbv * 32; } } while (0)
#define ATT_LOAD(F, s) do { int _s0, _kr, _cb; ATT_S0((s), _s0, _kr, _cb); attn_load(F, Kh, Vh, _s0, qi, q); } while (0)
#define ATT_COMP(F, s) do { int _s0, _kr, _cb; ATT_S0((s), _s0, _kr, _cb); const bool _w = (s) >= 8; const float* _br = rpbs + hh * 465 + (krow0 + _kr - qrow + 7) * 31; \
        _Pragma("unroll") for (int u = 0; u < 2; ++u) if (!_w || (_cb == 0 ? need0[u] : need1[u])) attn_compute(F, _w ? qr[u] : qa[u], lane, m[u], l[u], oacc[u], _w, _br + _cb * 32, _cb ? vm1[u] : vm0[u], boff[u]); } while (0)
    AttnFrag FA, FB;
    ATT_LOAD(FA, 0);
    for (int s = 0; s < nsteps; s += 2) {
        ATT_LOAD(FB, s + 1);
        ATT_COMP(FA, s);
        if (s + 2 < nsteps) ATT_LOAD(FA, s + 2);
        ATT_COMP(FB, s + 1);
    }
#undef ATT_S0
#undef ATT_LOAD
#undef ATT_COMP
#pragma unroll
    for (int u = 0; u < 2; ++u) {
        float lt = l[u]; lt += bperm_f(lane ^ 16, lt); lt += bperm_f(lane ^ 32, lt);
        const float rinv = 1.0f / lt;
        bf16_t* op = p.mix + (size_t)(b * TT + sq[u]) * D + 512 + hh * 64 + 4 * q;
#pragma unroll
        for (int db = 0; db < 4; ++db) { uint2 w; w.x = pg8::cvt_pk_bf16(oacc[u][db][0] * rinv, oacc[u][db][1] * rinv); w.y = pg8::cvt_pk_bf16(oacc[u][db][2] * rinv, oacc[u][db][3] * rinv); *(uint2*)(op + 16 * db) = w; }
    }
}

constexpr int RT_LD = 2052;
__device__ __forceinline__ void phase_router(const Params& p, unsigned char* Lb, int l, int bid, int nb) {
    const int tix = otid(), wid = tix >> 6, lane = tix & 63;
    float* At = (float*)Lb;
    float* Pp = At + 16 * RT_LD;
    int* ent = (int*)(Pp + 2 * 16 * 64);
    int* lcnt = ent + 480 * 4; int* lbase = lcnt + 64;
    const float* gam = p.norm2_g + (size_t)l * D;
    __syncthreads();
    if (tix < 64) lcnt[tix] = 0;
    int nloc = 0;
    const bool latonly = (l == 1);
    for (int tile = bid; tile < (latonly ? NB * L / 16 : M / 16); tile += nb, ++nloc) {
        const int g0 = latonly ? (tile >> 8) * TT + LC + (tile & 255) * 16 : tile * 16;
        __syncthreads();
#pragma unroll 1
        for (int rr = 0; rr < 2; ++rr) {
            const int r = 2 * wid + rr, g = g0 + r;
            const float* xr = p.xcur + (size_t)g * D;
            float4 v[8]; float ss = 0.f;
#pragma unroll
            for (int i = 0; i < 8; ++i) { v[i] = *(const float4*)(xr + (i * 64 + lane) * 4); ss += v[i].x * v[i].x + v[i].y * v[i].y + v[i].z * v[i].z + v[i].w * v[i].w; }
            ss = wave_sum(ss);
            const float rs = rsqrtf(ss * (1.0f / D) + 1e-6f);
            const float* mrow = p.mod + (size_t)(l * 5 + modrow(g)) * 6 * D; const float* sh = mrow + 3 * D; const float* sc = mrow + 4 * D;
#pragma unroll
            for (int i = 0; i < 8; ++i) {
                const int d = (i * 64 + lane) * 4;
                const float4 gg = *(const float4*)(gam + d), s4 = *(const float4*)(sh + d), c4 = *(const float4*)(sc + d);
                float4 o;
                o.x = v[i].x * rs * gg.x * (1.0f + c4.x) + s4.x; o.y = v[i].y * rs * gg.y * (1.0f + c4.y) + s4.y; o.z = v[i].z * rs * gg.z * (1.0f + c4.z) + s4.z; o.w = v[i].w * rs * gg.w * (1.0f + c4.w) + s4.w;
                uint2 pk; pk.x = pg8::cvt_pk_bf16(o.x, o.y); pk.y = pg8::cvt_pk_bf16(o.z, o.w);
                *(uint2*)(p.h + (size_t)g * D + d) = pk;
                *(float4*)(At + r * RT_LD + d) = o;
            }
        }
        __syncthreads();
        {
            const int nt = wid & 3, kh = wid >> 2, fr = lane & 15, q = lane >> 4;
            pg8::f32x4 acc = {0.f, 0.f, 0.f, 0.f};
            const float* wp = p.Wr + (((size_t)(l * 128 + kh * 64) * 4 + nt) * 64 + lane) * 4;
            const float* ap = At + fr * RT_LD + kh * 1024 + 4 * q;
#pragma unroll 16
            for (int j = 0; j < 64; ++j) {
                const float4 a4 = *(const float4*)(ap + 16 * j), b4 = *(const float4*)(wp + (size_t)j * 1024);
                acc = __builtin_amdgcn_mfma_f32_16x16x4f32(a4.x, b4.x, acc, 0, 0, 0); acc = __builtin_amdgcn_mfma_f32_16x16x4f32(a4.y, b4.y, acc, 0, 0, 0);
                acc = __builtin_amdgcn_mfma_f32_16x16x4f32(a4.z, b4.z, acc, 0, 0, 0); acc = __builtin_amdgcn_mfma_f32_16x16x4f32(a4.w, b4.w, acc, 0, 0, 0);
            }
#pragma unroll
            for (int jj = 0; jj < 4; ++jj) Pp[(kh * 16 + 4 * q + jj) * 64 + 16 * nt + fr] = acc[jj];
        }
        __syncthreads();
#pragma unroll 1
        for (int rr = 0; rr < 2; ++rr) {
            const int r = 2 * wid + rr, g = g0 + r;
            const float score = 1.0f / (1.0f + expf(-(Pp[r * 64 + lane] + Pp[(16 + r) * 64 + lane])));
            float val = score + p.router_bias[l * NEXP + lane];
            int myidx[TOPK]; float mysc[TOPK]; float tot = 0.f;
#pragma unroll
            for (int k = 0; k < TOPK; ++k) {
                float bv = val; int bi = lane;
#pragma unroll
                for (int o = 32; o >= 1; o >>= 1) { const float ov = bperm_f(lane ^ o, bv); const int oi = bperm_i(lane ^ o, bi); if (ov > bv || (ov == bv && oi < bi)) { bv = ov; bi = oi; } }
                const float sc_k = bperm_f(bi, score);
                myidx[k] = bi; mysc[k] = sc_k; tot += sc_k;
                if (lane == bi) val = -INFINITY;
            }
            if (lane < TOPK) {
                int e = myidx[0]; float w = mysc[0];
#pragma unroll
                for (int k = 1; k < TOPK; ++k) if (lane == k) { e = myidx[k]; w = mysc[k]; }
                w = w / tot * 2.5f;
                p.sel[g * TOPK + lane] = e; p.selw[g * TOPK + lane] = w;
                const int lp = atomicAdd(&lcnt[e], 1);
                int* en = ent + ((nloc * 16 + r) * TOPK + lane) * 4; en[0] = e; en[1] = __float_as_int(w); en[2] = g * 8 + lane; en[3] = lp;
            }
        }
    }
    __syncthreads();
    if (tix < 64) lbase[tix] = lcnt[tix] ? atomicAdd(p.cnt + l * NEXP + tix, lcnt[tix]) : 0;
    __syncthreads();
    for (int i = tix; i < nloc * 16 * TOPK; i += NT) {
        const int e = ent[i * 4], gk = ent[i * 4 + 2], pos = lbase[e] + ent[i * 4 + 3];
        p.ltok[(size_t)e * LCAP + pos] = gk >> 3; p.lw[(size_t)e * LCAP + pos] = __int_as_float(ent[i * 4 + 1]); p.tpos[(gk >> 3) * TOPK + (gk & 7)] = pos;
    }
}

constexpr int MAXU = 17;
__device__ __forceinline__ void moe_tables(const Params& p, LAS int* tab, int lc) {
    const int tix = otid();
    __syncthreads();
    if (tix == 0) { int ts = 0, of = 0;
        for (int e = 0; e < NEXP; ++e) { const int c = __hip_atomic_load(p.cnt + lc * NEXP + e, __ATOMIC_RELAXED, __HIP_MEMORY_SCOPE_AGENT); tab[e] = ts; tab[66 + e] = of; tab[132 + e] = c; ts += (c + 255) / 256; of += (c + 255) / 256 * 256; }
        tab[NEXP] = ts; tab[66 + NEXP] = of; ts += M / 256; of += M;
        tab[65] = ts; tab[66 + 65] = of; }
    __syncthreads();
}
struct MoeSched {
    const LAS int* tab; const LAS unsigned* rowtab; int NPN, G, c, total; unsigned rowbytes; const char* Bt; size_t bstride;
    __device__ __forceinline__ bool next(int i, pg8::Unit& u) const {
        const int Lq = i * G + c; if (Lq >= total) return false;
        const int rt = Lq / NPN; u.pn = Lq - rt * NPN;
        int lo = 0, hi = 64;
        while (lo < hi) { const int mid = (lo + hi + 1) >> 1; if (tab[mid] <= rt) lo = mid; else hi = mid - 1; }
        u.e = lo; u.pm = rt - tab[lo]; u.ord = i; return true;
    }
    __device__ __forceinline__ unsigned arow(const pg8::Unit& u, int r) const { return rowtab[u.ord * 256 + r] * rowbytes; }
    __device__ __forceinline__ const char* bptr(const pg8::Unit& u) const { return Bt + (size_t)u.e * bstride + (size_t)u.pn * 256 * rowbytes; }
};
struct EpiGU {
    bf16_t* U; const LAS int* tab;
    __device__ __forceinline__ void operator()(const pg8::f32x4 (&acc)[2][2][4][2], const pg8::Unit& u, int wr, int wc, int fr, int fq) const {
        const int cn = (u.e < NEXP ? tab[132 + u.e] : M), off = tab[66 + u.e], col0 = u.pn * 128 + wc * 32 + 8 * fq;
#pragma unroll
        for (int ai = 0; ai < 2; ++ai)
#pragma unroll
            for (int m = 0; m < 4; ++m) { const int i = u.pm * 256 + ai * 128 + wr * 64 + m * 16 + fr;
                if (i < cn) { float o[8];
#pragma unroll
                    for (int n = 0; n < 2; ++n)
#pragma unroll
                        for (int j = 0; j < 4; ++j) { const float gv = acc[ai][0][m][n][j], uv = acc[ai][1][m][n][j]; o[n * 4 + j] = gv * __builtin_amdgcn_rcpf(1.0f + __expf(-gv)) * uv; }
                    pg8::u32x4 w; w.x = pg8::cvt_pk_bf16(o[0], o[1]); w.y = pg8::cvt_pk_bf16(o[2], o[3]); w.z = pg8::cvt_pk_bf16(o[4], o[5]); w.w = pg8::cvt_pk_bf16(o[6], o[7]);
                    *(pg8::u32x4*)(U + (size_t)(off + i) * DE + col0) = w; } }
    }
};
struct EpiDown {
    bf16_t* Y; const LAS int* tab;
    __device__ __forceinline__ void operator()(const pg8::f32x4 (&acc)[2][2][4][2], const pg8::Unit& u, int wr, int wc, int fr, int fq) const {
        const int cn = (u.e < NEXP ? tab[132 + u.e] : M), off = tab[66 + u.e], col0 = u.pn * 256 + wc * 32 + 8 * fq;
#pragma unroll
        for (int ai = 0; ai < 2; ++ai)
#pragma unroll
            for (int m = 0; m < 4; ++m) { const int i = u.pm * 256 + ai * 128 + wr * 64 + m * 16 + fr;
                if (i < cn) { bf16_t* rowp = Y + (size_t)(off + i) * D + col0;
#pragma unroll
                    for (int bj = 0; bj < 2; ++bj) { const pg8::f32x4 v0 = acc[ai][bj][m][0], v1 = acc[ai][bj][m][1];
                        pg8::u32x4 w; w.x = pg8::cvt_pk_bf16(v0[0], v0[1]); w.y = pg8::cvt_pk_bf16(v0[2], v0[3]); w.z = pg8::cvt_pk_bf16(v1[0], v1[1]); w.w = pg8::cvt_pk_bf16(v1[2], v1[3]);
                        *(pg8::u32x4*)(rowp + bj * 128) = w; } } }
    }
};
template <bool DOWN>
__device__ __forceinline__ void phase_gemm_moe(const Params& p, LAS unsigned char* stage, LAS int* tab, LAS unsigned* rowtab, int l, int bid, int nb) {
    const int tix = otid();
    moe_tables(p, tab, l);
    MoeSched S; S.tab = tab; S.rowtab = rowtab; S.NPN = DOWN ? 8 : 4; S.G = nb; S.c = (nb % 8 == 0) ? (bid % 8) * (nb / 8) + bid / 8 : bid; S.total = tab[65] * S.NPN;
    S.rowbytes = DOWN ? DE * 2 : D * 2; S.Bt = DOWN ? (const char*)p.WdnT : (const char*)p.WguT; S.bstride = DOWN ? (size_t)D * DE * 2 : (size_t)1024 * D * 2;
    for (int i = 0; i < MAXU; ++i) { pg8::Unit u; if (!S.next(i, u)) break;
        if (tix < 256) { const int idx = u.pm * 256 + tix, cn = (u.e < NEXP ? tab[132 + u.e] : M); unsigned v;
            if (DOWN) v = (unsigned)(tab[66 + u.e] + idx); else v = idx < cn ? (u.e < NEXP ? (unsigned)p.ltok[(size_t)u.e * LCAP + idx] : (unsigned)idx) : (unsigned)M;
            rowtab[i * 256 + tix] = v; } }
    __syncthreads();
    if (DOWN) { EpiDown E; E.Y = p.Y; E.tab = tab; pg8::gemm_phase<true>(stage, (const char*)p.U, DE, S, E); }
    else { EpiGU E; E.U = p.U; E.tab = tab; pg8::gemm_phase<true>(stage, (const char*)p.h, D, S, E); }
}
__device__ __forceinline__ void phase_final(const Params& p, LAS int* tab, int bid, int nb) {
    moe_tables(p, tab, 1);
    const int tix = otid();
    const int wid = tix >> 6, lane = tix & 63;
    float4 vn[8]; CombPre cn;
    { const int r = bid * 8 + wid; if (r < NB * L) { const int g = (r / L) * TT + LC + r % L; const float* xr = p.xcur + (size_t)g * D;
#pragma unroll
        for (int i = 0; i < 8; ++i) vn[i] = *(const float4*)(xr + (i * 64 + lane) * 4);
        comb_prefetch(p, g, cn); } }
    for (int r = bid * 8 + wid; r < NB * L; r += nb * 8) {
        const int b = r / L, t = r % L;
        float4 v[8]; float ss = 0.f; CombPre cc = cn;
#pragma unroll
        for (int i = 0; i < 8; ++i) v[i] = vn[i];
        { const int rn = r + nb * 8; if (rn < NB * L) { const int gn = (rn / L) * TT + LC + rn % L; const float* xr = p.xcur + (size_t)gn * D;
#pragma unroll
            for (int i = 0; i < 8; ++i) vn[i] = *(const float4*)(xr + (i * 64 + lane) * 4);
            comb_prefetch(p, gn, cn); } }
        moe_combine_row(p, tab, 1, b * TT + LC + t, lane, cc, v);
#pragma unroll
        for (int i = 0; i < 8; ++i) ss += v[i].x * v[i].x + v[i].y * v[i].y + v[i].z * v[i].z + v[i].w * v[i].w;
        ss = wave_sum(ss); const float rs = rsqrtf(ss * (1.0f / D) + 1e-6f);
#pragma unroll
        for (int i = 0; i < 8; ++i) { const int d = (i * 64 + lane) * 4; const float4 gg = *(const float4*)(p.final_g + d);
            float4 o; o.x = v[i].x * rs * gg.x; o.y = v[i].y * rs * gg.y; o.z = v[i].z * rs * gg.z; o.w = v[i].w * rs * gg.w;
            *(float4*)(p.out + (size_t)r * D + d) = o; }
    }
}


constexpr int LDS_BYTES = 160 * 1024;
extern __shared__ __attribute__((aligned(16))) unsigned char dyn_lds_raw[];
__device__ __forceinline__ LAS unsigned char* lds_las(unsigned off) { asm volatile("" : "+s"(off)); return (LAS unsigned char*)(unsigned long)off; }
__device__ __forceinline__ int obid() { int b = blockIdx.x; asm volatile("" : "+s"(b)); return b; }
__device__ __forceinline__ int onb() { int b = gridDim.x; asm volatile("" : "+s"(b)); return b; }
typedef const __attribute__((address_space(4))) Params* KParams;
__device__ __forceinline__ KParams kp_opaque(KParams q) { asm volatile("" : "+s"(q)); return q; }
#define PPH (*(const Params*)kp_opaque(kp))
__global__ __launch_bounds__(512, 2) void mega(Params p_byval) {
    const KParams kp = (KParams)__builtin_amdgcn_kernarg_segment_ptr();
    if (threadIdx.x == 0) *(uint4*)dyn_lds_raw = make_uint4(0u, 0u, 0u, 0u);
    __syncthreads();
    XcdBarrier bar = xcd_barrier_post(PPH.bar, (volatile LAS unsigned*)dyn_lds_raw);
    const unsigned lds0 = (unsigned)(unsigned long long)(LAS unsigned char*)dyn_lds_raw;
#define LDSB ((unsigned char*)lds_las(lds0 + 1024u))
#define lds ((float*)LDSB)
#define stage (lds_las(lds0 + 1024u))
#define tab ((LAS int*)lds_las(lds0 + 1024u + 131072u))
#define rowtab ((LAS unsigned*)lds_las(lds0 + 1024u + 131072u + 1024u))
#define bid (obid())
#define nb (onb())
    phase_copy(PPH, bid, nb);
    phase_router_w(PPH, bid, nb);
    phase_lora_w(PPH, bid, nb);
    phase_adaln(PPH, lds, bid, nb);
    xcd_barrier(bar);
#pragma unroll 1
    for (int l = 0; l < 2; ++l) {
        phase_norm<0>(PPH, lds, tab, l, bid, nb);
        phase_convert(PPH, lds, l, bid, nb);
        xcd_barrier(bar);
        phase_gemm_in(PPH, stage, bid, nb);
        xcd_barrier(bar);
        phase_prep(PPH, lds, l, bid, nb);
        { const int b1 = obid(), n1 = onb(); RwPre pre; rwkv_prefetch(PPH, l, b1, otid(), pre); for (int unit = b1; unit < RW_UNITS; unit += n1) rwkv_unit(PPH, LDSB, l, unit, unit + n1, pre); }
        xcd_barrier(bar);
        { const int tix = otid(), wid = __builtin_amdgcn_readfirstlane(tix >> 6); const int bid_l = obid(), nb_l = onb();
          float* const rp_l = lds + 32768;
          { const Params& pr = PPH; for (int i = tix; i < 12 * 465; i += NT) rp_l[i] = pr.rpb[(size_t)l * 12 * 465 + i] * 1.4426950408889634f; }
          __syncthreads();
          if (bid_l < 96) rwkv_chain(PPH, LDSB, bid_l);
          { const int wt = nb_l > 96 ? 96 + 2 * (nb_l - 96) : nb_l, w0 = nb_l > 96 ? (bid_l < 96 ? bid_l : 96 + 2 * (bid_l - 96)) : bid_l, w1 = nb_l > 96 ? (bid_l < 96 ? bid_l + 1 : 96 + 2 * (bid_l - 95)) : bid_l + 1;
            const int lo = (int)((long)w0 * ATT_LAT2 / wt), hi = (int)((long)w1 * ATT_LAT2 / wt); for (int task = lo + wid; task < hi; task += 8) attn_task2(PPH, rp_l, task); }
          if (l == 0) for (int task = ATT_LAT2 + bid_l * 8 + wid; task < ATT_TASKS2; task += nb_l * 8) attn_task2(PPH, rp_l, task); }
        xcd_barrier(bar);
        { const int b1 = obid(), n1 = onb(); for (int u3 = b1; u3 < RW_UNITS / 2; u3 += n1) if (l == 0 || u3 % (TT / 64) >= 4) rwkv_out(PPH, LDSB, l, u3); }
        xcd_barrier(bar);
        phase_gemm_out(PPH, stage, l, bid, nb);
        xcd_barrier(bar);
        phase_router(PPH, LDSB, l, bid, nb);
        xcd_barrier(bar);
        phase_gemm_moe<false>(PPH, stage, tab, rowtab, l, bid, nb);
        xcd_barrier(bar);
        phase_gemm_moe<true>(PPH, stage, tab, rowtab, l, bid, nb);
        xcd_barrier(bar);
    }
    phase_final(PPH, tab, bid, nb);
}

#undef bid
#undef nb
#undef LDSB
#undef lds
#undef stage
#undef tab
#undef rowtab
extern "C" void kernel_launch(void* const* d_in, const int* in_sizes, int n_in, void* d_out, int out_size, void* d_ws, size_t ws_size, hipStream_t stream) {
    static int grid = 0;
    if (grid == 0) {
        int dev = 0, cus = 0, per_cu = 0;
        if (hipGetDevice(&dev) != hipSuccess || hipDeviceGetAttribute(&cus, hipDeviceAttributeMultiprocessorCount, dev) != hipSuccess) { grid = -1; return; }
        if (hipFuncSetAttribute((const void*)mega, hipFuncAttributeMaxDynamicSharedMemorySize, LDS_BYTES) != hipSuccess) { grid = -1; return; }
        if (hipOccupancyMaxActiveBlocksPerMultiprocessor(&per_cu, (const void*)mega, NT, LDS_BYTES) != hipSuccess || per_cu < 1) { grid = -1; return; }
        (void)hipGetLastError();
        grid = cus;
        if (grid < 96) { grid = -1; return; }
    }
    if (grid < 0) return;
    Params p{};
    const float** pf = (const float**)&p;
    for (int i = 0; i < 32; ++i) pf[i] = (const float*)d_in[i];
    p.out = (float*)d_out;
    char* w = (char*)d_ws; size_t o = 0;
    auto take = [&](size_t bytes) { char* r = w + o; o += (bytes + 255) & ~(size_t)255; return r; };
    p.bar = (unsigned*)take(XCD_BAR_WORDS * 4 + 2 * NEXP * 4);
    p.cnt = (int*)(p.bar + XCD_BAR_WORDS);
    p.mod = (float*)take((size_t)2 * 5 * 6 * D * 4);
    p.xcur = (float*)take((size_t)M * D * 4);
    p.h = (bf16_t*)take((size_t)(M + 1) * D * 2);
    p.mix = (bf16_t*)take((size_t)M * D * 2);
    p.z = (bf16_t*)take((size_t)M * ZLD * 2);
    p.Y = p.z;
    p.streams = (float*)take((size_t)M * SSTR * 4);
    p.bonus = (float*)take((size_t)2 * M * 12 * 4);
    { char* sb = (char*)p.streams; const size_t U = (size_t)RW_UNITS * 4096;
      p.rw_P = (bf16_t*)sb; sb += U * 2; p.rw_Ry = (bf16_t*)sb; sb += U * 2; p.rw_H0 = (bf16_t*)sb; sb += U * 2; p.rw_QT = (float*)sb; sb += U * 4; p.rw_Y0 = (float*)sb; sb += U * 4;
      p.rw_vb = (bf16_t*)sb; sb += U; p.rw_gb = (bf16_t*)sb; sb += U; }
    p.ydir = (float*)take((size_t)2 * M * 768 * 4);
    p.tpos = (int*)take((size_t)M * TOPK * 4);
    p.sel = (int*)take((size_t)M * TOPK * 4);
    p.selw = (float*)take((size_t)M * TOPK * 4);
    p.ltok = (int*)take((size_t)NEXP * LCAP * 4);
    p.lw = (float*)take((size_t)NEXP * LCAP * 4);
    p.U = (bf16_t*)take((size_t)(UROWS + M) * DE * 2);
    p.WinT = (bf16_t*)take((size_t)ZLD * D * 2);
    p.WoutT = (bf16_t*)take((size_t)D * D * 2);
    p.WguT = (bf16_t*)take((size_t)65 * 1024 * D * 2);
    p.WdnT = (bf16_t*)take((size_t)65 * D * DE * 2);
    p.Qa = (bf16_t*)take((size_t)NB * 12 * TT * 64 * 2);
    p.Qr = (bf16_t*)take((size_t)NB * 12 * L * 64 * 2);
    p.Ka = (bf16_t*)take((size_t)NB * 12 * TT * 64 * 2);
    p.Vt = (bf16_t*)take((size_t)NB * 12 * 64 * TT * 2);
    p.Wr = (float*)take((size_t)2 * D * NEXP * 4);
    p.Lwa = (bf16_t*)take((size_t)2 * 2 * 12 * 2 * 64 * 72 * 2);
    p.Lg = (bf16_t*)take((size_t)2 * 12 * 64 * 104 * 2);
    if (o > ws_size) return;
    if (hipMemsetAsync(p.bar, 0, XCD_BAR_WORDS * sizeof(unsigned) + 2 * NEXP * 4, stream) != hipSuccess) return;
    hipLaunchKernelGGL(mega, dim3(grid), dim3(NT), LDS_BYTES, stream, p);
}
```

```cpp
#include <hip/hip_runtime.h>
#include <stdint.h>

typedef unsigned short bf16_t;

constexpr int D = 2048, NB = 4, L = 4096, LC = 256, TT = L + LC, M = NB * TT;
constexpr int IN_COLS = 6432, ZLD = 6656;
constexpr int ZA = 0, ZB = 1536, ZC = 3840, RWC = 2592;
constexpr int NEXP = 64, TOPK = 6, DE = 512;
constexpr int NSTR = 10, SSTR = NSTR * 768;
constexpr int LCAP = M;
constexpr int UROWS = M * TOPK + NEXP * 256;
constexpr int NT = 512;

struct Params {
    const float *x, *c, *ctx, *c_ctx, *norm1_g, *norm2_g, *ada_w, *ada_b, *w_in, *conv_w, *rpb, *rw_shift, *rw_w0, *rw_w_up, *rw_a0, *rw_a_up, *rw_g_up,
        *rw_k_k, *rw_k_a, *rw_r_k, *rw_gn_g, *rw_gn_b, *w_out, *router_w, *router_bias, *exp_gate, *exp_up, *exp_down, *sh_gate, *sh_up, *sh_down, *final_g;
    float* out;
    unsigned* bar; float* mod; float* xcur; bf16_t* h; bf16_t* z; bf16_t* mix; float* streams; float* bonus; float* ydir;
    int* sel; float* selw; int* cnt; int* ltok; float* lw; bf16_t* U; bf16_t *WinT, *WoutT, *WguT, *WdnT; bf16_t *Qa, *Qr, *Ka, *Vt; bf16_t* Y; int* tpos; bf16_t *rw_P, *rw_Ry, *rw_H0, *rw_vb, *rw_gb; float *rw_QT, *rw_Y0; float* Wr; bf16_t *Lwa, *Lg; int* cvc; bf16_t *WguE, *WdnE;
};

__device__ __forceinline__ float bf2f(bf16_t b) { return __uint_as_float(((unsigned)b) << 16); }
__device__ __forceinline__ bf16_t f2bf(float f) { unsigned u = __float_as_uint(f); u += 0x7FFFu + ((u >> 16) & 1u); return (bf16_t)(u >> 16); }
__device__ __forceinline__ float sigmoidf_(float x) { return 1.0f / (1.0f + __expf(-x)); }
template <int CTRL, int RMASK> __device__ __forceinline__ float dpp_f(float old, float v) { return __int_as_float(__builtin_amdgcn_update_dpp(__float_as_int(old), __float_as_int(v), CTRL, RMASK, 0xF, false)); }
__device__ __forceinline__ float wave_sum(float v) {
    v += dpp_f<0xB1, 0xF>(0.f, v);
    v += dpp_f<0x4E, 0xF>(0.f, v);
    v += dpp_f<0x141, 0xF>(0.f, v);
    v += dpp_f<0x140, 0xF>(0.f, v);
    v += dpp_f<0x142, 0xA>(0.f, v);
    v += dpp_f<0x143, 0xC>(0.f, v);
    return __int_as_float(__builtin_amdgcn_readlane(__float_as_int(v), 63));
}
__device__ __forceinline__ float wave_max(float v) {
    v = fmaxf(v, dpp_f<0xB1, 0xF>(v, v));
    v = fmaxf(v, dpp_f<0x4E, 0xF>(v, v));
    v = fmaxf(v, dpp_f<0x141, 0xF>(v, v));
    v = fmaxf(v, dpp_f<0x140, 0xF>(v, v));
    v = fmaxf(v, dpp_f<0x142, 0xA>(v, v));
    v = fmaxf(v, dpp_f<0x143, 0xC>(v, v));
    return __int_as_float(__builtin_amdgcn_readlane(__float_as_int(v), 63));
}
__device__ __forceinline__ float bperm_f(int srclane, float v) { return __int_as_float(__builtin_amdgcn_ds_bpermute(srclane << 2, __float_as_int(v))); }
__device__ __forceinline__ int bperm_i(int srclane, int v) { return __builtin_amdgcn_ds_bpermute(srclane << 2, v); }
__device__ __forceinline__ int otid() { int t = threadIdx.x; asm volatile("" : "+v"(t)); return t; }
__device__ __forceinline__ void lds_barrier() { asm volatile("s_waitcnt lgkmcnt(0)" ::: "memory"); __builtin_amdgcn_s_barrier(); asm volatile("" ::: "memory"); }
__device__ __forceinline__ float bfl(unsigned u) { return __uint_as_float(u << 16); }
__device__ __forceinline__ float bfh(unsigned u) { return __uint_as_float(u & 0xffff0000u); }
__device__ __forceinline__ const float* in_row(const Params& p, int g) { const int b = g / TT, s = g - b * TT; return s < LC ? p.ctx + (size_t)(b * LC + s) * D : p.x + (size_t)(b * L + (s - LC)) * D; }
__device__ __forceinline__ int modrow(int g) { const int b = g / TT, s = g - b * TT; return s < LC ? 4 : b; }

#define XB_TMO      128
#define XB_XCNT(j)  (256  + 64 * (j))
#define XB_XSUB(j)  (1280 + 64 * (j))
#define XB_XGEN(j)  (2304 + 64 * (j))
#define XB_TOP      3328
#define XB_TOPGEN   3392
#define XCD_BAR_WORDS 3456
#define XB_SPIN_CAP (1u << 22)
#define LAS __attribute__((address_space(3)))

__device__ __forceinline__ unsigned xb_ld(unsigned* p)              { return __hip_atomic_load(p, __ATOMIC_RELAXED, __HIP_MEMORY_SCOPE_AGENT); }
__device__ __forceinline__ unsigned xb_add(unsigned* p, unsigned v) { return __hip_atomic_fetch_add(p, v, __ATOMIC_RELAXED, __HIP_MEMORY_SCOPE_AGENT); }
__device__ __forceinline__ unsigned xb_xcc_id() { return (unsigned)__builtin_amdgcn_s_getreg((3 << 11) | 20) & 0xFu; }
#define XB_SPIN(cond, bar) do { unsigned _sp = 0; while (cond) { __builtin_amdgcn_s_sleep(1); \
    if ((++_sp & 255u) == 0u) { if (xb_ld(&(bar)[XB_TMO])) break; if (_sp > XB_SPIN_CAP) { atomicAdd(&(bar)[XB_TMO], 1u); break; } } } } while (0)

struct XcdBarrier {
    unsigned* bar; unsigned x;
    volatile LAS unsigned* st;
};

__device__ __forceinline__ XcdBarrier xcd_barrier_post(unsigned* bar, volatile LAS unsigned* st) {
    XcdBarrier b; b.bar = bar; b.x = xb_xcc_id(); b.st = st;
    if (threadIdx.x == 0) (void)xb_add(&bar[XB_XCNT(b.x)], 1u);
    return b;
}
__device__ __forceinline__ void xcd_barrier_complete(unsigned* bar, unsigned x, unsigned& nloc, unsigned& nx) {
    const unsigned G = gridDim.x * gridDim.y * gridDim.z;
    unsigned sum, cnt, mine, sp = 0u;
    for (;;) {
        sum = 0u; cnt = 0u; mine = 0u;
#pragma unroll
        for (unsigned j = 0; j < 16; ++j) { const unsigned c = xb_ld(&bar[XB_XCNT(j)]); sum += c; cnt += (c > 0u) ? 1u : 0u; mine = (j == x) ? c : mine; }
        if (sum == G) break;
        __builtin_amdgcn_s_sleep(1);
        if ((++sp & 255u) == 0u) { if (xb_ld(&bar[XB_TMO])) break; if (sp > XB_SPIN_CAP) { atomicAdd(&bar[XB_TMO], 1u); break; } }
    }
    nloc = mine > 0u ? mine : 1u; nx = cnt > 0u ? cnt : 1u;
}

__device__ __forceinline__ void xcd_barrier(const XcdBarrier& b) {
    asm volatile("s_waitcnt vmcnt(0)" ::: "memory");
    __syncthreads();
    if (threadIdx.x == 0) {
        unsigned* bar = b.bar; const unsigned bx = xb_xcc_id();
        __builtin_amdgcn_s_waitcnt(0);
        unsigned nloc = b.st[0], nx = b.st[1];
        if (nloc == 0u) { xcd_barrier_complete(bar, bx, nloc, nx); b.st[0] = nloc; b.st[1] = nx; }
        const unsigned old = xb_add(&bar[XB_XSUB(bx)], 1u);
        const unsigned gen = old / nloc;
        if (old + 1u == (gen + 1u) * nloc) {
            __builtin_amdgcn_fence(__ATOMIC_RELEASE, "agent");
            asm volatile("s_waitcnt vmcnt(0)" ::: "memory");
            const unsigned og = xb_add(&bar[XB_TOP], 1u);
            const unsigned tg = og / nx;
            if (og + 1u == (tg + 1u) * nx) xb_add(&bar[XB_TOPGEN], 1u);
            else XB_SPIN(xb_ld(&bar[XB_TOPGEN]) == tg, bar);
            __builtin_amdgcn_fence(__ATOMIC_ACQUIRE, "agent");
            xb_add(&bar[XB_XGEN(bx)], 1u);
            asm volatile("s_waitcnt vmcnt(0)" ::: "memory");
        } else {
            XB_SPIN(xb_ld(&bar[XB_XGEN(bx)]) == gen, bar);
            __builtin_amdgcn_fence(__ATOMIC_ACQUIRE, "agent");
            asm volatile("s_waitcnt vmcnt(0)" ::: "memory");
        }
    }
    __syncthreads();
}


__device__ __forceinline__ void phase_copy(const Params& p, int bid, int nb) {
    const int tix = otid();
    if (bid == 0) for (int i = tix; i < D; i += NT) p.h[(size_t)M * D + i] = 0;
}

__device__ __forceinline__ void phase_router_w(const Params& p, int bid, int nb) {
    const int tix = otid();
    for (int i = bid * NT + tix; i < 2 * D * NEXP; i += nb * NT) {
        const int c = i & 3, n = (i >> 2) & 15, q = (i >> 6) & 3, nt = (i >> 8) & 3, j = (i >> 10) & 127, l = i >> 17;
        p.Wr[i] = p.router_w[((size_t)l * D + 16 * j + 4 * q + c) * NEXP + 16 * nt + n];
    }
}
__device__ __forceinline__ void phase_lora_w(const Params& p, int bid, int nb) {
    const int tix = otid();
    for (int i = bid * NT + tix; i < 2 * 2 * 12 * 2 * 64 * 72; i += nb * NT) {
        const int r = i % 72, c = (i / 72) & 63, which = (i / (72 * 64)) & 1, hh = (i / (72 * 64 * 2)) % 12, n = (i / (72 * 64 * 2 * 12)) & 1, l = i / (72 * 64 * 2 * 12 * 2);
        const float* src = (which == 0 ? p.rw_w_up : p.rw_a_up) + ((size_t)(l * 2 + n) * 48) * 768 + hh * 64 + c;
        p.Lwa[i] = r < 48 ? f2bf(src[(size_t)r * 768]) : (bf16_t)0;
    }
    for (int i = bid * NT + tix; i < 2 * 12 * 64 * 104; i += nb * NT) {
        const int r = i % 104, c = (i / 104) & 63, hh = (i / (104 * 64)) % 12, l = i / (104 * 64 * 12);
        p.Lg[i] = r < 96 ? f2bf(p.rw_g_up[((size_t)l * 96 + r) * 768 + hh * 64 + c]) : (bf16_t)0;
    }
}
__device__ __forceinline__ void phase_adaln(const Params& p, float* lds, int bid, int nb) {
    const int tix = otid();
    float* cond = lds;
    float* red = lds + 5 * D;
    for (int i = tix; i < 5 * D; i += NT) { const int r = i / D, d = i % D; const float v = r < 4 ? p.c[r * D + d] : p.c_ctx[d]; cond[i] = v * sigmoidf_(v); }
    __syncthreads();
    const int tid = tix, cg = tid & 15, ks = tid >> 4, wid = tid >> 6, lane = tid & 63;
    const int nitems = 2 * (6 * D / 64);
    for (int it = bid; it < nitems; it += nb) {
        const int l = it / (6 * D / 64), c0 = (it % (6 * D / 64)) * 64 + cg * 4;
        const float* W = p.ada_w + (size_t)l * D * 6 * D + c0;
        float4 acc[5];
#pragma unroll
        for (int r = 0; r < 5; ++r) acc[r] = make_float4(0.f, 0.f, 0.f, 0.f);
#pragma unroll 8
        for (int k = ks; k < D; k += 32) {
            const float4 w = *(const float4*)(W + (size_t)k * 6 * D);
#pragma unroll
            for (int r = 0; r < 5; ++r) { const float cv = cond[r * D + k]; acc[r].x += cv * w.x; acc[r].y += cv * w.y; acc[r].z += cv * w.z; acc[r].w += cv * w.w; }
        }
#pragma unroll
        for (int r = 0; r < 5; ++r) {
            acc[r].x += bperm_f(lane ^ 16, acc[r].x); acc[r].x += bperm_f(lane ^ 32, acc[r].x);
            acc[r].y += bperm_f(lane ^ 16, acc[r].y); acc[r].y += bperm_f(lane ^ 32, acc[r].y);
            acc[r].z += bperm_f(lane ^ 16, acc[r].z); acc[r].z += bperm_f(lane ^ 32, acc[r].z);
            acc[r].w += bperm_f(lane ^ 16, acc[r].w); acc[r].w += bperm_f(lane ^ 32, acc[r].w);
        }
        __syncthreads();
        if (lane < 16) {
#pragma unroll
            for (int r = 0; r < 5; ++r) { float* q = red + ((wid * 16 + lane) * 20 + r * 4); q[0] = acc[r].x; q[1] = acc[r].y; q[2] = acc[r].z; q[3] = acc[r].w; }
        }
        __syncthreads();
        if (tid < 16 * 20) {
            const int cgi = tid / 20, rj = tid % 20, r = rj / 4, j = rj % 4;
            float s = 0.f;
#pragma unroll
            for (int w = 0; w < 8; ++w) s += red[(w * 16 + cgi) * 20 + rj];
            const int col = (it % (6 * D / 64)) * 64 + cgi * 4 + j;
            p.mod[(size_t)(l * 5 + r) * 6 * D + col] = s + p.ada_b[(size_t)l * 6 * D + col];
        }
    }
}

__device__ __forceinline__ void moe_tables(const Params& p, LAS int* tab, int lc);

struct CombPre { int e[TOPK], tp[TOPK]; float w[TOPK]; };
__device__ __forceinline__ void comb_prefetch(const Params& p, int g, CombPre& c) {
#pragma unroll
    for (int k = 0; k < TOPK; ++k) { c.e[k] = p.sel[g * TOPK + k]; c.tp[k] = p.tpos[g * TOPK + k]; c.w[k] = p.selw[g * TOPK + k]; }
}
__device__ __forceinline__ void moe_combine_row(const Params& p, const LAS int* tab, int lm  , int g, int lane, const CombPre& c, float4 (&v)[8]) {
    int slot[TOPK + 1]; float w[TOPK + 1];
#pragma unroll
    for (int k = 0; k < TOPK; ++k) { slot[k] = tab[66 + c.e[k]] + c.tp[k]; w[k] = c.w[k]; }
    slot[TOPK] = tab[66 + NEXP] + g; w[TOPK] = 1.0f;
    const float* gt = p.mod + (size_t)(lm * 5 + modrow(g)) * 6 * D + 5 * D;
#pragma unroll
    for (int i = 0; i < 8; ++i) {
        const int d = (i * 64 + lane) * 4; float a0 = 0.f, a1 = 0.f, a2 = 0.f, a3 = 0.f;
#pragma unroll
        for (int k = 0; k <= TOPK; ++k) { const uint2 y = *(const uint2*)(p.Y + (size_t)slot[k] * D + d);
            a0 += w[k] * __uint_as_float(y.x << 16); a1 += w[k] * __uint_as_float(y.x & 0xffff0000u); a2 += w[k] * __uint_as_float(y.y << 16); a3 += w[k] * __uint_as_float(y.y & 0xffff0000u); }
        const float4 g4 = *(const float4*)(gt + d);
        v[i].x += g4.x * a0; v[i].y += g4.y * a1; v[i].z += g4.z * a2; v[i].w += g4.w * a3;
    }
}

template <int WHICH>
__device__ __forceinline__ void phase_norm(const Params& p, float* lds, LAS int* tab, int l, int bid, int nb) {
    const bool comb = (WHICH == 0 && l > 0);
    if (comb) moe_tables(p, tab, l - 1);
    const int tix = otid();
    const int wid = tix >> 6, lane = tix & 63;
    const float* gam = (WHICH == 0 ? p.norm1_g : p.norm2_g) + (size_t)l * D;
    float* frow = lds + wid * D;
    float4 vn[8]; CombPre cn;
    { const int g = bid * 8 + wid; if (g < M) { const float* xr = (WHICH == 0 && l == 0) ? in_row(p, g) : p.xcur + (size_t)g * D;
#pragma unroll
        for (int i = 0; i < 8; ++i) vn[i] = *(const float4*)(xr + (i * 64 + lane) * 4);
        if (comb) comb_prefetch(p, g, cn); } }
    for (int g = bid * 8 + wid; g < M; g += nb * 8) {
        float4 v[8]; float ss = 0.f; CombPre cc;
#pragma unroll
        for (int i = 0; i < 8; ++i) v[i] = vn[i];
        if (comb) cc = cn;
        { const int gn = g + nb * 8; if (gn < M) { const float* xr = (WHICH == 0 && l == 0) ? in_row(p, gn) : p.xcur + (size_t)gn * D;
#pragma unroll
            for (int i = 0; i < 8; ++i) vn[i] = *(const float4*)(xr + (i * 64 + lane) * 4);
            if (comb) comb_prefetch(p, gn, cn); } }
        if (comb) { moe_combine_row(p, tab, l - 1, g, lane, cc, v);
#pragma unroll
            for (int i = 0; i < 8; ++i) *(float4*)(p.xcur + (size_t)g * D + (i * 64 + lane) * 4) = v[i]; }
#pragma unroll
        for (int i = 0; i < 8; ++i) ss += v[i].x * v[i].x + v[i].y * v[i].y + v[i].z * v[i].z + v[i].w * v[i].w;
        ss = wave_sum(ss);
        const float rs = rsqrtf(ss * (1.0f / D) + 1e-6f);
        const float* mrow = p.mod + (size_t)(l * 5 + modrow(g)) * 6 * D;
        const float* sh = mrow + (WHICH == 0 ? 0 : 3) * D; const float* sc = mrow + (WHICH == 0 ? 1 : 4) * D;
#pragma unroll
        for (int i = 0; i < 8; ++i) {
            const int d = (i * 64 + lane) * 4;
            const float4 gg = *(const float4*)(gam + d), s4 = *(const float4*)(sh + d), c4 = *(const float4*)(sc + d);
            float4 o;
            o.x = v[i].x * rs * gg.x * (1.0f + c4.x) + s4.x; o.y = v[i].y * rs * gg.y * (1.0f + c4.y) + s4.y;
            o.z = v[i].z * rs * gg.z * (1.0f + c4.z) + s4.z; o.w = v[i].w * rs * gg.w * (1.0f + c4.w) + s4.w;
            uint2 pk; pk.x = (unsigned)f2bf(o.x) | ((unsigned)f2bf(o.y) << 16); pk.y = (unsigned)f2bf(o.z) | ((unsigned)f2bf(o.w) << 16);
            *(uint2*)(p.h + (size_t)g * D + d) = pk;
            if (WHICH == 1) *(float4*)(frow + d) = o;
        }
        if (WHICH == 1) {
            const float* rw = p.router_w + (size_t)l * D * NEXP + lane;
            float a0 = 0.f, a1 = 0.f, a2 = 0.f, a3 = 0.f;
            for (int k = 0; k < D; k += 4) {
                const float4 f = *(const float4*)(frow + k);
                a0 += f.x * rw[(size_t)(k + 0) * NEXP]; a1 += f.y * rw[(size_t)(k + 1) * NEXP]; a2 += f.z * rw[(size_t)(k + 2) * NEXP]; a3 += f.w * rw[(size_t)(k + 3) * NEXP];
            }
            const float score = 1.0f / (1.0f + expf(-((a0 + a1) + (a2 + a3))));
            float val = score + p.router_bias[l * NEXP + lane];
            int myidx[TOPK]; float mysc[TOPK]; float tot = 0.f;
#pragma unroll
            for (int k = 0; k < TOPK; ++k) {
                float bv = val; int bi = lane;
#pragma unroll
                for (int o = 32; o >= 1; o >>= 1) { const float ov = bperm_f(lane ^ o, bv); const int oi = bperm_i(lane ^ o, bi); if (ov > bv || (ov == bv && oi < bi)) { bv = ov; bi = oi; } }
                const float sc_k = bperm_f(bi, score);
                myidx[k] = bi; mysc[k] = sc_k; tot += sc_k;
                if (lane == bi) val = -INFINITY;
            }
            if (lane == 0) {
#pragma unroll
                for (int k = 0; k < TOPK; ++k) { p.sel[g * TOPK + k] = myidx[k]; p.selw[g * TOPK + k] = mysc[k] / tot * 2.5f; }
            }
        }
    }
}


namespace pg8 {
typedef short bf16x8 __attribute__((ext_vector_type(8)));
typedef float f32x4 __attribute__((ext_vector_type(4)));
typedef unsigned u32x4 __attribute__((ext_vector_type(4)));
constexpr int BM = 256, BK = 64, HALF = 128, HTB = HALF * BK * 2  , STAGE_BYTES = 8 * HTB, NXCD = 8, WGM = 8;
__device__ __forceinline__ int lds_byte(int r, int c) { const int st = (r >> 4) * 2 + (c >> 5), rr = r & 15, cc = c & 31, ob = rr * 64 + cc * 2; return st * 1024 + (ob ^ (((ob >> 9) & 1) << 5)); }
__device__ __forceinline__ void stage_rc(int b, int& R, int& C) { const int st = b / 1024, sb = b % 1024, swz = sb ^ (((sb >> 9) & 1) << 5); R = (st >> 1) * 16 + swz / 64; C = (st & 1) * 32 + (swz % 64) / 2; }
__device__ __forceinline__ int perm32(int rho) { const int n = rho >> 4, i = rho & 15; return 8 * (i >> 2) + 4 * n + (i & 3); }
typedef float cvt_f32x2 __attribute__((ext_vector_type(2)));
typedef __bf16 cvt_bf16x2 __attribute__((ext_vector_type(2)));
__device__ __forceinline__ unsigned cvt_pk_bf16(float lo, float hi) { const cvt_f32x2 v = {lo, hi}; const cvt_bf16x2 b = __builtin_convertvector(v, cvt_bf16x2); return __builtin_bit_cast(unsigned, b); }
struct Unit { int pm, pn, e, ord; };
template <bool PERM, class Sched, class Epi>
__device__ __forceinline__ void gemm_phase(LAS unsigned char* lds, const char* Abase, const int K, const Sched& S, const Epi& E) {
    const int tid = otid(), wid = __builtin_amdgcn_readfirstlane(tid >> 6), lane = tid & 63, wr = wid >> 2, wc = wid & 3, fr = lane & 15, fq = lane >> 4;
    const int nt = K / BK;
    unsigned voffB[2];
#pragma unroll
    for (int i = 0; i < 2; ++i) { int R, C; stage_rc(tid * 16 + i * 8192, R, C); const int Rb = PERM ? ((R & ~31) + perm32(R & 31)) : R; voffB[i] = (unsigned)(Rb * K + C) * 2u; }
    const size_t kstep = (size_t)(BK * 2);
    const size_t hstep = (size_t)HALF * K * 2;
    const unsigned ldsw = (unsigned)wid * 1024u;
    const int aoff = lds_byte(wr * 64 + fr, fq * 8), boff = lds_byte(wc * 32 + fr, fq * 8);
#define PG8_SA(b, h) (((b) * 2 + (h)) * HTB)
#define PG8_SB(b, h) ((4 + (b) * 2 + (h)) * HTB)
#define PG8_STAGE(bufoff, gbase, voff) do { _Pragma("unroll") for (int _i = 0; _i < 2; ++_i) \
        __builtin_amdgcn_global_load_lds((const unsigned*)((const char*)(gbase) + (voff)[_i]), (LAS unsigned*)(lds + (bufoff) + ldsw + _i * 8192), 16, 0, 0); } while (0)
#define PG8_LDA(dst, b, h) do { _Pragma("unroll") for (int m = 0; m < 4; ++m) _Pragma("unroll") for (int k = 0; k < 2; ++k) dst[m][k] = *(const LAS bf16x8*)(lds + PG8_SA(b, h) + aoff + m * 2048 + k * 1024); } while (0)
#define PG8_LDB(dst, b, h) do { _Pragma("unroll") for (int n = 0; n < 2; ++n) _Pragma("unroll") for (int k = 0; k < 2; ++k) dst[n][k] = *(const LAS bf16x8*)(lds + PG8_SB(b, h) + boff + n * 2048 + k * 1024); } while (0)
#define PG8_MMA(ai, bj, At, Bt) do { __builtin_amdgcn_s_setprio(1); _Pragma("unroll") for (int m = 0; m < 4; ++m) _Pragma("unroll") for (int n = 0; n < 2; ++n) _Pragma("unroll") for (int k = 0; k < 2; ++k) \
        acc[ai][bj][m][n] = __builtin_amdgcn_mfma_f32_16x16x32_bf16(Bt[n][k], At[m][k], acc[ai][bj][m][n], 0, 0, 0); __builtin_amdgcn_s_setprio(0); } while (0)
#define PG8_WAIT_V(n) asm volatile("s_waitcnt vmcnt(" #n ")" ::: "memory")
#define PG8_WAIT_L(n) asm volatile("s_waitcnt lgkmcnt(" #n ")" ::: "memory")
#define PG8_BAR __builtin_amdgcn_s_barrier()
#define PG8_SCHED __builtin_amdgcn_sched_barrier(0)
#define PG8_ROWS(u, v) do { const int _t = otid(); _Pragma("unroll") for (int _i = 0; _i < 2; ++_i) { int _R, _C; stage_rc(_t * 16 + _i * 8192, _R, _C); \
        _Pragma("unroll") for (int _h = 0; _h < 2; ++_h) v[_h][_i] = S.arow(u, _h * HALF + _R) + (unsigned)(_C * 2); } } while (0)
    Unit cur, nxt; int ui = 0;
    if (!S.next(0, cur)) return;
    f32x4 acc[2][2][4][2];
#pragma unroll
    for (int a = 0; a < 2; ++a)
#pragma unroll
        for (int b = 0; b < 2; ++b)
#pragma unroll
            for (int m = 0; m < 4; ++m)
#pragma unroll
                for (int n = 0; n < 2; ++n) acc[a][b][m][n] = (f32x4){0.f, 0.f, 0.f, 0.f};
    bf16x8 At[4][2], B0[2][2], B1[2][2];
    unsigned va[2][2];
    PG8_ROWS(cur, va);
    const char* cB = S.bptr(cur);
    PG8_STAGE(PG8_SB(0, 0), cB, voffB); PG8_STAGE(PG8_SA(0, 0), Abase, va[0]); PG8_STAGE(PG8_SB(0, 1), cB + hstep, voffB); PG8_STAGE(PG8_SA(0, 1), Abase, va[1]);
    if (wr == 1) PG8_BAR;
    PG8_WAIT_V(4); PG8_BAR;
    PG8_STAGE(PG8_SB(1, 0), cB + kstep, voffB); PG8_STAGE(PG8_SA(1, 0), Abase + kstep, va[0]); PG8_STAGE(PG8_SB(1, 1), cB + hstep + kstep, voffB);
    PG8_WAIT_V(6); PG8_BAR;
    for (;;) {
        const bool has_next = S.next(ui + 1, nxt);
        const char* nB = has_next ? S.bptr(nxt) : cB;
        for (int t = 0; t < nt; t += 2) {
            const bool last = (t == nt - 2);
            const char* a1 = Abase + (size_t)(t + 1) * kstep;
            const char* a2 = last ? Abase : Abase + (size_t)(t + 2) * kstep; const char* b2 = last ? nB : cB + (size_t)(t + 2) * kstep;
            const char* a3 = a2 + kstep; const char* b3 = b2 + kstep;
            PG8_LDB(B0, 0, 0); PG8_SCHED; PG8_LDA(At, 0, 0); PG8_STAGE(PG8_SA(1, 1), a1, va[1]);
            PG8_WAIT_L(8); PG8_BAR; PG8_WAIT_L(0); PG8_MMA(0, 0, At, B0); PG8_BAR; PG8_SCHED;
            if (last && has_next) { PG8_ROWS(nxt, va); }
            PG8_LDB(B1, 0, 1); PG8_STAGE(PG8_SB(0, 0), b2, voffB);
            PG8_BAR; PG8_WAIT_L(0); PG8_MMA(0, 1, At, B1); PG8_BAR;
            PG8_LDA(At, 0, 1); PG8_STAGE(PG8_SA(0, 0), a2, va[0]);
            PG8_BAR; PG8_WAIT_L(0); PG8_MMA(1, 0, At, B0); PG8_BAR; PG8_SCHED;
            PG8_STAGE(PG8_SB(0, 1), b2 + hstep, voffB);
            PG8_WAIT_V(6); PG8_BAR; PG8_MMA(1, 1, At, B1); PG8_BAR;
            PG8_LDB(B0, 1, 0); PG8_SCHED; PG8_LDA(At, 1, 0); PG8_STAGE(PG8_SA(0, 1), a2, va[1]);
            PG8_WAIT_L(8); PG8_BAR; PG8_WAIT_L(0); PG8_MMA(0, 0, At, B0); PG8_BAR; PG8_SCHED;
            PG8_LDB(B1, 1, 1); PG8_STAGE(PG8_SB(1, 0), b3, voffB);
            PG8_BAR; PG8_WAIT_L(0); PG8_MMA(0, 1, At, B1); PG8_BAR;
            PG8_LDA(At, 1, 1); PG8_STAGE(PG8_SA(1, 0), a3, va[0]);
            PG8_BAR; PG8_WAIT_L(0); PG8_MMA(1, 0, At, B0); PG8_BAR; PG8_SCHED;
            PG8_STAGE(PG8_SB(1, 1), b3 + hstep, voffB);
            PG8_WAIT_V(6); PG8_BAR; PG8_MMA(1, 1, At, B1); PG8_BAR;
        }
        E(acc, cur, wr, wc, fr, fq);
        if (!has_next) break;
#pragma unroll
        for (int a = 0; a < 2; ++a)
#pragma unroll
            for (int b = 0; b < 2; ++b)
#pragma unroll
                for (int m = 0; m < 4; ++m)
#pragma unroll
                    for (int n = 0; n < 2; ++n) acc[a][b][m][n] = (f32x4){0.f, 0.f, 0.f, 0.f};
        cur = nxt; cB = nB; ++ui;
    }
    PG8_WAIT_V(0);
    if (wr == 0) PG8_BAR;
    PG8_BAR;
#undef PG8_SA
#undef PG8_SB
#undef PG8_STAGE
#undef PG8_LDA
#undef PG8_LDB
#undef PG8_MMA
#undef PG8_WAIT_V
#undef PG8_WAIT_L
#undef PG8_BAR
#undef PG8_SCHED
#undef PG8_ROWS
}
struct DenseSched {
    int nM, nN, nwg, G, c; const char* Bt; unsigned rowbytes; int skipctx;
    __device__ __forceinline__ bool next(int i, Unit& u) const {
        const long L = (long)i * G + c; if (L >= nwg) return false;
        int wgid = (int)L; { const int q = nwg / NXCD, r = nwg % NXCD, xcd = wgid % NXCD, off = wgid / NXCD; wgid = (xcd < r ? xcd * (q + 1) : r * (q + 1) + (xcd - r) * q) + off; }
        const int nig = WGM * nN, gid = wgid / nig, fm = gid * WGM, gsz = (nM - fm) < WGM ? (nM - fm) : WGM;
        u.pm = fm + ((wgid % nig) % gsz); u.pn = (wgid % nig) / gsz; u.e = 0; u.ord = i; if (skipctx) u.pm = (u.pm >> 4) * 17 + 1 + (u.pm & 15); return true;
    }
    __device__ __forceinline__ unsigned arow(const Unit& u, int r) const { return (unsigned)(u.pm * BM + r) * rowbytes; }
    __device__ __forceinline__ const char* bptr(const Unit& u) const { return Bt + (size_t)u.pn * BM * rowbytes; }
};
}

struct CvTile { const float* src; bf16_t* dst; int ldn, nvalid, k0, n0, K, split; };
constexpr int CV_IN = 32 * 26, CV_OUT = 32 * 8, CV_PER_E = 32 * 2 + 32 * 2 + 8 * 8, CV_TOTAL = CV_IN + CV_OUT + 65 * CV_PER_E, CV_EEARLY = 24, CV_EARLY = CV_IN + CV_OUT + CV_EEARLY * CV_PER_E;
__device__ __forceinline__ CvTile cv_desc(const Params& p, int l, int it) {
    const int r1 = it - CV_IN, r2 = r1 - CV_OUT;
    const bool is_in = it < CV_IN, is_out = !is_in && r1 < CV_OUT;
    const int e = r2 >= 0 ? r2 / CV_PER_E : 0, re = r2 >= 0 ? r2 % CV_PER_E : 0;
    const bool is_gu = !is_in && !is_out && re < 128, up = re >= 64, is_dn = !is_in && !is_out && !is_gu;
    const int rg = re & 63, rd = re - 128;
    const float* sgu = e < NEXP ? (up ? p.exp_up : p.exp_gate) + ((size_t)l * NEXP + e) * D * DE : (up ? p.sh_up : p.sh_gate) + (size_t)l * D * DE;
    const float* sdn = e < NEXP ? p.exp_down + ((size_t)l * NEXP + e) * DE * D : p.sh_down + (size_t)l * DE * D;
    CvTile t;
    t.src = is_in ? p.w_in + (size_t)l * D * IN_COLS : (is_out ? p.w_out + (size_t)l * D * D : (is_gu ? sgu : sdn));
    const bool early = l == 1 && e < CV_EEARLY;
    t.dst = is_in ? p.WinT : (is_out ? p.WoutT + (size_t)l * D * D : (is_gu ? (early ? p.WguE : p.WguT) + (size_t)e * 1024 * D : (early ? p.WdnE : p.WdnT) + (size_t)e * D * DE));
    t.ldn = is_in ? IN_COLS : (is_gu ? DE : D); t.nvalid = t.ldn;
    t.k0 = (is_in ? it / 26 : (is_out ? r1 / 8 : (is_gu ? rg / 2 : rd / 8))) * 64;
    t.n0 = (is_in ? it % 26 : (is_out ? r1 % 8 : (is_gu ? rg % 2 : rd % 8))) * 256;
    t.K = is_dn ? DE : D; t.split = is_gu ? (up ? 2 : 1) : 0;
    return t;
}
__device__ __forceinline__ void cv_load(const CvTile& t, int tid, pg8::f32x4 (&v)[8]) {
    const int kp = tid >> 6, c4 = (tid & 63) * 4;
#pragma unroll
    for (int j = 0; j < 8; ++j) v[j] = (t.n0 + c4 < t.nvalid) ? *(const pg8::f32x4*)(t.src + (size_t)(t.k0 + 8 * kp + j) * t.ldn + t.n0 + c4) : (pg8::f32x4){0.f, 0.f, 0.f, 0.f};
}
__device__ __forceinline__ void cv_store(const CvTile& t, int tid, bf16_t* T  , const pg8::f32x4 (&v)[8]) {
    const int kp = tid >> 6, c4 = (tid & 63) * 4;
    uint4 o;
    o.x = pg8::cvt_pk_bf16(v[0][0], v[1][0]); o.y = pg8::cvt_pk_bf16(v[2][0], v[3][0]); o.z = pg8::cvt_pk_bf16(v[4][0], v[5][0]); o.w = pg8::cvt_pk_bf16(v[6][0], v[7][0]); *(uint4*)(T + (c4 + 0) * 72 + 8 * kp) = o;
    o.x = pg8::cvt_pk_bf16(v[0][1], v[1][1]); o.y = pg8::cvt_pk_bf16(v[2][1], v[3][1]); o.z = pg8::cvt_pk_bf16(v[4][1], v[5][1]); o.w = pg8::cvt_pk_bf16(v[6][1], v[7][1]); *(uint4*)(T + (c4 + 1) * 72 + 8 * kp) = o;
    o.x = pg8::cvt_pk_bf16(v[0][2], v[1][2]); o.y = pg8::cvt_pk_bf16(v[2][2], v[3][2]); o.z = pg8::cvt_pk_bf16(v[4][2], v[5][2]); o.w = pg8::cvt_pk_bf16(v[6][2], v[7][2]); *(uint4*)(T + (c4 + 2) * 72 + 8 * kp) = o;
    o.x = pg8::cvt_pk_bf16(v[0][3], v[1][3]); o.y = pg8::cvt_pk_bf16(v[2][3], v[3][3]); o.z = pg8::cvt_pk_bf16(v[4][3], v[5][3]); o.w = pg8::cvt_pk_bf16(v[6][3], v[7][3]); *(uint4*)(T + (c4 + 3) * 72 + 8 * kp) = o;
    lds_barrier();
#pragma unroll
    for (int j = 0; j < 4; ++j) {
        const int q = tid + 512 * j, nl = q >> 3, kc = q & 7, n = t.n0 + nl;
        const size_t drow = t.split == 0 ? (size_t)n : (size_t)((n >> 7) * 256 + (t.split == 2 ? 128 : 0) + (n & 127));
        *(uint4*)(t.dst + drow * t.K + t.k0 + kc * 8) = *(const uint4*)(T + nl * 72 + kc * 8);
    }
}
__device__ __forceinline__ void phase_convert(const Params& p, float* lds, int l, int first  , int bid, int nb) {
    const int tid = otid();
    bf16_t* T0 = (bf16_t*)lds; bf16_t* T1 = T0 + 256 * 72;
    pg8::f32x4 va[8], vb[8];
    __syncthreads();
    int it = first + bid;
    if (it < CV_TOTAL) cv_load(cv_desc(p, l, it), tid, va);
    for (; it < CV_TOTAL; it += 2 * nb) {
        const bool has1 = it + nb < CV_TOTAL, has2 = it + 2 * nb < CV_TOTAL;
        if (has1) cv_load(cv_desc(p, l, it + nb), tid, vb);
        cv_store(cv_desc(p, l, it), tid, T0, va);
        if (has2) cv_load(cv_desc(p, l, it + 2 * nb), tid, va);
        if (has1) cv_store(cv_desc(p, l, it + nb), tid, T1, vb);
    }
    __syncthreads();
}

constexpr int CVQ_OUT = 8, CVQ_GU_TOTAL = 1600, CVQ_GU_MAX = 32, CVQ_DN_TOTAL = 512, CVQ_DN_MAX = 8;
__device__ __forceinline__ void convert_tail(const Params& p, float* lds, int quota  ) {
    const int tid = otid();
    bf16_t* T0 = (bf16_t*)lds; bf16_t* T1 = T0 + 256 * 72; int* sh = (int*)(T1 + 256 * 72);
    __syncthreads();
    if (tid == 0) *sh = atomicAdd(p.cvc, quota);
    __syncthreads();
    const int base = *sh, end = base + quota < CV_EARLY ? base + quota : CV_EARLY;
    if (base < end) {
        pg8::f32x4 va[8], vb[8];
        int it = base; cv_load(cv_desc(p, 1, it), tid, va);
        for (; it < end; it += 2) {
            const bool has1 = it + 1 < end, has2 = it + 2 < end;
            if (has1) cv_load(cv_desc(p, 1, it + 1), tid, vb);
            cv_store(cv_desc(p, 1, it), tid, T0, va);
            if (has2) cv_load(cv_desc(p, 1, it + 2), tid, va);
            if (has1) cv_store(cv_desc(p, 1, it + 1), tid, T1, vb);
        }
    }
    __syncthreads();
}
__device__ __forceinline__ bool tail_idle(int total, int G, int c) { const int rounds = (total + G - 1) / G, mine = c < total ? (total - c + G - 1) / G : 0; return mine < rounds; }

struct EpiZ {
    bf16_t* z;
    __device__ __forceinline__ void operator()(const pg8::f32x4 (&acc)[2][2][4][2], const pg8::Unit& u, int wr, int wc, int fr, int fq) const {
        const int row0 = u.pm * 256 + wr * 64 + fr, col0 = u.pn * 256 + wc * 32 + 8 * fq;
#pragma unroll
        for (int ai = 0; ai < 2; ++ai)
#pragma unroll
            for (int m = 0; m < 4; ++m) { bf16_t* rowp = z + (size_t)(row0 + ai * 128 + m * 16) * ZLD + col0;
#pragma unroll
                for (int bj = 0; bj < 2; ++bj) { const pg8::f32x4 v0 = acc[ai][bj][m][0], v1 = acc[ai][bj][m][1];
                    pg8::u32x4 w; w.x = pg8::cvt_pk_bf16(v0[0], v0[1]); w.y = pg8::cvt_pk_bf16(v0[2], v0[3]); w.z = pg8::cvt_pk_bf16(v1[0], v1[1]); w.w = pg8::cvt_pk_bf16(v1[2], v1[3]);
                    *(pg8::u32x4*)(rowp + bj * 128) = w; } }
    }
};
struct EpiOut {
    float* xcur; const float* mod; int l; const float* xin; const float* cin;
    __device__ __forceinline__ void operator()(const pg8::f32x4 (&acc)[2][2][4][2], const pg8::Unit& u, int wr, int wc, int fr, int fq) const {
        const int row0 = u.pm * 256 + wr * 64 + fr, col0 = u.pn * 256 + wc * 32 + 4 * fq;
#pragma unroll
        for (int ai = 0; ai < 2; ++ai)
#pragma unroll
            for (int m = 0; m < 4; ++m) { const int g = row0 + ai * 128 + m * 16; float* xr = xcur + (size_t)g * D + col0; const float* gt = mod + (size_t)(l * 5 + modrow(g)) * 6 * D + 2 * D + col0;
                const int gb = g / TT, gs = g - gb * TT; const float* xs = l != 0 ? xr : (gs < LC ? cin + (size_t)(gb * LC + gs) * D : xin + (size_t)(gb * L + (gs - LC)) * D) + col0;
#pragma unroll
                for (int bj = 0; bj < 2; ++bj)
#pragma unroll
                    for (int n = 0; n < 2; ++n) { const int co = bj * 128 + n * 16; pg8::f32x4 x4 = *(const pg8::f32x4*)(xs + co); const pg8::f32x4 g4 = *(const pg8::f32x4*)(gt + co); x4 += g4 * acc[ai][bj][m][n]; *(pg8::f32x4*)(xr + co) = x4; } }
    }
};
__device__ __forceinline__ void phase_gemm_in(const Params& p, LAS unsigned char* stage, int l, int bid, int nb) {
    pg8::DenseSched S; S.nM = M / 256; S.nN = ZLD / 256; S.nwg = S.nM * S.nN; S.G = nb; S.c = bid; S.Bt = (const char*)p.WinT; S.rowbytes = D * 2; S.skipctx = 0;
    EpiZ E; E.z = p.z;
    pg8::gemm_phase<true>(stage, (const char*)p.h, D, S, E);
}
__device__ __forceinline__ void phase_gemm_out(const Params& p, LAS unsigned char* stage, int l, int bid, int nb) {
    pg8::DenseSched S; S.skipctx = (l == 1); S.nM = S.skipctx ? NB * L / 256 : M / 256; S.nN = D / 256; S.nwg = S.nM * S.nN; S.G = nb; S.c = bid; S.Bt = (const char*)(p.WoutT + (size_t)l * D * D); S.rowbytes = D * 2;
    EpiOut E; E.xcur = p.xcur; E.mod = p.mod; E.l = l; E.xin = p.x; E.cin = p.ctx;
    pg8::gemm_phase<false>(stage, (const char*)p.mix, D, S, E);
    if (l == 0 && tail_idle(S.nwg, S.G, S.c)) convert_tail(p, (float*)(unsigned char*)stage, CVQ_OUT);
}
__device__ __forceinline__ void phase_prep(const Params& p, float* lds, int l, int bid, int nb) {
    const int tix = otid();
    const int tid = tix;
    {
        float* cst = lds;
        __syncthreads();
        for (int i = tid; i < 1024; i += NT) { const int pos = i >> 4, f = i & 15; float sn, cs; sincosf((float)pos * expf(-(float)f * (9.210340371976184f / 16.0f)), &sn, &cs); cst[i] = cs; cst[1024 + i] = sn; }
        __syncthreads();
        const int lane = tid & 63, wid = tid >> 6;
        const int tl = lane >> 3, dv = lane & 7, axis = dv >> 2, half = (dv >> 1) & 1, f0 = 8 * (dv & 1);
        bf16_t* Tw = (bf16_t*)(lds + 2048) + wid * (64 * 72);
        for (int wt = bid * 8 + wid; wt < NB * 12 * (TT / 64); wt += nb * 8) {
            const int tile = wt % (TT / 64), bh = wt / (TT / 64), b = bh / 12, hh = bh % 12, s0 = tile * 64;
#pragma unroll 2
            for (int i = 0; i < 8; ++i) {
                const int s = s0 + 8 * i + tl; const bf16_t* zr = p.z + (size_t)(b * TT + s) * ZLD + ZB + hh * 64 + 8 * dv;
                const uint4 q8 = *(const uint4*)zr, k8 = *(const uint4*)(zr + 768), v8 = *(const uint4*)(zr + 1536);
                *(uint4*)(p.Qa + ((size_t)bh * TT + s) * 64 + 8 * dv) = q8;
                const unsigned vw[4] = {v8.x, v8.y, v8.z, v8.w};
#pragma unroll
                for (int e = 0; e < 4; ++e) { Tw[(8 * dv + 2 * e) * 72 + 8 * i + tl] = (bf16_t)(vw[e] & 0xffffu); Tw[(8 * dv + 2 * e + 1) * 72 + 8 * i + tl] = (bf16_t)(vw[e] >> 16); }
                uint4 ko = k8;
                if (s >= LC) {
                    const int t = s - LC, pos = axis == 0 ? (t >> 6) : (t & 63);
                    const unsigned qw[4] = {q8.x, q8.y, q8.z, q8.w}, kw[4] = {k8.x, k8.y, k8.z, k8.w};
                    unsigned qo[4], kq[4];
#pragma unroll
                    for (int e = 0; e < 4; ++e) {
                        const unsigned qpw = (unsigned)bperm_i(lane ^ 2, (int)qw[e]), kpw = (unsigned)bperm_i(lane ^ 2, (int)kw[e]);
                        const float c0 = cst[pos * 16 + f0 + 2 * e], s0f = cst[1024 + pos * 16 + f0 + 2 * e], c1 = cst[pos * 16 + f0 + 2 * e + 1], s1f = cst[1024 + pos * 16 + f0 + 2 * e + 1];
                        const float qa0 = bfl(qw[e]), qa1 = bfh(qw[e]), qb0 = bfl(qpw), qb1 = bfh(qpw), ka0 = bfl(kw[e]), ka1 = bfh(kw[e]), kb0 = bfl(kpw), kb1 = bfh(kpw);
                        const float sg = half == 0 ? -1.f : 1.f;
                        qo[e] = pg8::cvt_pk_bf16(qa0 * c0 + sg * qb0 * s0f, qa1 * c1 + sg * qb1 * s1f);
                        kq[e] = pg8::cvt_pk_bf16(ka0 * c0 + sg * kb0 * s0f, ka1 * c1 + sg * kb1 * s1f);
                    }
                    *(uint4*)(p.Qr + ((size_t)bh * L + t) * 64 + 8 * dv) = make_uint4(qo[0], qo[1], qo[2], qo[3]);
                    ko = make_uint4(kq[0], kq[1], kq[2], kq[3]);
                }
                *(uint4*)(p.Ka + ((((size_t)bh * (TT / 16) + (s >> 4)) * 2 + (dv >> 2)) * 16 + (s & 15)) * 32 + 8 * (dv & 3)) = ko;
            }
            __builtin_amdgcn_wave_barrier();
#pragma unroll 2
            for (int i = 0; i < 8; ++i) {
                const int item = i * 64 + lane, q4 = item & 3, d = (item >> 2) & 63, blk = item >> 8;
                const uint2 lo = *(const uint2*)(Tw + d * 72 + blk * 32 + 4 * q4), hi = *(const uint2*)(Tw + d * 72 + blk * 32 + 16 + 4 * q4);
                *(uint4*)(p.Vt + (((size_t)bh * (TT / 32) + tile * 2 + blk) * 64 + d) * 32 + 8 * q4) = make_uint4(lo.x, lo.y, hi.x, hi.y); }
            __builtin_amdgcn_wave_barrier();
        }
        __syncthreads();
    }
    const float* cw = p.conv_w + (size_t)l * 3 * 512;
    for (int i = bid * NT + tid; i < M * 64; i += nb * NT) {
        const int ch = (i & 63) * 8, g = i >> 6, s = g % TT;
        const bf16_t* zr = p.z + (size_t)g * ZLD + ch;
        const uint4 bg = *(const uint4*)zr, cg = *(const uint4*)(zr + 512), hv = *(const uint4*)(zr + 1024);
        uint4 cgp = make_uint4(0u, 0u, 0u, 0u), hp = cgp, cgn = cgp, hn = cgp;
        if (s != 0 && s != LC) { cgp = *(const uint4*)(zr + 512 - ZLD); hp = *(const uint4*)(zr + 1024 - ZLD); }
        if (s != LC - 1 && s != TT - 1) { cgn = *(const uint4*)(zr + 512 + ZLD); hn = *(const uint4*)(zr + 1024 + ZLD); }
        const float4 w0a = *(const float4*)(cw + ch), w0b = *(const float4*)(cw + ch + 4), w1a = *(const float4*)(cw + 512 + ch), w1b = *(const float4*)(cw + 512 + ch + 4), w2a = *(const float4*)(cw + 1024 + ch), w2b = *(const float4*)(cw + 1024 + ch + 4);
        const float w0[8] = {w0a.x, w0a.y, w0a.z, w0a.w, w0b.x, w0b.y, w0b.z, w0b.w}, w1[8] = {w1a.x, w1a.y, w1a.z, w1a.w, w1b.x, w1b.y, w1b.z, w1b.w}, w2[8] = {w2a.x, w2a.y, w2a.z, w2a.w, w2b.x, w2b.y, w2b.z, w2b.w};
        const unsigned bgw[4] = {bg.x, bg.y, bg.z, bg.w}, cgw[4] = {cg.x, cg.y, cg.z, cg.w}, hw[4] = {hv.x, hv.y, hv.z, hv.w}, cpw[4] = {cgp.x, cgp.y, cgp.z, cgp.w}, hpw[4] = {hp.x, hp.y, hp.z, hp.w}, cnw[4] = {cgn.x, cgn.y, cgn.z, cgn.w}, hnw[4] = {hn.x, hn.y, hn.z, hn.w};
        unsigned o[4];
#pragma unroll
        for (int e = 0; e < 4; ++e) {
            const float r0 = bfl(bgw[e]) * (w0[2 * e] * bfl(cpw[e]) * bfl(hpw[e]) + w1[2 * e] * bfl(cgw[e]) * bfl(hw[e]) + w2[2 * e] * bfl(cnw[e]) * bfl(hnw[e]));
            const float r1 = bfh(bgw[e]) * (w0[2 * e + 1] * bfh(cpw[e]) * bfh(hpw[e]) + w1[2 * e + 1] * bfh(cgw[e]) * bfh(hw[e]) + w2[2 * e + 1] * bfh(cnw[e]) * bfh(hnw[e]));
            o[e] = pg8::cvt_pk_bf16(r0, r1);
        }
        *(uint4*)(p.mix + (size_t)g * D + ch) = make_uint4(o[0], o[1], o[2], o[3]);
    }
}

typedef short rw_bf16x8 __attribute__((ext_vector_type(8)));
typedef float rw_f32x4 __attribute__((ext_vector_type(4)));
constexpr int RLD = 72, FLD = 68, GLD = 104;
constexpr int RW_UNITS = NB * 12 * (TT / 64) * 2;
template <int K> __device__ __forceinline__ void mm_t(rw_f32x4 (&acc)[2], const bf16_t* A, int lda, const bf16_t* Bt, int ldb, int rb, int ch, int fr, int q) {
#pragma unroll
    for (int ks = 0; ks < K / 32; ++ks) {
        const rw_bf16x8 a = *(const rw_bf16x8*)(A + (16 * rb + fr) * lda + 32 * ks + 8 * q);
#pragma unroll
        for (int nt = 0; nt < 2; ++nt) { const rw_bf16x8 b = *(const rw_bf16x8*)(Bt + (32 * ch + 16 * nt + fr) * ldb + 32 * ks + 8 * q); acc[nt] = __builtin_amdgcn_mfma_f32_16x16x32_bf16(b, a, acc[nt], 0, 0, 0); }
    }
}
__device__ __forceinline__ bool rw_map(int tid, int n, int hh, int& kind, int& c8, int& col, int& rg) {
    const int w = __builtin_amdgcn_readfirstlane(tid >> 6), ln = tid & 63; rg = ln & 7; const int cvl = ln >> 3;
    if (w < 3) { kind = w; c8 = cvl * 8; col = w * 768 + hh * 64 + c8; return true; }
    if (w < 5) { kind = w; c8 = cvl * 8; col = (w == 3 ? 2400 : 2496) + n * 48 + c8; return cvl < 6; }
    if (w < 7) { kind = 5; const int cg = (w - 5) * 8 + cvl; c8 = cg * 8; col = 2304 + c8; return n == 0 && cg < 12; }
    kind = 6; c8 = 0; col = 0; return false;
}
struct RwPre { uint4 raw[10]; float4 m0a, m0b, m1a, m1b; };
__device__ __forceinline__ void rwkv_prefetch(const Params& p, int l, int unit, int tid, RwPre& P) {
    const int n = unit & 1, ci = (unit >> 1) % (TT / 64), bh = (unit >> 1) / (TT / 64), b = bh / 12, hh = bh % 12;
    const int segb = ci < 4 ? 0 : LC, sege = ci < 4 ? LC : TT, s0 = ci * 64;
    int kind, c8, col, rg; const bool act = rw_map(tid, n, hh, kind, c8, col, rg);
#pragma unroll
    for (int i = 0; i < 10; ++i) P.raw[i] = make_uint4(0u, 0u, 0u, 0u);
    if (unit < RW_UNITS && act) {
        const int j0 = 8 * rg;
        const int ta = n == 0 ? s0 + j0 : s0 + 63 - j0 - 7;
        const bf16_t* zp = p.z + (size_t)(b * TT + ta) * ZLD + ZC + col;
#pragma unroll
        for (int i = 0; i < 10; ++i) { const int tk = ta - 1 + i; if (tk >= segb && tk < sege) P.raw[i] = *(const uint4*)(zp + (ptrdiff_t)(i - 1) * ZLD); }
        const float* mu = p.rw_shift + (size_t)l * 2 * RWC;
        P.m0a = *(const float4*)(mu + col); P.m0b = *(const float4*)(mu + col + 4); P.m1a = *(const float4*)(mu + RWC + col); P.m1b = *(const float4*)(mu + RWC + col + 4);
    }
}
__device__ __forceinline__ void rwkv_unit(const Params& p, unsigned char* Lb, int l, int unit, int unit_next, RwPre& P) {
    const int tid = otid(), wid = tid >> 6, lane = tid & 63, rb = wid & 3, ch = wid >> 2, fr = lane & 15, q = lane >> 4;
    const int n = unit & 1, ci = (unit >> 1) % (TT / 64), bh = (unit >> 1) / (TT / 64), b = bh / 12, hh = bh % 12;
    const int segb = ci < 4 ? 0 : LC, sege = ci < 4 ? LC : TT, s0 = ci * 64;
    float* rf = (float*)Lb; float* kf = rf + 64 * FLD; float* red = kf + 64 * FLD;
    bf16_t* Aw = (bf16_t*)(Lb + 36864); bf16_t* Aa = Aw + 64 * RLD; bf16_t* Bw = Aa + 64 * RLD; bf16_t* Ba = Bw + 64 * RLD; bf16_t* Ag = Ba + 64 * RLD; bf16_t* Bg = Ag + 64 * GLD;
    bf16_t* Rt = (bf16_t*)(Lb + 36864); bf16_t* Kt = (bf16_t*)(Lb + 46080); bf16_t* Bt = (bf16_t*)(Lb + 55296); bf16_t* kap = (bf16_t*)(Lb + 64512);
    bf16_t* KtT = (bf16_t*)(Lb + 73728); bf16_t* BtT = (bf16_t*)(Lb + 82944); bf16_t* kapT = (bf16_t*)(Lb + 92160); bf16_t* VT = (bf16_t*)(Lb + 101376);
    float* btot = (float*)(Lb + 110592); float* GCv = btot + 256;
    bf16_t* Akk = (bf16_t*)(Lb + 27648); bf16_t* Ark = (bf16_t*)(Lb + 111872); bf16_t* Arb = (bf16_t*)(Lb + 121088); bf16_t* XT = (bf16_t*)(Lb + 130304);
    bf16_t* const Ms[2] = {(bf16_t*)(Lb + 0), (bf16_t*)(Lb + 46080)}; bf16_t* const MTs[2] = {(bf16_t*)(Lb + 9216), (bf16_t*)(Lb + 55296)}; bf16_t* const Ts[2] = {(bf16_t*)(Lb + 18432), (bf16_t*)(Lb + 64512)};
    const float* mu = p.rw_shift + (size_t)l * 2 * RWC;
    lds_barrier();
    float4 cst[2][5];
#pragma unroll
    for (int nt = 0; nt < 2; ++nt) { const int c = hh * 64 + 32 * ch + 16 * nt + 4 * q;
        cst[nt][0] = *(const float4*)(p.rw_k_k + (size_t)l * 768 + c); cst[nt][1] = *(const float4*)(p.rw_k_a + (size_t)l * 768 + c); cst[nt][2] = *(const float4*)(p.rw_r_k + (size_t)l * 768 + c);
        cst[nt][3] = *(const float4*)(p.rw_w0 + ((size_t)l * 2 + n) * 768 + c); cst[nt][4] = *(const float4*)(p.rw_a0 + ((size_t)l * 2 + n) * 768 + c); }
    const uint4* srcw = (const uint4*)(p.Lwa + (size_t)((l * 2 + n) * 12 + hh) * 2 * 64 * 72);
    const uint4* srcg = (const uint4*)(p.Lg + (size_t)(l * 12 + hh) * 64 * 104);
    const uint4 wv0 = srcw[tid], wv1 = srcw[tid + 512], wv2 = tid < 128 ? srcw[tid + 1024] : make_uint4(0u, 0u, 0u, 0u);
    uint4 gv0 = make_uint4(0u, 0u, 0u, 0u), gv1 = gv0; if (n == 0) { gv0 = srcg[tid]; if (tid < 320) gv1 = srcg[tid + 512]; }
    {
        int kind, c8, col, rg;
        if (rw_map(tid, n, hh, kind, c8, col, rg)) {
            const int j0 = 8 * rg;
            const int ta = n == 0 ? s0 + j0 : s0 + 63 - j0 - 7;
            const float m0[8] = {P.m0a.x, P.m0a.y, P.m0a.z, P.m0a.w, P.m0b.x, P.m0b.y, P.m0b.z, P.m0b.w}, m1[8] = {P.m1a.x, P.m1a.y, P.m1a.z, P.m1a.w, P.m1b.x, P.m1b.y, P.m1b.z, P.m1b.w};
            unsigned vpk[8][4];
#pragma unroll
            for (int i = 0; i < 8; ++i) {
                const int tk = ta + i, j = n == 0 ? tk - s0 : s0 + 63 - tk;
                const uint4 pu = P.raw[i], cu = P.raw[i + 1], nu = P.raw[i + 2];
                const unsigned pw[4] = {pu.x, pu.y, pu.z, pu.w}, cw[4] = {cu.x, cu.y, cu.z, cu.w}, nw[4] = {nu.x, nu.y, nu.z, nu.w};
                float x[8];
#pragma unroll
                for (int e = 0; e < 4; ++e) { const float c0 = bfl(cw[e]), c1 = bfh(cw[e]);
                    x[2 * e] = c0 + m0[2 * e] * (bfl(pw[e]) - c0) + m1[2 * e] * (bfl(nw[e]) - c0); x[2 * e + 1] = c1 + m0[2 * e + 1] * (bfh(pw[e]) - c1) + m1[2 * e + 1] * (bfh(nw[e]) - c1); }
                if (kind == 0) { *(float4*)(rf + j * FLD + c8) = make_float4(x[0], x[1], x[2], x[3]); *(float4*)(rf + j * FLD + c8 + 4) = make_float4(x[4], x[5], x[6], x[7]); }
                else if (kind == 1) { *(float4*)(kf + j * FLD + c8) = make_float4(x[0], x[1], x[2], x[3]); *(float4*)(kf + j * FLD + c8 + 4) = make_float4(x[4], x[5], x[6], x[7]); }
                else if (kind == 2) {
#pragma unroll
                    for (int e = 0; e < 8; ++e) { const unsigned hbits = (unsigned)f2bf(x[e]); vpk[e][i >> 1] = (i & 1) ? (vpk[e][i >> 1] | (hbits << 16)) : hbits; }
                    if (n == 0) { uint4 o; o.x = pg8::cvt_pk_bf16(x[0], x[1]); o.y = pg8::cvt_pk_bf16(x[2], x[3]); o.z = pg8::cvt_pk_bf16(x[4], x[5]); o.w = pg8::cvt_pk_bf16(x[6], x[7]);
                        *(uint4*)(p.rw_vb + ((size_t)(bh * (TT / 64) + ci) * 64 + j) * 64 + c8) = o; } }
                else {
                    bf16_t* dst = kind == 3 ? Aw + j * RLD + c8 : (kind == 4 ? Aa + j * RLD + c8 : Ag + j * GLD + c8);
                    if (kind == 3) {
#pragma unroll
                        for (int e = 0; e < 8; ++e) x[e] = 1.0f - 2.0f * __builtin_amdgcn_rcpf(1.0f + __builtin_amdgcn_exp2f(2.8853900817779268f * x[e])); }
                    else if (kind == 5) {
#pragma unroll
                        for (int e = 0; e < 8; ++e) x[e] = __builtin_amdgcn_rcpf(1.0f + __builtin_amdgcn_exp2f(-1.4426950408889634f * x[e])); }
                    uint4 o; o.x = pg8::cvt_pk_bf16(x[0], x[1]); o.y = pg8::cvt_pk_bf16(x[2], x[3]); o.z = pg8::cvt_pk_bf16(x[4], x[5]); o.w = pg8::cvt_pk_bf16(x[6], x[7]); *(uint4*)dst = o;
                }
            }
            if (kind == 2) {
#pragma unroll
                for (int e = 0; e < 8; ++e) { uint4 o = make_uint4(vpk[e][0], vpk[e][1], vpk[e][2], vpk[e][3]);
                    if (n != 0) o = make_uint4((o.w << 16) | (o.w >> 16), (o.z << 16) | (o.z >> 16), (o.y << 16) | (o.y >> 16), (o.x << 16) | (o.x >> 16));
                    *(uint4*)(VT + (c8 + e) * RLD + j0) = o; }
            }
        }
    }
    for (int i = tid; i < 64 * 16; i += NT) { const int j = i >> 4, c = 48 + (i & 15); Aw[j * RLD + c] = 0; Aa[j * RLD + c] = 0; }
    { uint4* dw = (uint4*)Bw; dw[tid] = wv0; dw[tid + 512] = wv1; if (tid < 128) dw[tid + 1024] = wv2;
      if (n == 0) { uint4* dg = (uint4*)Bg; dg[tid] = gv0; if (tid < 320) dg[tid + 512] = gv1; } }
    rwkv_prefetch(p, l, unit_next, tid, P);
    lds_barrier();
    rw_f32x4 accw[2], acca[2], accg[2];
#pragma unroll
    for (int nt = 0; nt < 2; ++nt) { accw[nt] = (rw_f32x4){0.f, 0.f, 0.f, 0.f}; acca[nt] = accw[nt]; accg[nt] = accw[nt]; }
    mm_t<64>(accw, Aw, RLD, Bw, RLD, rb, ch, fr, q);
    mm_t<64>(acca, Aa, RLD, Ba, RLD, rb, ch, fr, q);
    if (n == 0) mm_t<96>(accg, Ag, GLD, Bg, GLD, rb, ch, fr, q);
    const int t = 16 * rb + fr, s = n == 0 ? s0 + t : s0 + 63 - t, g = b * TT + s;
    float kv[2][4], rv[2][4], kkr[2][4], av[2][4], lw[2][4], kd[2][4], G[2][4]; float ssq = 0.f, bon = 0.f;
#pragma unroll
    for (int nt = 0; nt < 2; ++nt) {
        const int c = 32 * ch + 16 * nt + 4 * q;
        const float4 k4 = *(const float4*)(kf + t * FLD + c), r4 = *(const float4*)(rf + t * FLD + c);
        const float4 kk4 = cst[nt][0], ka4 = cst[nt][1], rk4 = cst[nt][2], w04 = cst[nt][3], a04 = cst[nt][4];
        const float ke[4] = {k4.x, k4.y, k4.z, k4.w}, re[4] = {r4.x, r4.y, r4.z, r4.w}, kke[4] = {kk4.x, kk4.y, kk4.z, kk4.w}, kae[4] = {ka4.x, ka4.y, ka4.z, ka4.w}, rke[4] = {rk4.x, rk4.y, rk4.z, rk4.w}, w0e[4] = {w04.x, w04.y, w04.z, w04.w}, a0e[4] = {a04.x, a04.y, a04.z, a04.w};
#pragma unroll
        for (int j = 0; j < 4; ++j) {
            kv[nt][j] = ke[j]; rv[nt][j] = re[j]; kkr[nt][j] = ke[j] * kke[j]; ssq += kkr[nt][j] * kkr[nt][j];
            const float wpre = w0e[j] + accw[nt][j]; lw[nt][j] = -0.6065306597126334f * __builtin_amdgcn_rcpf(1.0f + __expf(-wpre));
            av[nt][j] = __builtin_amdgcn_rcpf(1.0f + __expf(-(a0e[j] + acca[nt][j])));
            kd[nt][j] = ke[j] * (1.0f + (av[nt][j] - 1.0f) * kae[j]); bon += re[j] * kd[nt][j] * rke[j];
            float x = lw[nt][j];
            x += __int_as_float(__builtin_amdgcn_update_dpp(0, __float_as_int(x), 0x111, 0xF, 0xF, true)); x += __int_as_float(__builtin_amdgcn_update_dpp(0, __float_as_int(x), 0x112, 0xF, 0xF, true));
            x += __int_as_float(__builtin_amdgcn_update_dpp(0, __float_as_int(x), 0x114, 0xF, 0xF, true)); x += __int_as_float(__builtin_amdgcn_update_dpp(0, __float_as_int(x), 0x118, 0xF, 0xF, true));
            G[nt][j] = x; if (fr == 15) btot[rb * 64 + c + j] = x;
        }
    }
    ssq += bperm_f(lane ^ 16, ssq); ssq += bperm_f(lane ^ 32, ssq); bon += bperm_f(lane ^ 16, bon); bon += bperm_f(lane ^ 32, bon);
    if (q == 0) { red[ch * 64 + t] = ssq; red[128 + ch * 64 + t] = bon; }
    lds_barrier();
    const float rnorm = 1.0f / fmaxf(sqrtf(red[t] + red[64 + t]), 1e-12f);
    if (ch == 0 && q == 0) p.bonus[((size_t)n * M + g) * 12 + hh] = red[128 + t] + red[192 + t];
    const size_t uoff = (size_t)unit * 4096;
#pragma unroll
    for (int nt = 0; nt < 2; ++nt)
#pragma unroll
        for (int j = 0; j < 4; ++j) { const int c = 32 * ch + 16 * nt + 4 * q + j; float pre = 0.f, tot = 0.f;
#pragma unroll
            for (int r2 = 0; r2 < 4; ++r2) { const float bt = btot[r2 * 64 + c]; tot += bt; if (r2 < rb) pre += bt; }
            G[nt][j] += pre; if (t == 63) GCv[c] = __expf(tot); }
#pragma unroll
    for (int nt = 0; nt < 2; ++nt) {
        const int c = 32 * ch + 16 * nt + 4 * q;
        float rt[4], kt[4], bt[4], kp[4];
#pragma unroll
        for (int j = 0; j < 4; ++j) { const float gam = __expf(G[nt][j]), ig = __expf(-G[nt][j]), gp = __expf(G[nt][j] - lw[nt][j]); const float kk = kkr[nt][j] * rnorm;
            rt[j] = rv[nt][j] * gam; kt[j] = kd[nt][j] * ig; bt[j] = kk * av[nt][j] * ig; kp[j] = kk * gp;
            KtT[(c + j) * RLD + t] = f2bf(kt[j]); BtT[(c + j) * RLD + t] = f2bf(bt[j]); kapT[(c + j) * RLD + t] = f2bf(kp[j]); }
        uint2 o; o.x = pg8::cvt_pk_bf16(rt[0], rt[1]); o.y = pg8::cvt_pk_bf16(rt[2], rt[3]); *(uint2*)(Rt + t * RLD + c) = o;
        o.x = pg8::cvt_pk_bf16(kt[0], kt[1]); o.y = pg8::cvt_pk_bf16(kt[2], kt[3]); *(uint2*)(Kt + t * RLD + c) = o;
        o.x = pg8::cvt_pk_bf16(bt[0], bt[1]); o.y = pg8::cvt_pk_bf16(bt[2], bt[3]); *(uint2*)(Bt + t * RLD + c) = o;
        o.x = pg8::cvt_pk_bf16(kp[0], kp[1]); o.y = pg8::cvt_pk_bf16(kp[2], kp[3]); *(uint2*)(kap + t * RLD + c) = o;
        if (n == 0) { o.x = pg8::cvt_pk_bf16(accg[nt][0], accg[nt][1]); o.y = pg8::cvt_pk_bf16(accg[nt][2], accg[nt][3]); *(uint2*)(p.rw_gb + ((size_t)(bh * (TT / 64) + ci) * 64 + t) * 64 + c) = o; }
    }
    lds_barrier();
#define RW_ZERO(a) do { a[0] = (rw_f32x4){0.f, 0.f, 0.f, 0.f}; a[1] = a[0]; } while (0)
#define RW_STORE_BF(dst, a) do { _Pragma("unroll") for (int _nt = 0; _nt < 2; ++_nt) { uint2 _o; _o.x = pg8::cvt_pk_bf16(a[_nt][0], a[_nt][1]); _o.y = pg8::cvt_pk_bf16(a[_nt][2], a[_nt][3]); \
        *(uint2*)((dst) + t * RLD + 32 * ch + 16 * _nt + 4 * q) = _o; } } while (0)
    { rw_f32x4 a1[2], a2[2], a3[2], a4[2], a5[2]; RW_ZERO(a1); RW_ZERO(a2); RW_ZERO(a3); RW_ZERO(a4); RW_ZERO(a5);
      mm_t<64>(a1, kap, RLD, Bt, RLD, rb, ch, fr, q);
      mm_t<64>(a2, Bt, RLD, kap, RLD, rb, ch, fr, q);
      mm_t<64>(a3, kap, RLD, Kt, RLD, rb, ch, fr, q);
      mm_t<64>(a4, Rt, RLD, Kt, RLD, rb, ch, fr, q);
      mm_t<64>(a5, Rt, RLD, Bt, RLD, rb, ch, fr, q);
      rw_f32x4 t1[2];
#pragma unroll
      for (int nt = 0; nt < 2; ++nt)
#pragma unroll
          for (int j = 0; j < 4; ++j) { const int cc = 32 * ch + 16 * nt + 4 * q + j;
              a1[nt][j] = cc < t ? -a1[nt][j] : 0.f; t1[nt][j] = a1[nt][j] + (cc == t ? 1.f : 0.f);
              a2[nt][j] = t < cc ? -a2[nt][j] : 0.f;
              a3[nt][j] = cc < t ? a3[nt][j] : 0.f; a4[nt][j] = cc <= t ? a4[nt][j] : 0.f; a5[nt][j] = cc <= t ? a5[nt][j] : 0.f; }
      RW_STORE_BF(Ms[0], a1); RW_STORE_BF(MTs[0], a2); RW_STORE_BF(Ts[0], t1); RW_STORE_BF(Akk, a3); RW_STORE_BF(Ark, a4); RW_STORE_BF(Arb, a5); }
    lds_barrier();
    { rw_f32x4 a1[2], a2[2], a3[2]; RW_ZERO(a1); RW_ZERO(a2); RW_ZERO(a3);
      mm_t<64>(a1, VT, RLD, Akk, RLD, rb, ch, fr, q);
      mm_t<64>(a2, Ms[0], RLD, MTs[0], RLD, rb, ch, fr, q);
      mm_t<64>(a3, MTs[0], RLD, Ms[0], RLD, rb, ch, fr, q);
      RW_STORE_BF(XT, a1); RW_STORE_BF(Ms[1], a2); RW_STORE_BF(MTs[1], a3); }
    lds_barrier();
#pragma unroll
    for (int k = 1; k <= 5; ++k) {
        const bf16_t* Tk = Ts[(k + 1) & 1]; bf16_t* Tn = Ts[k & 1];
        rw_f32x4 a1[2]; RW_ZERO(a1);
        mm_t<64>(a1, Tk, RLD, MTs[k & 1], RLD, rb, ch, fr, q);
#pragma unroll
        for (int nt = 0; nt < 2; ++nt) { const uint2 o = *(const uint2*)(Tk + t * RLD + 32 * ch + 16 * nt + 4 * q); a1[nt][0] += bfl(o.x); a1[nt][1] += bfh(o.x); a1[nt][2] += bfl(o.y); a1[nt][3] += bfh(o.y); }
        RW_STORE_BF(Tn, a1);
        if (k < 5) { rw_f32x4 a2[2], a3[2]; RW_ZERO(a2); RW_ZERO(a3);
            mm_t<64>(a2, Ms[k & 1], RLD, MTs[k & 1], RLD, rb, ch, fr, q);
            mm_t<64>(a3, MTs[k & 1], RLD, Ms[k & 1], RLD, rb, ch, fr, q);
            RW_STORE_BF(Ms[(k + 1) & 1], a2); RW_STORE_BF(MTs[(k + 1) & 1], a3); }
        lds_barrier();
    }
    { rw_f32x4 a1[2], a2[2]; RW_ZERO(a1); RW_ZERO(a2);
      mm_t<64>(a1, kapT, RLD, Ts[1], RLD, rb, ch, fr, q);
      mm_t<64>(a2, XT, RLD, Ts[1], RLD, rb, ch, fr, q);
      RW_STORE_BF(Ms[0], a1); RW_STORE_BF(MTs[0], a2); }
    lds_barrier();
    { const bf16_t* WT = Ms[0]; const bf16_t* U0T = MTs[0];
      rw_f32x4 a1[2]; RW_ZERO(a1); mm_t<64>(a1, BtT, RLD, WT, RLD, rb, ch, fr, q);
      { const float gc = GCv[t];
#pragma unroll
        for (int nt = 0; nt < 2; ++nt) { uint2 o; float e[4];
#pragma unroll
            for (int j = 0; j < 4; ++j) e[j] = gc * ((32 * ch + 16 * nt + 4 * q + j == t ? 1.f : 0.f) - a1[nt][j]);
            o.x = pg8::cvt_pk_bf16(e[0], e[1]); o.y = pg8::cvt_pk_bf16(e[2], e[3]); *(uint2*)(p.rw_P + uoff + t * 64 + 32 * ch + 16 * nt + 4 * q) = o; } }
      rw_f32x4 a2[2], a3[2]; RW_ZERO(a2); RW_ZERO(a3); mm_t<64>(a2, VT, RLD, KtT, RLD, rb, ch, fr, q); mm_t<64>(a3, U0T, RLD, BtT, RLD, rb, ch, fr, q);
#pragma unroll
      for (int nt = 0; nt < 2; ++nt) { const int c = 32 * ch + 16 * nt + 4 * q; const float4 gc4 = *(const float4*)(GCv + c);
          *(float4*)(p.rw_QT + uoff + t * 64 + c) = make_float4(gc4.x * (a2[nt][0] - a3[nt][0]), gc4.y * (a2[nt][1] - a3[nt][1]), gc4.z * (a2[nt][2] - a3[nt][2]), gc4.w * (a2[nt][3] - a3[nt][3])); }
      rw_f32x4 a4[2]; RW_ZERO(a4); mm_t<64>(a4, Arb, RLD, WT, RLD, rb, ch, fr, q);
#pragma unroll
      for (int nt = 0; nt < 2; ++nt) { const int c = 32 * ch + 16 * nt + 4 * q; const uint2 r2 = *(const uint2*)(Rt + t * RLD + c); uint2 o;
          o.x = pg8::cvt_pk_bf16(bfl(r2.x) - a4[nt][0], bfh(r2.x) - a4[nt][1]); o.y = pg8::cvt_pk_bf16(bfl(r2.y) - a4[nt][2], bfh(r2.y) - a4[nt][3]); *(uint2*)(p.rw_Ry + uoff + t * 64 + c) = o; }
      rw_f32x4 a5[2], a6[2]; RW_ZERO(a5); RW_ZERO(a6); mm_t<64>(a5, Ark, RLD, VT, RLD, rb, ch, fr, q); mm_t<64>(a6, Arb, RLD, U0T, RLD, rb, ch, fr, q);
#pragma unroll
      for (int nt = 0; nt < 2; ++nt) { const int c = 32 * ch + 16 * nt + 4 * q; *(float4*)(p.rw_Y0 + uoff + t * 64 + c) = make_float4(a5[nt][0] - a6[nt][0], a5[nt][1] - a6[nt][1], a5[nt][2] - a6[nt][2], a5[nt][3] - a6[nt][3]); } }
#undef RW_ZERO
#undef RW_STORE_BF
}

__device__ __forceinline__ void rwkv_chain(const Params& p, unsigned char* Lb, int chain) {
    const int tid = otid(), wid = tid >> 6, lane = tid & 63, rb = wid & 3, ch = wid >> 2, fr = lane & 15, q = lane >> 4;
    const int n = chain / 48, bh = chain % 48;
    bf16_t* HT[2] = {(bf16_t*)Lb, (bf16_t*)(Lb + 9216)};
    rw_f32x4 hacc[2];
    hacc[0] = (rw_f32x4){0.f, 0.f, 0.f, 0.f}; hacc[1] = hacc[0];
    __syncthreads();
    auto uoff_of = [&](int step) { const int ci = n == 0 ? step : (step < 4 ? 3 - step : (TT / 64 - 1) - (step - 4)); return (size_t)(((bh * (TT / 64) + ci) << 1) | n) * 4096; };
    struct Ops { rw_bf16x8 p0, p1; float4 q0, q1; };
    auto load_ops = [&](int step, Ops& o) { const size_t uo = uoff_of(step); const bf16_t* Pp = p.rw_P + uo + (16 * rb + fr) * 64 + 8 * q; o.p0 = *(const rw_bf16x8*)Pp; o.p1 = *(const rw_bf16x8*)(Pp + 32);
        o.q0 = *(const float4*)(p.rw_QT + uo + (32 * ch + fr) * 64 + 16 * rb + 4 * q); o.q1 = *(const float4*)(p.rw_QT + uo + (32 * ch + 16 + fr) * 64 + 16 * rb + 4 * q); };
    auto do_step = [&](int step, const Ops& o) {
        const size_t uoff = uoff_of(step);
        bf16_t* hb = HT[step & 1];
#pragma unroll
        for (int nt = 0; nt < 2; ++nt) { uint2 w; w.x = pg8::cvt_pk_bf16(hacc[nt][0], hacc[nt][1]); w.y = pg8::cvt_pk_bf16(hacc[nt][2], hacc[nt][3]);
            const int v = 32 * ch + 16 * nt + fr, k0 = 16 * rb + 4 * q;
            *(uint2*)(hb + v * RLD + k0) = w; *(uint2*)(p.rw_H0 + uoff + v * 64 + k0) = w; }
        lds_barrier();
#pragma unroll
        for (int nt = 0; nt < 2; ++nt) {
            const bf16_t* bp = hb + (32 * ch + 16 * nt + fr) * RLD + 8 * q;
            const rw_bf16x8 b0 = *(const rw_bf16x8*)bp, b1 = *(const rw_bf16x8*)(bp + 32);
            const float4 cq = nt == 0 ? o.q0 : o.q1;
            rw_f32x4 c = (rw_f32x4){cq.x, cq.y, cq.z, cq.w};
            c = __builtin_amdgcn_mfma_f32_16x16x32_bf16(o.p0, b0, c, 0, 0, 0);
            hacc[nt] = __builtin_amdgcn_mfma_f32_16x16x32_bf16(o.p1, b1, c, 0, 0, 0);
        }
    };
    Ops A, B; load_ops(0, A); load_ops(1, B);
    for (int step = 0; step < TT / 64; step += 2) {
        do_step(step, A); if (step + 2 < TT / 64) load_ops(step + 2, A);
        do_step(step + 1, B); if (step + 3 < TT / 64) load_ops(step + 3, B);
    }
}

__device__ __forceinline__ void rwkv_out(const Params& p, unsigned char* Lb, int l, int unit3) {
    const int tid = otid(), wid = tid >> 6, lane = tid & 63, rb = wid & 3, ch = wid >> 2, fr = lane & 15, q = lane >> 4;
    const int ci = unit3 % (TT / 64), bh = unit3 / (TT / 64), b = bh / 12, hh = bh % 12;
    float* red = (float*)Lb;
    const int t = 16 * rb + fr, g = b * TT + ci * 64 + t;
    rw_f32x4 y[2]; y[0] = (rw_f32x4){0.f, 0.f, 0.f, 0.f}; y[1] = y[0];
#pragma unroll
    for (int n = 0; n < 2; ++n) {
        const size_t uoff = (size_t)(((bh * (TT / 64) + ci) << 1) | n) * 4096;
        const int row = n == 0 ? t : 63 - t;
        const bf16_t* ap = p.rw_Ry + uoff + row * 64 + 8 * q;
        const rw_bf16x8 a0 = *(const rw_bf16x8*)ap, a1 = *(const rw_bf16x8*)(ap + 32);
#pragma unroll
        for (int nt = 0; nt < 2; ++nt) {
            const int c = 32 * ch + 16 * nt;
            const bf16_t* bp = p.rw_H0 + uoff + (c + fr) * 64 + 8 * q;
            const rw_bf16x8 b0 = *(const rw_bf16x8*)bp, b1 = *(const rw_bf16x8*)(bp + 32);
            const float4 y0 = *(const float4*)(p.rw_Y0 + uoff + row * 64 + c + 4 * q);
            rw_f32x4 acc = (rw_f32x4){y0.x, y0.y, y0.z, y0.w};
            acc = __builtin_amdgcn_mfma_f32_16x16x32_bf16(b0, a0, acc, 0, 0, 0);
            acc = __builtin_amdgcn_mfma_f32_16x16x32_bf16(b1, a1, acc, 0, 0, 0);
            y[nt] += acc;
        }
    }
    float s1 = 0.f, s2 = 0.f;
#pragma unroll
    for (int nt = 0; nt < 2; ++nt)
#pragma unroll
        for (int j = 0; j < 4; ++j) { s1 += y[nt][j]; s2 += y[nt][j] * y[nt][j]; }
    s1 += bperm_f(lane ^ 16, s1); s1 += bperm_f(lane ^ 32, s1); s2 += bperm_f(lane ^ 16, s2); s2 += bperm_f(lane ^ 32, s2);
    __syncthreads();
    if (q == 0) { red[ch * 64 + t] = s1; red[128 + ch * 64 + t] = s2; }
    __syncthreads();
    const float mean = (red[t] + red[64 + t]) * (1.0f / 64.0f), var = fmaxf((red[128 + t] + red[192 + t]) * (1.0f / 64.0f) - mean * mean, 0.f), rstd = rsqrtf(var + 64e-5f);
    const float bon = p.bonus[(size_t)g * 12 + hh] + p.bonus[((size_t)M + g) * 12 + hh];
    const float* gng = p.rw_gn_g + (size_t)l * 768 + hh * 64; const float* gnb = p.rw_gn_b + (size_t)l * 768 + hh * 64;
    const size_t coff = ((size_t)(bh * (TT / 64) + ci) * 64 + t) * 64;
#pragma unroll
    for (int nt = 0; nt < 2; ++nt) {
        const int c = 32 * ch + 16 * nt + 4 * q;
        const float4 gg = *(const float4*)(gng + c), gb = *(const float4*)(gnb + c);
        const uint2 vv = *(const uint2*)(p.rw_vb + coff + c), gt = *(const uint2*)(p.rw_gb + coff + c);
        const float o0 = ((y[nt][0] - mean) * rstd * gg.x + gb.x + bon * bfl(vv.x)) * bfl(gt.x), o1 = ((y[nt][1] - mean) * rstd * gg.y + gb.y + bon * bfh(vv.x)) * bfh(gt.x);
        const float o2 = ((y[nt][2] - mean) * rstd * gg.z + gb.z + bon * bfl(vv.y)) * bfl(gt.y), o3 = ((y[nt][3] - mean) * rstd * gg.w + gb.w + bon * bfh(vv.y)) * bfh(gt.y);
        uint2 o; o.x = pg8::cvt_pk_bf16(o0, o1); o.y = pg8::cvt_pk_bf16(o2, o3);
        *(uint2*)(p.mix + (size_t)g * D + 1280 + hh * 64 + c) = o;
    }
}

typedef short attn_bf16x8 __attribute__((ext_vector_type(8)));
typedef float attn_f32x4 __attribute__((ext_vector_type(4)));
constexpr int ATT_LAT = NB * 12 * 64 * 4, ATT_CTX = NB * 12 * (LC / 16), ATT_TASKS = ATT_LAT + ATT_CTX;
__device__ __forceinline__ attn_bf16x8 ld_frag16(const bf16_t* ptr) { return *(const attn_bf16x8*)ptr; }
__device__ __forceinline__ attn_bf16x8 ld_frag8x2(const bf16_t* p0, const bf16_t* p1) {
    const uint2 a = *(const uint2*)p0, b = *(const uint2*)p1; uint4 r; r.x = a.x; r.y = a.y; r.z = b.x; r.w = b.y; return *(const attn_bf16x8*)&r; }
struct AttnFrag { attn_bf16x8 k[2][2]; attn_bf16x8 v[4]; };
__device__ __forceinline__ void attn_load(AttnFrag& F, const bf16_t* Kh  , const bf16_t* Vh  , int s0  , int qi, int q) {
#pragma unroll
    for (int t = 0; t < 2; ++t)
#pragma unroll
        for (int ks = 0; ks < 2; ++ks) F.k[t][ks] = ld_frag16(Kh + ((size_t)(((s0 >> 4) + t) * 2 + ks) * 16 + qi) * 32 + 8 * q);
#pragma unroll
    for (int db = 0; db < 4; ++db) F.v[db] = ld_frag16(Vh + ((size_t)(s0 >> 5) * 64 + 16 * db + qi) * 32 + 8 * q);
}
__device__ __forceinline__ void attn_compute(const AttnFrag& F, const attn_bf16x8 (&qf)[2], int lane, float& m, float& l, attn_f32x4 (&oacc)[4],
                                             bool win, const float* brow  , unsigned vmask  , const int (&boff)[8]) {
    attn_f32x4 st[2];
#pragma unroll
    for (int t = 0; t < 2; ++t) {
        attn_f32x4 z4 = {0.f, 0.f, 0.f, 0.f};
        z4 = __builtin_amdgcn_mfma_f32_16x16x32_bf16(F.k[t][0], qf[0], z4, 0, 0, 0);
        st[t] = __builtin_amdgcn_mfma_f32_16x16x32_bf16(F.k[t][1], qf[1], z4, 0, 0, 0);
    }
    float sc[8]; float mx = -1e30f;
#pragma unroll
    for (int i = 0; i < 8; ++i) {
        float s = st[i >> 2][i & 3] * 0.18033688011112042f;
        if (win) s = ((vmask >> i) & 1u) ? s + brow[boff[i]] : -1e30f;
        sc[i] = s; mx = fmaxf(mx, s);
    }
    mx = fmaxf(mx, bperm_f(lane ^ 16, mx)); mx = fmaxf(mx, bperm_f(lane ^ 32, mx));
    if (__any(mx > m)) {
        const float mn = fmaxf(m, mx), alpha = __builtin_amdgcn_exp2f(m - mn);
        l *= alpha; m = mn;
#pragma unroll
        for (int db = 0; db < 4; ++db) oacc[db] *= alpha;
    }
    float ps = 0.f; float pv[8];
#pragma unroll
    for (int i = 0; i < 8; ++i) { pv[i] = __builtin_amdgcn_exp2f(sc[i] - m); ps += pv[i]; }
    l += ps;
    uint4 pk; pk.x = pg8::cvt_pk_bf16(pv[0], pv[1]); pk.y = pg8::cvt_pk_bf16(pv[2], pv[3]); pk.z = pg8::cvt_pk_bf16(pv[4], pv[5]); pk.w = pg8::cvt_pk_bf16(pv[6], pv[7]);
    const attn_bf16x8 pb = *(const attn_bf16x8*)&pk;
#pragma unroll
    for (int db = 0; db < 4; ++db) oacc[db] = __builtin_amdgcn_mfma_f32_16x16x32_bf16(F.v[db], pb, oacc[db], 0, 0, 0);
}
constexpr int ATT_LAT2 = NB * 12 * 64 * 2, ATT_CTX2 = NB * 12 * (LC / 32), ATT_TASKS2 = ATT_LAT2 + ATT_CTX2;
__device__ __forceinline__ void attn_task2(const Params& p, const float* rpbs  , int task) {
    const int lane = otid() & 63, qi = lane & 15, q = lane >> 4;
    const bool lat = task < ATT_LAT2;
    int bh, qrow = 0, qp;
    if (lat) { bh = task >> 7; const int rem = task & 127; qrow = rem >> 1; qp = rem & 1; }
    else { const int t2 = task - ATT_LAT2; bh = t2 >> 3; qp = t2 & 7; }
    const int b = bh / 12, hh = bh % 12;
    const bf16_t* Kh = p.Ka + (size_t)bh * TT * 64; const bf16_t* Vh = p.Vt + (size_t)bh * 64 * TT;
    int sq[2]; attn_bf16x8 qa[2][2], qr[2][2];
#pragma unroll
    for (int u = 0; u < 2; ++u) {
        sq[u] = lat ? LC + qrow * 64 + (2 * qp + u) * 16 + qi : (2 * qp + u) * 16 + qi;
        const bf16_t* qp0 = p.Qa + ((size_t)bh * TT + sq[u]) * 64 + 8 * q; qa[u][0] = ld_frag16(qp0); qa[u][1] = ld_frag16(qp0 + 32); qr[u][0] = qa[u][0]; qr[u][1] = qa[u][1];
        if (lat) { const bf16_t* qp1 = p.Qr + ((size_t)bh * L + (sq[u] - LC)) * 64 + 8 * q; qr[u][0] = ld_frag16(qp1); qr[u][1] = ld_frag16(qp1 + 32); }
    }
    const int krow0 = min(max(qrow - 4, 0), 56);
    bool need0[2], need1[2]; unsigned vm0[2], vm1[2]; int boff[2][8];
#pragma unroll
    for (int u = 0; u < 2; ++u) { const int qb = 2 * qp + u, qc = qb * 16 + qi, kcol0 = min(max(qc - 8, 0), 48);
        const int clo = min(max(qb * 16 - 8, 0), 48), chi = min(max(qb * 16 + 7, 0), 48) + 16; need0[u] = clo < 32; need1[u] = chi > 32; vm0[u] = 0u; vm1[u] = 0u;
#pragma unroll
        for (int i = 0; i < 8; ++i) { const int kc = 16 * (i >> 2) + 4 * q + (i & 3); boff[u][i] = kc - qc + 15; vm0[u] |= ((unsigned)(kc - kcol0) < 16u ? 1u : 0u) << i; vm1[u] |= ((unsigned)(kc + 32 - kcol0) < 16u ? 1u : 0u) << i; } }
    const bool cb0 = need0[0] || need0[1], cb1 = need1[0] || need1[1]; const int ncb = (cb0 && cb1) ? 2 : 1, cbo = cb0 ? 0 : 1;
    const int nsteps = lat ? 8 + 8 * ncb : 8;
    float m[2] = {-1e30f, -1e30f}, l[2] = {0.f, 0.f}; attn_f32x4 oacc[2][4];
#pragma unroll
    for (int u = 0; u < 2; ++u)
#pragma unroll
        for (int db = 0; db < 4; ++db) oacc[u][db] = (attn_f32x4){0.f, 0.f, 0.f, 0.f};
#define ATT_S0(s, s0v, krv, cbv) do { if ((s) < 8) { s0v = (s) * 32; krv = 0; cbv = 0; } else { const int _w = (s) - 8; krv = ncb == 2 ? (_w >> 1) : _w; cbv = ncb == 2 ? (_w & 1) : cbo; s0v = LC + (krow0 + krv) * 64 + cbv * 32; } } while (0)
#define ATT_LOAD(F, s) do { int _s0, _kr, _cb; ATT_S0((s), _s0, _kr, _cb); attn_load(F, Kh, Vh, _s0, qi, q); } while (0)
#define ATT_COMP(F, s) do { int _s0, _kr, _cb; ATT_S0((s), _s0, _kr, _cb); const bool _w = (s) >= 8; const float* _br = rpbs + hh * 465 + (krow0 + _kr - qrow + 7) * 31; \
        _Pragma("unroll") for (int u = 0; u < 2; ++u) if (!_w || (_cb == 0 ? need0[u] : need1[u])) attn_compute(F, _w ? qr[u] : qa[u], lane, m[u], l[u], oacc[u], _w, _br + _cb * 32, _cb ? vm1[u] : vm0[u], boff[u]); } while (0)
    AttnFrag FA, FB;
    ATT_LOAD(FA, 0);
    for (int s = 0; s < nsteps; s += 2) {
        ATT_LOAD(FB, s + 1);
        ATT_COMP(FA, s);
        if (s + 2 < nsteps) ATT_LOAD(FA, s + 2);
        ATT_COMP(FB, s + 1);
    }
#undef ATT_S0
#undef ATT_LOAD
#undef ATT_COMP
#pragma unroll
    for (int u = 0; u < 2; ++u) {
        float lt = l[u]; lt += bperm_f(lane ^ 16, lt); lt += bperm_f(lane ^ 32, lt);
        const float rinv = 1.0f / lt;
        bf16_t* op = p.mix + (size_t)(b * TT + sq[u]) * D + 512 + hh * 64 + 4 * q;
#pragma unroll
        for (int db = 0; db < 4; ++db) { uint2 w; w.x = pg8::cvt_pk_bf16(oacc[u][db][0] * rinv, oacc[u][db][1] * rinv); w.y = pg8::cvt_pk_bf16(oacc[u][db][2] * rinv, oacc[u][db][3] * rinv); *(uint2*)(op + 16 * db) = w; }
    }
}

constexpr int RT_LD = 2052;
__device__ __forceinline__ void phase_router(const Params& p, unsigned char* Lb, int l, int bid, int nb) {
    const int tix = otid(), wid = tix >> 6, lane = tix & 63;
    float* At = (float*)Lb;
    float* Pp = At + 16 * RT_LD;
    int* ent = (int*)(Pp + 2 * 16 * 64);
    int* lcnt = ent + 480 * 4; int* lbase = lcnt + 64;
    const float* gam = p.norm2_g + (size_t)l * D;
    __syncthreads();
    if (tix < 64) lcnt[tix] = 0;
    int nloc = 0;
    const bool latonly = (l == 1);
    for (int tile = bid; tile < (latonly ? NB * L / 16 : M / 16); tile += nb, ++nloc) {
        const int g0 = latonly ? (tile >> 8) * TT + LC + (tile & 255) * 16 : tile * 16;
        __syncthreads();
#pragma unroll 1
        for (int rr = 0; rr < 2; ++rr) {
            const int r = 2 * wid + rr, g = g0 + r;
            const float* xr = p.xcur + (size_t)g * D;
            float4 v[8]; float ss = 0.f;
#pragma unroll
            for (int i = 0; i < 8; ++i) { v[i] = *(const float4*)(xr + (i * 64 + lane) * 4); ss += v[i].x * v[i].x + v[i].y * v[i].y + v[i].z * v[i].z + v[i].w * v[i].w; }
            ss = wave_sum(ss);
            const float rs = rsqrtf(ss * (1.0f / D) + 1e-6f);
            const float* mrow = p.mod + (size_t)(l * 5 + modrow(g)) * 6 * D; const float* sh = mrow + 3 * D; const float* sc = mrow + 4 * D;
#pragma unroll
            for (int i = 0; i < 8; ++i) {
                const int d = (i * 64 + lane) * 4;
                const float4 gg = *(const float4*)(gam + d), s4 = *(const float4*)(sh + d), c4 = *(const float4*)(sc + d);
                float4 o;
                o.x = v[i].x * rs * gg.x * (1.0f + c4.x) + s4.x; o.y = v[i].y * rs * gg.y * (1.0f + c4.y) + s4.y; o.z = v[i].z * rs * gg.z * (1.0f + c4.z) + s4.z; o.w = v[i].w * rs * gg.w * (1.0f + c4.w) + s4.w;
                uint2 pk; pk.x = pg8::cvt_pk_bf16(o.x, o.y); pk.y = pg8::cvt_pk_bf16(o.z, o.w);
                *(uint2*)(p.h + (size_t)g * D + d) = pk;
                *(float4*)(At + r * RT_LD + d) = o;
            }
        }
        __syncthreads();
        {
            const int nt = wid & 3, kh = wid >> 2, fr = lane & 15, q = lane >> 4;
            pg8::f32x4 acc = {0.f, 0.f, 0.f, 0.f};
            const float* wp = p.Wr + (((size_t)(l * 128 + kh * 64) * 4 + nt) * 64 + lane) * 4;
            const float* ap = At + fr * RT_LD + kh * 1024 + 4 * q;
#pragma unroll 16
            for (int j = 0; j < 64; ++j) {
                const float4 a4 = *(const float4*)(ap + 16 * j), b4 = *(const float4*)(wp + (size_t)j * 1024);
                acc = __builtin_amdgcn_mfma_f32_16x16x4f32(a4.x, b4.x, acc, 0, 0, 0); acc = __builtin_amdgcn_mfma_f32_16x16x4f32(a4.y, b4.y, acc, 0, 0, 0);
                acc = __builtin_amdgcn_mfma_f32_16x16x4f32(a4.z, b4.z, acc, 0, 0, 0); acc = __builtin_amdgcn_mfma_f32_16x16x4f32(a4.w, b4.w, acc, 0, 0, 0);
            }
#pragma unroll
            for (int jj = 0; jj < 4; ++jj) Pp[(kh * 16 + 4 * q + jj) * 64 + 16 * nt + fr] = acc[jj];
        }
        __syncthreads();
#pragma unroll 1
        for (int rr = 0; rr < 2; ++rr) {
            const int r = 2 * wid + rr, g = g0 + r;
            const float score = 1.0f / (1.0f + expf(-(Pp[r * 64 + lane] + Pp[(16 + r) * 64 + lane])));
            float val = score + p.router_bias[l * NEXP + lane];
            int myidx[TOPK]; float mysc[TOPK]; float tot = 0.f;
#pragma unroll
            for (int k = 0; k < TOPK; ++k) {
                float bv = val; int bi = lane;
#pragma unroll
                for (int o = 32; o >= 1; o >>= 1) { const float ov = bperm_f(lane ^ o, bv); const int oi = bperm_i(lane ^ o, bi); if (ov > bv || (ov == bv && oi < bi)) { bv = ov; bi = oi; } }
                const float sc_k = bperm_f(bi, score);
                myidx[k] = bi; mysc[k] = sc_k; tot += sc_k;
                if (lane == bi) val = -INFINITY;
            }
            if (lane < TOPK) {
                int e = myidx[0]; float w = mysc[0];
#pragma unroll
                for (int k = 1; k < TOPK; ++k) if (lane == k) { e = myidx[k]; w = mysc[k]; }
                w = w / tot * 2.5f;
                p.sel[g * TOPK + lane] = e; p.selw[g * TOPK + lane] = w;
                const int lp = atomicAdd(&lcnt[e], 1);
                int* en = ent + ((nloc * 16 + r) * TOPK + lane) * 4; en[0] = e; en[1] = __float_as_int(w); en[2] = g * 8 + lane; en[3] = lp;
            }
        }
    }
    __syncthreads();
    if (tix < 64) lbase[tix] = lcnt[tix] ? atomicAdd(p.cnt + l * NEXP + tix, lcnt[tix]) : 0;
    __syncthreads();
    for (int i = tix; i < nloc * 16 * TOPK; i += NT) {
        const int e = ent[i * 4], gk = ent[i * 4 + 2], pos = lbase[e] + ent[i * 4 + 3];
        p.ltok[(size_t)e * LCAP + pos] = gk >> 3; p.lw[(size_t)e * LCAP + pos] = __int_as_float(ent[i * 4 + 1]); p.tpos[(gk >> 3) * TOPK + (gk & 7)] = pos;
    }
}

constexpr int MAXU = 17;
__device__ __forceinline__ void moe_tables(const Params& p, LAS int* tab, int lc) {
    const int tix = otid();
    __syncthreads();
    if (tix == 0) { int ts = 0, of = 0;
        for (int e = 0; e < NEXP; ++e) { const int c = __hip_atomic_load(p.cnt + lc * NEXP + e, __ATOMIC_RELAXED, __HIP_MEMORY_SCOPE_AGENT); tab[e] = ts; tab[66 + e] = of; tab[132 + e] = c; ts += (c + 255) / 256; of += (c + 255) / 256 * 256; }
        tab[NEXP] = ts; tab[66 + NEXP] = of; ts += M / 256; of += M;
        tab[65] = ts; tab[66 + 65] = of; }
    __syncthreads();
}
struct MoeSched {
    const LAS int* tab; const LAS unsigned* rowtab; int NPN, G, c, total; unsigned rowbytes; const char* Bt; const char* Bte  ; size_t bstride;
    __device__ __forceinline__ bool next(int i, pg8::Unit& u) const {
        const int Lq = i * G + c; if (Lq >= total) return false;
        const int rt = Lq / NPN; u.pn = Lq - rt * NPN;
        int lo = 0, hi = 64;
        while (lo < hi) { const int mid = (lo + hi + 1) >> 1; if (tab[mid] <= rt) lo = mid; else hi = mid - 1; }
        u.e = lo; u.pm = rt - tab[lo]; u.ord = i; return true;
    }
    __device__ __forceinline__ unsigned arow(const pg8::Unit& u, int r) const { return rowtab[u.ord * 256 + r] * rowbytes; }
    __device__ __forceinline__ const char* bptr(const pg8::Unit& u) const { return (u.e < CV_EEARLY ? Bte : Bt) + (size_t)u.e * bstride + (size_t)u.pn * 256 * rowbytes; }
};
struct EpiGU {
    bf16_t* U; const LAS int* tab;
    __device__ __forceinline__ void operator()(const pg8::f32x4 (&acc)[2][2][4][2], const pg8::Unit& u, int wr, int wc, int fr, int fq) const {
        const int cn = (u.e < NEXP ? tab[132 + u.e] : M), off = tab[66 + u.e], col0 = u.pn * 128 + wc * 32 + 8 * fq;
#pragma unroll
        for (int ai = 0; ai < 2; ++ai)
#pragma unroll
            for (int m = 0; m < 4; ++m) { const int i = u.pm * 256 + ai * 128 + wr * 64 + m * 16 + fr;
                if (i < cn) { float o[8];
#pragma unroll
                    for (int n = 0; n < 2; ++n)
#pragma unroll
                        for (int j = 0; j < 4; ++j) { const float gv = acc[ai][0][m][n][j], uv = acc[ai][1][m][n][j]; o[n * 4 + j] = gv * __builtin_amdgcn_rcpf(1.0f + __expf(-gv)) * uv; }
                    pg8::u32x4 w; w.x = pg8::cvt_pk_bf16(o[0], o[1]); w.y = pg8::cvt_pk_bf16(o[2], o[3]); w.z = pg8::cvt_pk_bf16(o[4], o[5]); w.w = pg8::cvt_pk_bf16(o[6], o[7]);
                    *(pg8::u32x4*)(U + (size_t)(off + i) * DE + col0) = w; } }
    }
};
struct EpiDown {
    bf16_t* Y; const LAS int* tab;
    __device__ __forceinline__ void operator()(const pg8::f32x4 (&acc)[2][2][4][2], const pg8::Unit& u, int wr, int wc, int fr, int fq) const {
        const int cn = (u.e < NEXP ? tab[132 + u.e] : M), off = tab[66 + u.e], col0 = u.pn * 256 + wc * 32 + 8 * fq;
#pragma unroll
        for (int ai = 0; ai < 2; ++ai)
#pragma unroll
            for (int m = 0; m < 4; ++m) { const int i = u.pm * 256 + ai * 128 + wr * 64 + m * 16 + fr;
                if (i < cn) { bf16_t* rowp = Y + (size_t)(off + i) * D + col0;
#pragma unroll
                    for (int bj = 0; bj < 2; ++bj) { const pg8::f32x4 v0 = acc[ai][bj][m][0], v1 = acc[ai][bj][m][1];
                        pg8::u32x4 w; w.x = pg8::cvt_pk_bf16(v0[0], v0[1]); w.y = pg8::cvt_pk_bf16(v0[2], v0[3]); w.z = pg8::cvt_pk_bf16(v1[0], v1[1]); w.w = pg8::cvt_pk_bf16(v1[2], v1[3]);
                        *(pg8::u32x4*)(rowp + bj * 128) = w; } } }
    }
};
template <bool DOWN>
__device__ __forceinline__ void phase_gemm_moe(const Params& p, LAS unsigned char* stage, LAS int* tab, LAS unsigned* rowtab, int l, int bid, int nb) {
    const int tix = otid();
    moe_tables(p, tab, l);
    MoeSched S; S.tab = tab; S.rowtab = rowtab; S.NPN = DOWN ? 8 : 4; S.G = nb; S.c = (nb % 8 == 0) ? (bid % 8) * (nb / 8) + bid / 8 : bid; S.total = tab[65] * S.NPN;
    S.rowbytes = DOWN ? DE * 2 : D * 2; S.Bt = DOWN ? (const char*)p.WdnT : (const char*)p.WguT; S.Bte = l == 0 ? S.Bt : (DOWN ? (const char*)p.WdnE : (const char*)p.WguE); S.bstride = DOWN ? (size_t)D * DE * 2 : (size_t)1024 * D * 2;
    for (int i = 0; i < MAXU; ++i) { pg8::Unit u; if (!S.next(i, u)) break;
        if (tix < 256) { const int idx = u.pm * 256 + tix, cn = (u.e < NEXP ? tab[132 + u.e] : M); unsigned v;
            if (DOWN) v = (unsigned)(tab[66 + u.e] + idx); else v = idx < cn ? (u.e < NEXP ? (unsigned)p.ltok[(size_t)u.e * LCAP + idx] : (unsigned)idx) : (unsigned)M;
            rowtab[i * 256 + tix] = v; } }
    __syncthreads();
    if (DOWN) { EpiDown E; E.Y = p.Y; E.tab = tab; pg8::gemm_phase<true>(stage, (const char*)p.U, DE, S, E); }
    else { EpiGU E; E.U = p.U; E.tab = tab; pg8::gemm_phase<true>(stage, (const char*)p.h, D, S, E); }
    if (l == 0 && tail_idle(S.total, S.G, S.c)) {
        const int nidle = (S.total + S.G - 1) / S.G * S.G - S.total, per = (DOWN ? CVQ_DN_TOTAL : CVQ_GU_TOTAL) / nidle, cap = DOWN ? CVQ_DN_MAX : CVQ_GU_MAX;
        convert_tail(p, (float*)(unsigned char*)stage, per < cap ? per : cap); }
}
__device__ __forceinline__ void phase_final(const Params& p, LAS int* tab, int bid, int nb) {
    moe_tables(p, tab, 1);
    const int tix = otid();
    const int wid = tix >> 6, lane = tix & 63;
    float4 vn[8]; CombPre cn;
    { const int r = bid * 8 + wid; if (r < NB * L) { const int g = (r / L) * TT + LC + r % L; const float* xr = p.xcur + (size_t)g * D;
#pragma unroll
        for (int i = 0; i < 8; ++i) vn[i] = *(const float4*)(xr + (i * 64 + lane) * 4);
        comb_prefetch(p, g, cn); } }
    for (int r = bid * 8 + wid; r < NB * L; r += nb * 8) {
        const int b = r / L, t = r % L;
        float4 v[8]; float ss = 0.f; CombPre cc = cn;
#pragma unroll
        for (int i = 0; i < 8; ++i) v[i] = vn[i];
        { const int rn = r + nb * 8; if (rn < NB * L) { const int gn = (rn / L) * TT + LC + rn % L; const float* xr = p.xcur + (size_t)gn * D;
#pragma unroll
            for (int i = 0; i < 8; ++i) vn[i] = *(const float4*)(xr + (i * 64 + lane) * 4);
            comb_prefetch(p, gn, cn); } }
        moe_combine_row(p, tab, 1, b * TT + LC + t, lane, cc, v);
#pragma unroll
        for (int i = 0; i < 8; ++i) ss += v[i].x * v[i].x + v[i].y * v[i].y + v[i].z * v[i].z + v[i].w * v[i].w;
        ss = wave_sum(ss); const float rs = rsqrtf(ss * (1.0f / D) + 1e-6f);
#pragma unroll
        for (int i = 0; i < 8; ++i) { const int d = (i * 64 + lane) * 4; const float4 gg = *(const float4*)(p.final_g + d);
            float4 o; o.x = v[i].x * rs * gg.x; o.y = v[i].y * rs * gg.y; o.z = v[i].z * rs * gg.z; o.w = v[i].w * rs * gg.w;
            *(float4*)(p.out + (size_t)r * D + d) = o; }
    }
}


constexpr int LDS_BYTES = 160 * 1024;
extern __shared__ __attribute__((aligned(16))) unsigned char dyn_lds_raw[];
__device__ __forceinline__ LAS unsigned char* lds_las(unsigned off) { asm volatile("" : "+s"(off)); return (LAS unsigned char*)(unsigned long)off; }
__device__ __forceinline__ int obid() { int b = blockIdx.x; asm volatile("" : "+s"(b)); return b; }
__device__ __forceinline__ int onb() { int b = gridDim.x; asm volatile("" : "+s"(b)); return b; }
typedef const __attribute__((address_space(4))) Params* KParams;
__device__ __forceinline__ KParams kp_opaque(KParams q) { asm volatile("" : "+s"(q)); return q; }
#define PPH (*(const Params*)kp_opaque(kp))
__global__ __launch_bounds__(512, 2) void mega(Params p_byval) {
    const KParams kp = (KParams)__builtin_amdgcn_kernarg_segment_ptr();
    if (threadIdx.x == 0) *(uint4*)dyn_lds_raw = make_uint4(0u, 0u, 0u, 0u);
    __syncthreads();
    XcdBarrier bar = xcd_barrier_post(PPH.bar, (volatile LAS unsigned*)dyn_lds_raw);
    const unsigned lds0 = (unsigned)(unsigned long long)(LAS unsigned char*)dyn_lds_raw;
#define LDSB ((unsigned char*)lds_las(lds0 + 1024u))
#define lds ((float*)LDSB)
#define stage (lds_las(lds0 + 1024u))
#define tab ((LAS int*)lds_las(lds0 + 1024u + 131072u))
#define rowtab ((LAS unsigned*)lds_las(lds0 + 1024u + 131072u + 1024u))
#define bid (obid())
#define nb (onb())
    phase_copy(PPH, bid, nb);
    phase_router_w(PPH, bid, nb);
    phase_lora_w(PPH, bid, nb);
    phase_adaln(PPH, lds, bid, nb);
    xcd_barrier(bar);
#pragma unroll 1
    for (int l = 0; l < 2; ++l) {
        phase_norm<0>(PPH, lds, tab, l, bid, nb);
        { int first = 0; if (l == 1) { first = __hip_atomic_load(PPH.cvc, __ATOMIC_RELAXED, __HIP_MEMORY_SCOPE_AGENT); first = first < CV_EARLY ? first : CV_EARLY; }
          phase_convert(PPH, lds, l, first, bid, nb); }
        xcd_barrier(bar);
        phase_gemm_in(PPH, stage, l, bid, nb);
        xcd_barrier(bar);
        phase_prep(PPH, lds, l, bid, nb);
        { const int b1 = obid(), n1 = onb(); RwPre pre; rwkv_prefetch(PPH, l, b1, otid(), pre); for (int unit = b1; unit < RW_UNITS; unit += n1) rwkv_unit(PPH, LDSB, l, unit, unit + n1, pre); }
        xcd_barrier(bar);
        { const int tix = otid(), wid = __builtin_amdgcn_readfirstlane(tix >> 6); const int bid_l = obid(), nb_l = onb();
          float* const rp_l = lds + 32768;
          { const Params& pr = PPH; for (int i = tix; i < 12 * 465; i += NT) rp_l[i] = pr.rpb[(size_t)l * 12 * 465 + i] * 1.4426950408889634f; }
          __syncthreads();
          if (bid_l < 96) rwkv_chain(PPH, LDSB, bid_l);
          { const int wt = nb_l > 96 ? 96 + 2 * (nb_l - 96) : nb_l, w0 = nb_l > 96 ? (bid_l < 96 ? bid_l : 96 + 2 * (bid_l - 96)) : bid_l, w1 = nb_l > 96 ? (bid_l < 96 ? bid_l + 1 : 96 + 2 * (bid_l - 95)) : bid_l + 1;
            const int lo = (int)((long)w0 * ATT_LAT2 / wt), hi = (int)((long)w1 * ATT_LAT2 / wt); for (int task = lo + wid; task < hi; task += 8) attn_task2(PPH, rp_l, task); }
          if (l == 0) for (int task = ATT_LAT2 + bid_l * 8 + wid; task < ATT_TASKS2; task += nb_l * 8) attn_task2(PPH, rp_l, task); }
        xcd_barrier(bar);
        { const int b1 = obid(), n1 = onb(); for (int u3 = b1; u3 < RW_UNITS / 2; u3 += n1) if (l == 0 || u3 % (TT / 64) >= 4) rwkv_out(PPH, LDSB, l, u3); }
        xcd_barrier(bar);
        phase_gemm_out(PPH, stage, l, bid, nb);
        xcd_barrier(bar);
        phase_router(PPH, LDSB, l, bid, nb);
        xcd_barrier(bar);
        phase_gemm_moe<false>(PPH, stage, tab, rowtab, l, bid, nb);
        xcd_barrier(bar);
        phase_gemm_moe<true>(PPH, stage, tab, rowtab, l, bid, nb);
        xcd_barrier(bar);
    }
    phase_final(PPH, tab, bid, nb);
}

#undef bid
#undef nb
#undef LDSB
#undef lds
#undef stage
#undef tab
#undef rowtab
extern "C" void kernel_launch(void* const* d_in, const int* in_sizes, int n_in, void* d_out, int out_size, void* d_ws, size_t ws_size, hipStream_t stream) {
    static int grid = 0;
    if (grid == 0) {
        int dev = 0, cus = 0, per_cu = 0;
        if (hipGetDevice(&dev) != hipSuccess || hipDeviceGetAttribute(&cus, hipDeviceAttributeMultiprocessorCount, dev) != hipSuccess) { grid = -1; return; }
        if (hipFuncSetAttribute((const void*)mega, hipFuncAttributeMaxDynamicSharedMemorySize, LDS_BYTES) != hipSuccess) { grid = -1; return; }
        if (hipOccupancyMaxActiveBlocksPerMultiprocessor(&per_cu, (const void*)mega, NT, LDS_BYTES) != hipSuccess || per_cu < 1) { grid = -1; return; }
        (void)hipGetLastError();
        grid = cus;
        if (grid < 96) { grid = -1; return; }
    }
    if (grid < 0) return;
    Params p{};
    const float** pf = (const float**)&p;
    for (int i = 0; i < 32; ++i) pf[i] = (const float*)d_in[i];
    p.out = (float*)d_out;
    char* w = (char*)d_ws; size_t o = 0;
    auto take = [&](size_t bytes) { char* r = w + o; o += (bytes + 255) & ~(size_t)255; return r; };
    p.bar = (unsigned*)take(XCD_BAR_WORDS * 4 + 2 * NEXP * 4 + 64);
    p.cnt = (int*)(p.bar + XCD_BAR_WORDS); p.cvc = p.cnt + 2 * NEXP;
    p.mod = (float*)take((size_t)2 * 5 * 6 * D * 4);
    p.xcur = (float*)take((size_t)M * D * 4);
    p.h = (bf16_t*)take((size_t)(M + 1) * D * 2);
    p.mix = (bf16_t*)take((size_t)M * D * 2);
    p.z = (bf16_t*)take((size_t)M * ZLD * 2);
    p.Y = p.z;
    p.streams = (float*)take((size_t)RW_UNITS * 4096 * 16);
    p.bonus = (float*)take((size_t)2 * M * 12 * 4);
    { char* sb = (char*)p.streams; const size_t U = (size_t)RW_UNITS * 4096;
      p.rw_P = (bf16_t*)sb; sb += U * 2; p.rw_Ry = (bf16_t*)sb; sb += U * 2; p.rw_H0 = (bf16_t*)sb; sb += U * 2; p.rw_QT = (float*)sb; sb += U * 4; p.rw_Y0 = (float*)sb; sb += U * 4;
      p.rw_vb = (bf16_t*)sb; sb += U; p.rw_gb = (bf16_t*)sb; sb += U; }
    p.tpos = (int*)take((size_t)M * TOPK * 4);
    p.sel = (int*)take((size_t)M * TOPK * 4);
    p.selw = (float*)take((size_t)M * TOPK * 4);
    p.ltok = (int*)take((size_t)NEXP * LCAP * 4);
    p.lw = (float*)take((size_t)NEXP * LCAP * 4);
    p.U = (bf16_t*)take((size_t)(UROWS + M) * DE * 2);
    p.WinT = (bf16_t*)take((size_t)ZLD * D * 2);
    p.WoutT = (bf16_t*)take((size_t)2 * D * D * 2);
    p.WguT = (bf16_t*)take((size_t)65 * 1024 * D * 2); p.WguE = (bf16_t*)take((size_t)CV_EEARLY * 1024 * D * 2);
    p.WdnT = (bf16_t*)take((size_t)65 * D * DE * 2); p.WdnE = (bf16_t*)take((size_t)CV_EEARLY * D * DE * 2);
    p.Qa = (bf16_t*)take((size_t)NB * 12 * TT * 64 * 2);
    p.Qr = (bf16_t*)take((size_t)NB * 12 * L * 64 * 2);
    p.Ka = (bf16_t*)take((size_t)NB * 12 * TT * 64 * 2);
    p.Vt = (bf16_t*)take((size_t)NB * 12 * 64 * TT * 2);
    p.Wr = (float*)take((size_t)2 * D * NEXP * 4);
    p.Lwa = (bf16_t*)take((size_t)2 * 2 * 12 * 2 * 64 * 72 * 2);
    p.Lg = (bf16_t*)take((size_t)2 * 12 * 64 * 104 * 2);
    if (o > ws_size) return;
    if (hipMemsetAsync(p.bar, 0, XCD_BAR_WORDS * sizeof(unsigned) + 2 * NEXP * 4 + 64, stream) != hipSuccess) return;
    hipLaunchKernelGGL(mega, dim3(grid), dim3(NT), LDS_BYTES, stream, p);
}
```

```cpp
#include <hip/hip_runtime.h>
#include <stdint.h>

typedef unsigned short bf16_t;

constexpr int D = 2048, NB = 4, L = 4096, LC = 256, TT = L + LC, M = NB * TT;
constexpr int IN_COLS = 6432, ZLD = 6656;
constexpr int ZA = 0, ZB = 1536, ZC = 3840, RWC = 2592;
constexpr int NEXP = 64, TOPK = 6, DE = 512;
constexpr int NSTR = 10, SSTR = NSTR * 768;
constexpr int LCAP = M;
constexpr int UROWS = M * TOPK + NEXP * 256;
constexpr int NT = 512;

struct Params {
    const float *x, *c, *ctx, *c_ctx, *norm1_g, *norm2_g, *ada_w, *ada_b, *w_in, *conv_w, *rpb, *rw_shift, *rw_w0, *rw_w_up, *rw_a0, *rw_a_up, *rw_g_up,
        *rw_k_k, *rw_k_a, *rw_r_k, *rw_gn_g, *rw_gn_b, *w_out, *router_w, *router_bias, *exp_gate, *exp_up, *exp_down, *sh_gate, *sh_up, *sh_down, *final_g;
    float* out;
    unsigned* bar; float* mod; float* xcur; bf16_t* h; bf16_t* z; bf16_t* mix; float* streams; float* bonus; float* ydir;
    int* sel; float* selw; int* cnt; int* ltok; float* lw; bf16_t* U; bf16_t *WinT, *WoutT, *WguT, *WdnT; bf16_t *Qa, *Qr, *Ka, *Vt; bf16_t* Y; int* tpos; bf16_t *rw_P, *rw_Ry, *rw_H0, *rw_vb, *rw_gb; float *rw_QT, *rw_Y0; float* Wr; bf16_t *Lwa, *Lg; int* cvc; bf16_t *WguE, *WdnE;
};

__device__ __forceinline__ float bf2f(bf16_t b) { return __uint_as_float(((unsigned)b) << 16); }
__device__ __forceinline__ bf16_t f2bf(float f) { unsigned u = __float_as_uint(f); u += 0x7FFFu + ((u >> 16) & 1u); return (bf16_t)(u >> 16); }
__device__ __forceinline__ float sigmoidf_(float x) { return 1.0f / (1.0f + __expf(-x)); }
template <int CTRL, int RMASK> __device__ __forceinline__ float dpp_f(float old, float v) { return __int_as_float(__builtin_amdgcn_update_dpp(__float_as_int(old), __float_as_int(v), CTRL, RMASK, 0xF, false)); }
__device__ __forceinline__ float wave_sum(float v) {
    v += dpp_f<0xB1, 0xF>(0.f, v);
    v += dpp_f<0x4E, 0xF>(0.f, v);
    v += dpp_f<0x141, 0xF>(0.f, v);
    v += dpp_f<0x140, 0xF>(0.f, v);
    v += dpp_f<0x142, 0xA>(0.f, v);
    v += dpp_f<0x143, 0xC>(0.f, v);
    return __int_as_float(__builtin_amdgcn_readlane(__float_as_int(v), 63));
}
__device__ __forceinline__ float wave_max(float v) {
    v = fmaxf(v, dpp_f<0xB1, 0xF>(v, v));
    v = fmaxf(v, dpp_f<0x4E, 0xF>(v, v));
    v = fmaxf(v, dpp_f<0x141, 0xF>(v, v));
    v = fmaxf(v, dpp_f<0x140, 0xF>(v, v));
    v = fmaxf(v, dpp_f<0x142, 0xA>(v, v));
    v = fmaxf(v, dpp_f<0x143, 0xC>(v, v));
    return __int_as_float(__builtin_amdgcn_readlane(__float_as_int(v), 63));
}
__device__ __forceinline__ float bperm_f(int srclane, float v) { return __int_as_float(__builtin_amdgcn_ds_bpermute(srclane << 2, __float_as_int(v))); }
__device__ __forceinline__ int bperm_i(int srclane, int v) { return __builtin_amdgcn_ds_bpermute(srclane << 2, v); }
__device__ __forceinline__ int otid() { int t = threadIdx.x; asm volatile("" : "+v"(t)); return t; }
__device__ __forceinline__ void lds_barrier() { asm volatile("s_waitcnt lgkmcnt(0)" ::: "memory"); __builtin_amdgcn_s_barrier(); asm volatile("" ::: "memory"); }
__device__ __forceinline__ float bfl(unsigned u) { return __uint_as_float(u << 16); }
__device__ __forceinline__ float bfh(unsigned u) { return __uint_as_float(u & 0xffff0000u); }
__device__ __forceinline__ const float* in_row(const Params& p, int g) { const int b = g / TT, s = g - b * TT; return s < LC ? p.ctx + (size_t)(b * LC + s) * D : p.x + (size_t)(b * L + (s - LC)) * D; }
__device__ __forceinline__ int modrow(int g) { const int b = g / TT, s = g - b * TT; return s < LC ? 4 : b; }

#define XB_TMO      128
#define XB_XCNT(j)  (256  + 64 * (j))
#define XB_XSUB(j)  (1280 + 64 * (j))
#define XB_XGEN(j)  (2304 + 64 * (j))
#define XB_TOP      3328
#define XB_TOPGEN   3392
#define XCD_BAR_WORDS 3456
#define XB_SPIN_CAP (1u << 22)
#define LAS __attribute__((address_space(3)))

__device__ __forceinline__ unsigned xb_ld(unsigned* p)              { return __hip_atomic_load(p, __ATOMIC_RELAXED, __HIP_MEMORY_SCOPE_AGENT); }
__device__ __forceinline__ unsigned xb_add(unsigned* p, unsigned v) { return __hip_atomic_fetch_add(p, v, __ATOMIC_RELAXED, __HIP_MEMORY_SCOPE_AGENT); }
__device__ __forceinline__ unsigned xb_xcc_id() { return (unsigned)__builtin_amdgcn_s_getreg((3 << 11) | 20) & 0xFu; }
#define XB_SPIN(cond, bar) do { unsigned _sp = 0; while (cond) { __builtin_amdgcn_s_sleep(1); \
    if ((++_sp & 255u) == 0u) { if (xb_ld(&(bar)[XB_TMO])) break; if (_sp > XB_SPIN_CAP) { atomicAdd(&(bar)[XB_TMO], 1u); break; } } } } while (0)

struct XcdBarrier {
    unsigned* bar; unsigned x;
    volatile LAS unsigned* st;
};

__device__ __forceinline__ XcdBarrier xcd_barrier_post(unsigned* bar, volatile LAS unsigned* st) {
    XcdBarrier b; b.bar = bar; b.x = xb_xcc_id(); b.st = st;
    if (threadIdx.x == 0) (void)xb_add(&bar[XB_XCNT(b.x)], 1u);
    return b;
}
__device__ __forceinline__ void xcd_barrier_complete(unsigned* bar, unsigned x, unsigned& nloc, unsigned& nx) {
    const unsigned G = gridDim.x * gridDim.y * gridDim.z;
    unsigned sum, cnt, mine, sp = 0u;
    for (;;) {
        sum = 0u; cnt = 0u; mine = 0u;
#pragma unroll
        for (unsigned j = 0; j < 16; ++j) { const unsigned c = xb_ld(&bar[XB_XCNT(j)]); sum += c; cnt += (c > 0u) ? 1u : 0u; mine = (j == x) ? c : mine; }
        if (sum == G) break;
        __builtin_amdgcn_s_sleep(1);
        if ((++sp & 255u) == 0u) { if (xb_ld(&bar[XB_TMO])) break; if (sp > XB_SPIN_CAP) { atomicAdd(&bar[XB_TMO], 1u); break; } }
    }
    nloc = mine > 0u ? mine : 1u; nx = cnt > 0u ? cnt : 1u;
}

__device__ __forceinline__ void xcd_barrier(const XcdBarrier& b) {
    asm volatile("s_waitcnt vmcnt(0)" ::: "memory");
    __syncthreads();
    if (threadIdx.x == 0) {
        unsigned* bar = b.bar; const unsigned bx = xb_xcc_id();
        __builtin_amdgcn_s_waitcnt(0);
        unsigned nloc = b.st[0], nx = b.st[1];
        if (nloc == 0u) { xcd_barrier_complete(bar, bx, nloc, nx); b.st[0] = nloc; b.st[1] = nx; }
        const unsigned old = xb_add(&bar[XB_XSUB(bx)], 1u);
        const unsigned gen = old / nloc;
        if (old + 1u == (gen + 1u) * nloc) {
            __builtin_amdgcn_fence(__ATOMIC_RELEASE, "agent");
            asm volatile("s_waitcnt vmcnt(0)" ::: "memory");
            const unsigned og = xb_add(&bar[XB_TOP], 1u);
            const unsigned tg = og / nx;
            if (og + 1u == (tg + 1u) * nx) xb_add(&bar[XB_TOPGEN], 1u);
            else XB_SPIN(xb_ld(&bar[XB_TOPGEN]) == tg, bar);
            __builtin_amdgcn_fence(__ATOMIC_ACQUIRE, "agent");
            xb_add(&bar[XB_XGEN(bx)], 1u);
            asm volatile("s_waitcnt vmcnt(0)" ::: "memory");
        } else {
            XB_SPIN(xb_ld(&bar[XB_XGEN(bx)]) == gen, bar);
            __builtin_amdgcn_fence(__ATOMIC_ACQUIRE, "agent");
            asm volatile("s_waitcnt vmcnt(0)" ::: "memory");
        }
    }
    __syncthreads();
}


__device__ __forceinline__ void phase_copy(const Params& p, int bid, int nb) {
    const int tix = otid();
    if (bid == 0) for (int i = tix; i < D; i += NT) p.h[(size_t)M * D + i] = 0;
}

__device__ __forceinline__ void phase_router_w(const Params& p, int bid, int nb) {
    const int tix = otid();
    for (int i = bid * NT + tix; i < 2 * D * NEXP; i += nb * NT) {
        const int c = i & 3, n = (i >> 2) & 15, q = (i >> 6) & 3, nt = (i >> 8) & 3, j = (i >> 10) & 127, l = i >> 17;
        p.Wr[i] = p.router_w[((size_t)l * D + 16 * j + 4 * q + c) * NEXP + 16 * nt + n];
    }
}
__device__ __forceinline__ void phase_lora_w(const Params& p, int bid, int nb) {
    const int tix = otid();
    for (int i = bid * NT + tix; i < 2 * 2 * 12 * 2 * 64 * 72; i += nb * NT) {
        const int r = i % 72, c = (i / 72) & 63, which = (i / (72 * 64)) & 1, hh = (i / (72 * 64 * 2)) % 12, n = (i / (72 * 64 * 2 * 12)) & 1, l = i / (72 * 64 * 2 * 12 * 2);
        const float* src = (which == 0 ? p.rw_w_up : p.rw_a_up) + ((size_t)(l * 2 + n) * 48) * 768 + hh * 64 + c;
        p.Lwa[i] = r < 48 ? f2bf(src[(size_t)r * 768]) : (bf16_t)0;
    }
    for (int i = bid * NT + tix; i < 2 * 12 * 64 * 104; i += nb * NT) {
        const int r = i % 104, c = (i / 104) & 63, hh = (i / (104 * 64)) % 12, l = i / (104 * 64 * 12);
        p.Lg[i] = r < 96 ? f2bf(p.rw_g_up[((size_t)l * 96 + r) * 768 + hh * 64 + c]) : (bf16_t)0;
    }
}
__device__ __forceinline__ void phase_adaln(const Params& p, float* lds, int bid, int nb) {
    const int tix = otid();
    float* cond = lds;
    float* red = lds + 5 * D;
    for (int i = tix; i < 5 * D; i += NT) { const int r = i / D, d = i % D; const float v = r < 4 ? p.c[r * D + d] : p.c_ctx[d]; cond[i] = v * sigmoidf_(v); }
    __syncthreads();
    const int tid = tix, cg = tid & 15, ks = tid >> 4, wid = tid >> 6, lane = tid & 63;
    const int nitems = 2 * (6 * D / 64);
    for (int it = bid; it < nitems; it += nb) {
        const int l = it / (6 * D / 64), c0 = (it % (6 * D / 64)) * 64 + cg * 4;
        const float* W = p.ada_w + (size_t)l * D * 6 * D + c0;
        float4 acc[5];
#pragma unroll
        for (int r = 0; r < 5; ++r) acc[r] = make_float4(0.f, 0.f, 0.f, 0.f);
#pragma unroll 8
        for (int k = ks; k < D; k += 32) {
            const float4 w = *(const float4*)(W + (size_t)k * 6 * D);
#pragma unroll
            for (int r = 0; r < 5; ++r) { const float cv = cond[r * D + k]; acc[r].x += cv * w.x; acc[r].y += cv * w.y; acc[r].z += cv * w.z; acc[r].w += cv * w.w; }
        }
#pragma unroll
        for (int r = 0; r < 5; ++r) {
            acc[r].x += bperm_f(lane ^ 16, acc[r].x); acc[r].x += bperm_f(lane ^ 32, acc[r].x);
            acc[r].y += bperm_f(lane ^ 16, acc[r].y); acc[r].y += bperm_f(lane ^ 32, acc[r].y);
            acc[r].z += bperm_f(lane ^ 16, acc[r].z); acc[r].z += bperm_f(lane ^ 32, acc[r].z);
            acc[r].w += bperm_f(lane ^ 16, acc[r].w); acc[r].w += bperm_f(lane ^ 32, acc[r].w);
        }
        __syncthreads();
        if (lane < 16) {
#pragma unroll
            for (int r = 0; r < 5; ++r) { float* q = red + ((wid * 16 + lane) * 20 + r * 4); q[0] = acc[r].x; q[1] = acc[r].y; q[2] = acc[r].z; q[3] = acc[r].w; }
        }
        __syncthreads();
        if (tid < 16 * 20) {
            const int cgi = tid / 20, rj = tid % 20, r = rj / 4, j = rj % 4;
            float s = 0.f;
#pragma unroll
            for (int w = 0; w < 8; ++w) s += red[(w * 16 + cgi) * 20 + rj];
            const int col = (it % (6 * D / 64)) * 64 + cgi * 4 + j;
            p.mod[(size_t)(l * 5 + r) * 6 * D + col] = s + p.ada_b[(size_t)l * 6 * D + col];
        }
    }
}

__device__ __forceinline__ void moe_tables(const Params& p, LAS int* tab, int lc);

struct CombPre { int e[TOPK], tp[TOPK]; float w[TOPK]; };
__device__ __forceinline__ void comb_prefetch(const Params& p, int g, CombPre& c) {
#pragma unroll
    for (int k = 0; k < TOPK; ++k) { c.e[k] = p.sel[g * TOPK + k]; c.tp[k] = p.tpos[g * TOPK + k]; c.w[k] = p.selw[g * TOPK + k]; }
}
__device__ __forceinline__ void moe_combine_row(const Params& p, const LAS int* tab, int lm  , int g, int lane, const CombPre& c, float4 (&v)[8]) {
    int slot[TOPK + 1]; float w[TOPK + 1];
#pragma unroll
    for (int k = 0; k < TOPK; ++k) { slot[k] = tab[66 + c.e[k]] + c.tp[k]; w[k] = c.w[k]; }
    slot[TOPK] = tab[66 + NEXP] + g; w[TOPK] = 1.0f;
    const float* gt = p.mod + (size_t)(lm * 5 + modrow(g)) * 6 * D + 5 * D;
#pragma unroll
    for (int i = 0; i < 8; ++i) {
        const int d = (i * 64 + lane) * 4; float a0 = 0.f, a1 = 0.f, a2 = 0.f, a3 = 0.f;
#pragma unroll
        for (int k = 0; k <= TOPK; ++k) { const uint2 y = *(const uint2*)(p.Y + (size_t)slot[k] * D + d);
            a0 += w[k] * __uint_as_float(y.x << 16); a1 += w[k] * __uint_as_float(y.x & 0xffff0000u); a2 += w[k] * __uint_as_float(y.y << 16); a3 += w[k] * __uint_as_float(y.y & 0xffff0000u); }
        const float4 g4 = *(const float4*)(gt + d);
        v[i].x += g4.x * a0; v[i].y += g4.y * a1; v[i].z += g4.z * a2; v[i].w += g4.w * a3;
    }
}

template <int WHICH>
__device__ __forceinline__ void phase_norm(const Params& p, float* lds, LAS int* tab, int l, int bid, int nb) {
    const bool comb = (WHICH == 0 && l > 0);
    if (comb) moe_tables(p, tab, l - 1);
    const int tix = otid();
    const int wid = tix >> 6, lane = tix & 63;
    const float* gam = (WHICH == 0 ? p.norm1_g : p.norm2_g) + (size_t)l * D;
    float* frow = lds + wid * D;
    float4 vn[8]; CombPre cn;
    { const int g = bid * 8 + wid; if (g < M) { const float* xr = (WHICH == 0 && l == 0) ? in_row(p, g) : p.xcur + (size_t)g * D;
#pragma unroll
        for (int i = 0; i < 8; ++i) vn[i] = *(const float4*)(xr + (i * 64 + lane) * 4);
        if (comb) comb_prefetch(p, g, cn); } }
    for (int g = bid * 8 + wid; g < M; g += nb * 8) {
        float4 v[8]; float ss = 0.f; CombPre cc;
#pragma unroll
        for (int i = 0; i < 8; ++i) v[i] = vn[i];
        if (comb) cc = cn;
        { const int gn = g + nb * 8; if (gn < M) { const float* xr = (WHICH == 0 && l == 0) ? in_row(p, gn) : p.xcur + (size_t)gn * D;
#pragma unroll
            for (int i = 0; i < 8; ++i) vn[i] = *(const float4*)(xr + (i * 64 + lane) * 4);
            if (comb) comb_prefetch(p, gn, cn); } }
        if (comb) { moe_combine_row(p, tab, l - 1, g, lane, cc, v);
#pragma unroll
            for (int i = 0; i < 8; ++i) *(float4*)(p.xcur + (size_t)g * D + (i * 64 + lane) * 4) = v[i]; }
#pragma unroll
        for (int i = 0; i < 8; ++i) ss += v[i].x * v[i].x + v[i].y * v[i].y + v[i].z * v[i].z + v[i].w * v[i].w;
        ss = wave_sum(ss);
        const float rs = rsqrtf(ss * (1.0f / D) + 1e-6f);
        const float* mrow = p.mod + (size_t)(l * 5 + modrow(g)) * 6 * D;
        const float* sh = mrow + (WHICH == 0 ? 0 : 3) * D; const float* sc = mrow + (WHICH == 0 ? 1 : 4) * D;
#pragma unroll
        for (int i = 0; i < 8; ++i) {
            const int d = (i * 64 + lane) * 4;
            const float4 gg = *(const float4*)(gam + d), s4 = *(const float4*)(sh + d), c4 = *(const float4*)(sc + d);
            float4 o;
            o.x = v[i].x * rs * gg.x * (1.0f + c4.x) + s4.x; o.y = v[i].y * rs * gg.y * (1.0f + c4.y) + s4.y;
            o.z = v[i].z * rs * gg.z * (1.0f + c4.z) + s4.z; o.w = v[i].w * rs * gg.w * (1.0f + c4.w) + s4.w;
            uint2 pk; pk.x = (unsigned)f2bf(o.x) | ((unsigned)f2bf(o.y) << 16); pk.y = (unsigned)f2bf(o.z) | ((unsigned)f2bf(o.w) << 16);
            *(uint2*)(p.h + (size_t)g * D + d) = pk;
            if (WHICH == 1) *(float4*)(frow + d) = o;
        }
        if (WHICH == 1) {
            const float* rw = p.router_w + (size_t)l * D * NEXP + lane;
            float a0 = 0.f, a1 = 0.f, a2 = 0.f, a3 = 0.f;
            for (int k = 0; k < D; k += 4) {
                const float4 f = *(const float4*)(frow + k);
                a0 += f.x * rw[(size_t)(k + 0) * NEXP]; a1 += f.y * rw[(size_t)(k + 1) * NEXP]; a2 += f.z * rw[(size_t)(k + 2) * NEXP]; a3 += f.w * rw[(size_t)(k + 3) * NEXP];
            }
            const float score = 1.0f / (1.0f + expf(-((a0 + a1) + (a2 + a3))));
            float val = score + p.router_bias[l * NEXP + lane];
            int myidx[TOPK]; float mysc[TOPK]; float tot = 0.f;
#pragma unroll
            for (int k = 0; k < TOPK; ++k) {
                float bv = val; int bi = lane;
#pragma unroll
                for (int o = 32; o >= 1; o >>= 1) { const float ov = bperm_f(lane ^ o, bv); const int oi = bperm_i(lane ^ o, bi); if (ov > bv || (ov == bv && oi < bi)) { bv = ov; bi = oi; } }
                const float sc_k = bperm_f(bi, score);
                myidx[k] = bi; mysc[k] = sc_k; tot += sc_k;
                if (lane == bi) val = -INFINITY;
            }
            if (lane == 0) {
#pragma unroll
                for (int k = 0; k < TOPK; ++k) { p.sel[g * TOPK + k] = myidx[k]; p.selw[g * TOPK + k] = mysc[k] / tot * 2.5f; }
            }
        }
    }
}


namespace pg8 {
typedef short bf16x8 __attribute__((ext_vector_type(8)));
typedef float f32x4 __attribute__((ext_vector_type(4)));
typedef unsigned u32x4 __attribute__((ext_vector_type(4)));
constexpr int BM = 256, BK = 64, HALF = 128, HTB = HALF * BK * 2  , STAGE_BYTES = 8 * HTB, NXCD = 8, WGM = 8;
__device__ __forceinline__ int lds_byte(int r, int c) { const int st = (r >> 4) * 2 + (c >> 5), rr = r & 15, cc = c & 31, ob = rr * 64 + cc * 2; return st * 1024 + (ob ^ (((ob >> 9) & 1) << 5)); }
__device__ __forceinline__ void stage_rc(int b, int& R, int& C) { const int st = b / 1024, sb = b % 1024, swz = sb ^ (((sb >> 9) & 1) << 5); R = (st >> 1) * 16 + swz / 64; C = (st & 1) * 32 + (swz % 64) / 2; }
__device__ __forceinline__ int perm32(int rho) { const int n = rho >> 4, i = rho & 15; return 8 * (i >> 2) + 4 * n + (i & 3); }
typedef float cvt_f32x2 __attribute__((ext_vector_type(2)));
typedef __bf16 cvt_bf16x2 __attribute__((ext_vector_type(2)));
__device__ __forceinline__ unsigned cvt_pk_bf16(float lo, float hi) { const cvt_f32x2 v = {lo, hi}; const cvt_bf16x2 b = __builtin_convertvector(v, cvt_bf16x2); return __builtin_bit_cast(unsigned, b); }
struct Unit { int pm, pn, e, ord; };
template <bool PERM, class Sched, class Epi>
__device__ __forceinline__ void gemm_phase(LAS unsigned char* lds, const char* Abase, const int K, const Sched& S, const Epi& E) {
    const int tid = otid(), wid = __builtin_amdgcn_readfirstlane(tid >> 6), lane = tid & 63, wr = wid >> 2, wc = wid & 3, fr = lane & 15, fq = lane >> 4;
    const int nt = K / BK;
    unsigned voffB[2];
#pragma unroll
    for (int i = 0; i < 2; ++i) { int R, C; stage_rc(tid * 16 + i * 8192, R, C); const int Rb = PERM ? ((R & ~31) + perm32(R & 31)) : R; voffB[i] = (unsigned)(Rb * K + C) * 2u; }
    const size_t kstep = (size_t)(BK * 2);
    const size_t hstep = (size_t)HALF * K * 2;
    const unsigned ldsw = (unsigned)wid * 1024u;
    const int aoff = lds_byte(wr * 64 + fr, fq * 8), boff = lds_byte(wc * 32 + fr, fq * 8);
#define PG8_SA(b, h) (((b) * 2 + (h)) * HTB)
#define PG8_SB(b, h) ((4 + (b) * 2 + (h)) * HTB)
#define PG8_STAGE(bufoff, gbase, voff) do { _Pragma("unroll") for (int _i = 0; _i < 2; ++_i) \
        __builtin_amdgcn_global_load_lds((const unsigned*)((const char*)(gbase) + (voff)[_i]), (LAS unsigned*)(lds + (bufoff) + ldsw + _i * 8192), 16, 0, 0); } while (0)
#define PG8_LDA(dst, b, h) do { _Pragma("unroll") for (int m = 0; m < 4; ++m) _Pragma("unroll") for (int k = 0; k < 2; ++k) dst[m][k] = *(const LAS bf16x8*)(lds + PG8_SA(b, h) + aoff + m * 2048 + k * 1024); } while (0)
#define PG8_LDB(dst, b, h) do { _Pragma("unroll") for (int n = 0; n < 2; ++n) _Pragma("unroll") for (int k = 0; k < 2; ++k) dst[n][k] = *(const LAS bf16x8*)(lds + PG8_SB(b, h) + boff + n * 2048 + k * 1024); } while (0)
#define PG8_MMA(ai, bj, At, Bt) do { __builtin_amdgcn_s_setprio(1); _Pragma("unroll") for (int m = 0; m < 4; ++m) _Pragma("unroll") for (int n = 0; n < 2; ++n) _Pragma("unroll") for (int k = 0; k < 2; ++k) \
        acc[ai][bj][m][n] = __builtin_amdgcn_mfma_f32_16x16x32_bf16(Bt[n][k], At[m][k], acc[ai][bj][m][n], 0, 0, 0); __builtin_amdgcn_s_setprio(0); } while (0)
#define PG8_WAIT_V(n) asm volatile("s_waitcnt vmcnt(" #n ")" ::: "memory")
#define PG8_WAIT_L(n) asm volatile("s_waitcnt lgkmcnt(" #n ")" ::: "memory")
#define PG8_BAR __builtin_amdgcn_s_barrier()
#define PG8_SCHED __builtin_amdgcn_sched_barrier(0)
#define PG8_ROWS(u, v) do { const int _t = otid(); _Pragma("unroll") for (int _i = 0; _i < 2; ++_i) { int _R, _C; stage_rc(_t * 16 + _i * 8192, _R, _C); \
        _Pragma("unroll") for (int _h = 0; _h < 2; ++_h) v[_h][_i] = S.arow(u, _h * HALF + _R) + (unsigned)(_C * 2); } } while (0)
    Unit cur, nxt; int ui = 0;
    if (!S.next(0, cur)) return;
    f32x4 acc[2][2][4][2];
#pragma unroll
    for (int a = 0; a < 2; ++a)
#pragma unroll
        for (int b = 0; b < 2; ++b)
#pragma unroll
            for (int m = 0; m < 4; ++m)
#pragma unroll
                for (int n = 0; n < 2; ++n) acc[a][b][m][n] = (f32x4){0.f, 0.f, 0.f, 0.f};
    bf16x8 At[4][2], B0[2][2], B1[2][2];
    unsigned va[2][2];
    PG8_ROWS(cur, va);
    const char* cB = S.bptr(cur);
    PG8_STAGE(PG8_SB(0, 0), cB, voffB); PG8_STAGE(PG8_SA(0, 0), Abase, va[0]); PG8_STAGE(PG8_SB(0, 1), cB + hstep, voffB); PG8_STAGE(PG8_SA(0, 1), Abase, va[1]);
    if (wr == 1) PG8_BAR;
    PG8_WAIT_V(4); PG8_BAR;
    PG8_STAGE(PG8_SB(1, 0), cB + kstep, voffB); PG8_STAGE(PG8_SA(1, 0), Abase + kstep, va[0]); PG8_STAGE(PG8_SB(1, 1), cB + hstep + kstep, voffB);
    PG8_WAIT_V(6); PG8_BAR;
    for (;;) {
        const bool has_next = S.next(ui + 1, nxt);
        const char* nB = has_next ? S.bptr(nxt) : cB;
        for (int t = 0; t < nt; t += 2) {
            const bool last = (t == nt - 2);
            const char* a1 = Abase + (size_t)(t + 1) * kstep;
            const char* a2 = last ? Abase : Abase + (size_t)(t + 2) * kstep; const char* b2 = last ? nB : cB + (size_t)(t + 2) * kstep;
            const char* a3 = a2 + kstep; const char* b3 = b2 + kstep;
            PG8_LDB(B0, 0, 0); PG8_SCHED; PG8_LDA(At, 0, 0); PG8_STAGE(PG8_SA(1, 1), a1, va[1]);
            PG8_WAIT_L(8); PG8_BAR; PG8_WAIT_L(0); PG8_MMA(0, 0, At, B0); PG8_BAR; PG8_SCHED;
            if (last && has_next) { PG8_ROWS(nxt, va); }
            PG8_LDB(B1, 0, 1); PG8_STAGE(PG8_SB(0, 0), b2, voffB);
            PG8_BAR; PG8_WAIT_L(0); PG8_MMA(0, 1, At, B1); PG8_BAR;
            PG8_LDA(At, 0, 1); PG8_STAGE(PG8_SA(0, 0), a2, va[0]);
            PG8_BAR; PG8_WAIT_L(0); PG8_MMA(1, 0, At, B0); PG8_BAR; PG8_SCHED;
            PG8_STAGE(PG8_SB(0, 1), b2 + hstep, voffB);
            PG8_WAIT_V(6); PG8_BAR; PG8_MMA(1, 1, At, B1); PG8_BAR;
            PG8_LDB(B0, 1, 0); PG8_SCHED; PG8_LDA(At, 1, 0); PG8_STAGE(PG8_SA(0, 1), a2, va[1]);
            PG8_WAIT_L(8); PG8_BAR; PG8_WAIT_L(0); PG8_MMA(0, 0, At, B0); PG8_BAR; PG8_SCHED;
            PG8_LDB(B1, 1, 1); PG8_STAGE(PG8_SB(1, 0), b3, voffB);
            PG8_BAR; PG8_WAIT_L(0); PG8_MMA(0, 1, At, B1); PG8_BAR;
            PG8_LDA(At, 1, 1); PG8_STAGE(PG8_SA(1, 0), a3, va[0]);
            PG8_BAR; PG8_WAIT_L(0); PG8_MMA(1, 0, At, B0); PG8_BAR; PG8_SCHED;
            PG8_STAGE(PG8_SB(1, 1), b3 + hstep, voffB);
            PG8_WAIT_V(6); PG8_BAR; PG8_MMA(1, 1, At, B1); PG8_BAR;
        }
        E(acc, cur, wr, wc, fr, fq);
        if (!has_next) break;
#pragma unroll
        for (int a = 0; a < 2; ++a)
#pragma unroll
            for (int b = 0; b < 2; ++b)
#pragma unroll
                for (int m = 0; m < 4; ++m)
#pragma unroll
                    for (int n = 0; n < 2; ++n) acc[a][b][m][n] = (f32x4){0.f, 0.f, 0.f, 0.f};
        cur = nxt; cB = nB; ++ui;
    }
    PG8_WAIT_V(0);
    if (wr == 0) PG8_BAR;
    PG8_BAR;
#undef PG8_SA
#undef PG8_SB
#undef PG8_STAGE
#undef PG8_LDA
#undef PG8_LDB
#undef PG8_MMA
#undef PG8_WAIT_V
#undef PG8_WAIT_L
#undef PG8_BAR
#undef PG8_SCHED
#undef PG8_ROWS
}
struct DenseSched {
    int nM, nN, nwg, G, c; const char* Bt; unsigned rowbytes; int skipctx;
    __device__ __forceinline__ bool next(int i, Unit& u) const {
        const long L = (long)i * G + c; if (L >= nwg) return false;
        int wgid = (int)L; { const int q = nwg / NXCD, r = nwg % NXCD, xcd = wgid % NXCD, off = wgid / NXCD; wgid = (xcd < r ? xcd * (q + 1) : r * (q + 1) + (xcd - r) * q) + off; }
        const int nig = WGM * nN, gid = wgid / nig, fm = gid * WGM, gsz = (nM - fm) < WGM ? (nM - fm) : WGM;
        u.pm = fm + ((wgid % nig) % gsz); u.pn = (wgid % nig) / gsz; u.e = 0; u.ord = i; if (skipctx) u.pm = (u.pm >> 4) * 17 + 1 + (u.pm & 15); return true;
    }
    __device__ __forceinline__ unsigned arow(const Unit& u, int r) const { return (unsigned)(u.pm * BM + r) * rowbytes; }
    __device__ __forceinline__ const char* bptr(const Unit& u) const { return Bt + (size_t)u.pn * BM * rowbytes; }
};
}

struct CvTile { const float* src; bf16_t* dst; int ldn, nvalid, k0, n0, K, split; };
constexpr int CV_IN = 32 * 26, CV_OUT = 32 * 8, CV_PER_E = 32 * 2 + 32 * 2 + 8 * 8, CV_TOTAL = CV_IN + CV_OUT + 65 * CV_PER_E, CV_EEARLY = 32, CV_EARLY = CV_IN + CV_OUT + CV_EEARLY * CV_PER_E;
__device__ __forceinline__ CvTile cv_desc(const Params& p, int l, int it) {
    const int r1 = it - CV_IN, r2 = r1 - CV_OUT;
    const bool is_in = it < CV_IN, is_out = !is_in && r1 < CV_OUT;
    const int e = r2 >= 0 ? r2 / CV_PER_E : 0, re = r2 >= 0 ? r2 % CV_PER_E : 0;
    const bool is_gu = !is_in && !is_out && re < 128, up = re >= 64, is_dn = !is_in && !is_out && !is_gu;
    const int rg = re & 63, rd = re - 128;
    const float* sgu = e < NEXP ? (up ? p.exp_up : p.exp_gate) + ((size_t)l * NEXP + e) * D * DE : (up ? p.sh_up : p.sh_gate) + (size_t)l * D * DE;
    const float* sdn = e < NEXP ? p.exp_down + ((size_t)l * NEXP + e) * DE * D : p.sh_down + (size_t)l * DE * D;
    CvTile t;
    t.src = is_in ? p.w_in + (size_t)l * D * IN_COLS : (is_out ? p.w_out + (size_t)l * D * D : (is_gu ? sgu : sdn));
    const bool early = l == 1 && e < CV_EEARLY;
    t.dst = is_in ? p.WinT : (is_out ? p.WoutT + (size_t)l * D * D : (is_gu ? (early ? p.WguE : p.WguT) + (size_t)e * 1024 * D : (early ? p.WdnE : p.WdnT) + (size_t)e * D * DE));
    t.ldn = is_in ? IN_COLS : (is_gu ? DE : D); t.nvalid = t.ldn;
    t.k0 = (is_in ? it / 26 : (is_out ? r1 / 8 : (is_gu ? rg / 2 : rd / 8))) * 64;
    t.n0 = (is_in ? it % 26 : (is_out ? r1 % 8 : (is_gu ? rg % 2 : rd % 8))) * 256;
    t.K = is_dn ? DE : D; t.split = is_gu ? (up ? 2 : 1) : 0;
    return t;
}
__device__ __forceinline__ void cv_load(const CvTile& t, int tid, pg8::f32x4 (&v)[8]) {
    const int kp = tid >> 6, c4 = (tid & 63) * 4;
#pragma unroll
    for (int j = 0; j < 8; ++j) v[j] = (t.n0 + c4 < t.nvalid) ? *(const pg8::f32x4*)(t.src + (size_t)(t.k0 + 8 * kp + j) * t.ldn + t.n0 + c4) : (pg8::f32x4){0.f, 0.f, 0.f, 0.f};
}
__device__ __forceinline__ void cv_store(const CvTile& t, int tid, bf16_t* T  , const pg8::f32x4 (&v)[8]) {
    const int kp = tid >> 6, c4 = (tid & 63) * 4;
    uint4 o;
    o.x = pg8::cvt_pk_bf16(v[0][0], v[1][0]); o.y = pg8::cvt_pk_bf16(v[2][0], v[3][0]); o.z = pg8::cvt_pk_bf16(v[4][0], v[5][0]); o.w = pg8::cvt_pk_bf16(v[6][0], v[7][0]); *(uint4*)(T + (c4 + 0) * 72 + 8 * kp) = o;
    o.x = pg8::cvt_pk_bf16(v[0][1], v[1][1]); o.y = pg8::cvt_pk_bf16(v[2][1], v[3][1]); o.z = pg8::cvt_pk_bf16(v[4][1], v[5][1]); o.w = pg8::cvt_pk_bf16(v[6][1], v[7][1]); *(uint4*)(T + (c4 + 1) * 72 + 8 * kp) = o;
    o.x = pg8::cvt_pk_bf16(v[0][2], v[1][2]); o.y = pg8::cvt_pk_bf16(v[2][2], v[3][2]); o.z = pg8::cvt_pk_bf16(v[4][2], v[5][2]); o.w = pg8::cvt_pk_bf16(v[6][2], v[7][2]); *(uint4*)(T + (c4 + 2) * 72 + 8 * kp) = o;
    o.x = pg8::cvt_pk_bf16(v[0][3], v[1][3]); o.y = pg8::cvt_pk_bf16(v[2][3], v[3][3]); o.z = pg8::cvt_pk_bf16(v[4][3], v[5][3]); o.w = pg8::cvt_pk_bf16(v[6][3], v[7][3]); *(uint4*)(T + (c4 + 3) * 72 + 8 * kp) = o;
    lds_barrier();
#pragma unroll
    for (int j = 0; j < 4; ++j) {
        const int q = tid + 512 * j, nl = q >> 3, kc = q & 7, n = t.n0 + nl;
        const size_t drow = t.split == 0 ? (size_t)n : (size_t)((n >> 7) * 256 + (t.split == 2 ? 128 : 0) + (n & 127));
        *(uint4*)(t.dst + drow * t.K + t.k0 + kc * 8) = *(const uint4*)(T + nl * 72 + kc * 8);
    }
}
__device__ __forceinline__ void phase_convert(const Params& p, float* lds, int l, int first  , int bid, int nb) {
    const int tid = otid();
    bf16_t* T0 = (bf16_t*)lds; bf16_t* T1 = T0 + 256 * 72;
    pg8::f32x4 va[8], vb[8];
    __syncthreads();
    int it = first + bid;
    if (it < CV_TOTAL) cv_load(cv_desc(p, l, it), tid, va);
    for (; it < CV_TOTAL; it += 2 * nb) {
        const bool has1 = it + nb < CV_TOTAL, has2 = it + 2 * nb < CV_TOTAL;
        if (has1) cv_load(cv_desc(p, l, it + nb), tid, vb);
        cv_store(cv_desc(p, l, it), tid, T0, va);
        if (has2) cv_load(cv_desc(p, l, it + 2 * nb), tid, va);
        if (has1) cv_store(cv_desc(p, l, it + nb), tid, T1, vb);
    }
    __syncthreads();
}

constexpr int CVG = 4;
__device__ __forceinline__ int gemm_wgs(int total, int nb) { const int rounds = (total + nb - 1) / nb; int g = rounds > 0 ? ((total + rounds - 1) / rounds + 7) & ~7 : nb; return g < nb ? g : nb; }
__device__ __forceinline__ void convert_until(const Params& p, float* lds, int* done, int G, bool report) {
    const int tid = otid();
    bf16_t* T0 = (bf16_t*)lds; bf16_t* T1 = T0 + 256 * 72; int* sh = (int*)(T1 + 256 * 72);
    __syncthreads();
    if (report && tid == 0) atomicAdd(done, 1);
    for (;;) {
        __syncthreads();
        if (tid == 0) *sh = __hip_atomic_load(done, __ATOMIC_RELAXED, __HIP_MEMORY_SCOPE_AGENT) >= G ? CV_EARLY : atomicAdd(p.cvc, CVG);
        __syncthreads();
        const int base = *sh; if (base >= CV_EARLY) break;
        const int end = base + CVG < CV_EARLY ? base + CVG : CV_EARLY;
        pg8::f32x4 va[8], vb[8];
        int it = base; cv_load(cv_desc(p, 1, it), tid, va);
        for (; it < end; it += 2) {
            const bool has1 = it + 1 < end, has2 = it + 2 < end;
            if (has1) cv_load(cv_desc(p, 1, it + 1), tid, vb);
            cv_store(cv_desc(p, 1, it), tid, T0, va);
            if (has2) cv_load(cv_desc(p, 1, it + 2), tid, va);
            if (has1) cv_store(cv_desc(p, 1, it + 1), tid, T1, vb);
        }
    }
    __syncthreads();
}

struct EpiZ {
    bf16_t* z;
    __device__ __forceinline__ void operator()(const pg8::f32x4 (&acc)[2][2][4][2], const pg8::Unit& u, int wr, int wc, int fr, int fq) const {
        const int row0 = u.pm * 256 + wr * 64 + fr, col0 = u.pn * 256 + wc * 32 + 8 * fq;
#pragma unroll
        for (int ai = 0; ai < 2; ++ai)
#pragma unroll
            for (int m = 0; m < 4; ++m) { bf16_t* rowp = z + (size_t)(row0 + ai * 128 + m * 16) * ZLD + col0;
#pragma unroll
                for (int bj = 0; bj < 2; ++bj) { const pg8::f32x4 v0 = acc[ai][bj][m][0], v1 = acc[ai][bj][m][1];
                    pg8::u32x4 w; w.x = pg8::cvt_pk_bf16(v0[0], v0[1]); w.y = pg8::cvt_pk_bf16(v0[2], v0[3]); w.z = pg8::cvt_pk_bf16(v1[0], v1[1]); w.w = pg8::cvt_pk_bf16(v1[2], v1[3]);
                    *(pg8::u32x4*)(rowp + bj * 128) = w; } }
    }
};
struct EpiOut {
    float* xcur; const float* mod; int l; const float* xin; const float* cin;
    __device__ __forceinline__ void operator()(const pg8::f32x4 (&acc)[2][2][4][2], const pg8::Unit& u, int wr, int wc, int fr, int fq) const {
        const int row0 = u.pm * 256 + wr * 64 + fr, col0 = u.pn * 256 + wc * 32 + 4 * fq;
#pragma unroll
        for (int ai = 0; ai < 2; ++ai)
#pragma unroll
            for (int m = 0; m < 4; ++m) { const int g = row0 + ai * 128 + m * 16; float* xr = xcur + (size_t)g * D + col0; const float* gt = mod + (size_t)(l * 5 + modrow(g)) * 6 * D + 2 * D + col0;
                const int gb = g / TT, gs = g - gb * TT; const float* xs = l != 0 ? xr : (gs < LC ? cin + (size_t)(gb * LC + gs) * D : xin + (size_t)(gb * L + (gs - LC)) * D) + col0;
#pragma unroll
                for (int bj = 0; bj < 2; ++bj)
#pragma unroll
                    for (int n = 0; n < 2; ++n) { const int co = bj * 128 + n * 16; pg8::f32x4 x4 = *(const pg8::f32x4*)(xs + co); const pg8::f32x4 g4 = *(const pg8::f32x4*)(gt + co); x4 += g4 * acc[ai][bj][m][n]; *(pg8::f32x4*)(xr + co) = x4; } }
    }
};
__device__ __forceinline__ void phase_gemm_in(const Params& p, LAS unsigned char* stage, int l, int bid, int nb) {
    pg8::DenseSched S; S.nM = M / 256; S.nN = ZLD / 256; S.nwg = S.nM * S.nN; S.G = nb; S.c = bid; S.Bt = (const char*)p.WinT; S.rowbytes = D * 2; S.skipctx = 0;
    EpiZ E; E.z = p.z;
    pg8::gemm_phase<true>(stage, (const char*)p.h, D, S, E);
}
__device__ __forceinline__ void phase_gemm_out(const Params& p, LAS unsigned char* stage, int l, int bid, int nb) {
    pg8::DenseSched S; S.skipctx = (l == 1); S.nM = S.skipctx ? NB * L / 256 : M / 256; S.nN = D / 256; S.nwg = S.nM * S.nN; S.G = l == 0 ? gemm_wgs(S.nwg, nb) : nb; S.c = bid; S.Bt = (const char*)(p.WoutT + (size_t)l * D * D); S.rowbytes = D * 2;
    EpiOut E; E.xcur = p.xcur; E.mod = p.mod; E.l = l; E.xin = p.x; E.cin = p.ctx;
    if (bid < S.G) pg8::gemm_phase<false>(stage, (const char*)p.mix, D, S, E);
    if (l == 0) convert_until(p, (float*)(unsigned char*)stage, p.cvc + 1, S.G, bid < S.G);
}
__device__ __forceinline__ void phase_prep(const Params& p, float* lds, int l, int bid, int nb) {
    const int tix = otid();
    const int tid = tix;
    {
        float* cst = lds;
        __syncthreads();
        for (int i = tid; i < 1024; i += NT) { const int pos = i >> 4, f = i & 15; float sn, cs; sincosf((float)pos * expf(-(float)f * (9.210340371976184f / 16.0f)), &sn, &cs); cst[i] = cs; cst[1024 + i] = sn; }
        __syncthreads();
        const int lane = tid & 63, wid = tid >> 6;
        const int tl = lane >> 3, dv = lane & 7, axis = dv >> 2, half = (dv >> 1) & 1, f0 = 8 * (dv & 1);
        bf16_t* Tw = (bf16_t*)(lds + 2048) + wid * (64 * 72);
        for (int wt = bid * 8 + wid; wt < NB * 12 * (TT / 64); wt += nb * 8) {
            const int tile = wt % (TT / 64), bh = wt / (TT / 64), b = bh / 12, hh = bh % 12, s0 = tile * 64;
#pragma unroll 2
            for (int i = 0; i < 8; ++i) {
                const int s = s0 + 8 * i + tl; const bf16_t* zr = p.z + (size_t)(b * TT + s) * ZLD + ZB + hh * 64 + 8 * dv;
                const uint4 q8 = *(const uint4*)zr, k8 = *(const uint4*)(zr + 768), v8 = *(const uint4*)(zr + 1536);
                *(uint4*)(p.Qa + ((size_t)bh * TT + s) * 64 + 8 * dv) = q8;
                const unsigned vw[4] = {v8.x, v8.y, v8.z, v8.w};
#pragma unroll
                for (int e = 0; e < 4; ++e) { Tw[(8 * dv + 2 * e) * 72 + 8 * i + tl] = (bf16_t)(vw[e] & 0xffffu); Tw[(8 * dv + 2 * e + 1) * 72 + 8 * i + tl] = (bf16_t)(vw[e] >> 16); }
                uint4 ko = k8;
                if (s >= LC) {
                    const int t = s - LC, pos = axis == 0 ? (t >> 6) : (t & 63);
                    const unsigned qw[4] = {q8.x, q8.y, q8.z, q8.w}, kw[4] = {k8.x, k8.y, k8.z, k8.w};
                    unsigned qo[4], kq[4];
#pragma unroll
                    for (int e = 0; e < 4; ++e) {
                        const unsigned qpw = (unsigned)bperm_i(lane ^ 2, (int)qw[e]), kpw = (unsigned)bperm_i(lane ^ 2, (int)kw[e]);
                        const float c0 = cst[pos * 16 + f0 + 2 * e], s0f = cst[1024 + pos * 16 + f0 + 2 * e], c1 = cst[pos * 16 + f0 + 2 * e + 1], s1f = cst[1024 + pos * 16 + f0 + 2 * e + 1];
                        const float qa0 = bfl(qw[e]), qa1 = bfh(qw[e]), qb0 = bfl(qpw), qb1 = bfh(qpw), ka0 = bfl(kw[e]), ka1 = bfh(kw[e]), kb0 = bfl(kpw), kb1 = bfh(kpw);
                        const float sg = half == 0 ? -1.f : 1.f;
                        qo[e] = pg8::cvt_pk_bf16(qa0 * c0 + sg * qb0 * s0f, qa1 * c1 + sg * qb1 * s1f);
                        kq[e] = pg8::cvt_pk_bf16(ka0 * c0 + sg * kb0 * s0f, ka1 * c1 + sg * kb1 * s1f);
                    }
                    *(uint4*)(p.Qr + ((size_t)bh * L + t) * 64 + 8 * dv) = make_uint4(qo[0], qo[1], qo[2], qo[3]);
                    ko = make_uint4(kq[0], kq[1], kq[2], kq[3]);
                }
                *(uint4*)(p.Ka + ((((size_t)bh * (TT / 16) + (s >> 4)) * 2 + (dv >> 2)) * 16 + (s & 15)) * 32 + 8 * (dv & 3)) = ko;
            }
            __builtin_amdgcn_wave_barrier();
#pragma unroll 2
            for (int i = 0; i < 8; ++i) {
                const int item = i * 64 + lane, q4 = item & 3, d = (item >> 2) & 63, blk = item >> 8;
                const uint2 lo = *(const uint2*)(Tw + d * 72 + blk * 32 + 4 * q4), hi = *(const uint2*)(Tw + d * 72 + blk * 32 + 16 + 4 * q4);
                *(uint4*)(p.Vt + (((size_t)bh * (TT / 32) + tile * 2 + blk) * 64 + d) * 32 + 8 * q4) = make_uint4(lo.x, lo.y, hi.x, hi.y); }
            __builtin_amdgcn_wave_barrier();
        }
        __syncthreads();
    }
    const float* cw = p.conv_w + (size_t)l * 3 * 512;
    for (int i = bid * NT + tid; i < M * 64; i += nb * NT) {
        const int ch = (i & 63) * 8, g = i >> 6, s = g % TT;
        const bf16_t* zr = p.z + (size_t)g * ZLD + ch;
        const uint4 bg = *(const uint4*)zr, cg = *(const uint4*)(zr + 512), hv = *(const uint4*)(zr + 1024);
        uint4 cgp = make_uint4(0u, 0u, 0u, 0u), hp = cgp, cgn = cgp, hn = cgp;
        if (s != 0 && s != LC) { cgp = *(const uint4*)(zr + 512 - ZLD); hp = *(const uint4*)(zr + 1024 - ZLD); }
        if (s != LC - 1 && s != TT - 1) { cgn = *(const uint4*)(zr + 512 + ZLD); hn = *(const uint4*)(zr + 1024 + ZLD); }
        const float4 w0a = *(const float4*)(cw + ch), w0b = *(const float4*)(cw + ch + 4), w1a = *(const float4*)(cw + 512 + ch), w1b = *(const float4*)(cw + 512 + ch + 4), w2a = *(const float4*)(cw + 1024 + ch), w2b = *(const float4*)(cw + 1024 + ch + 4);
        const float w0[8] = {w0a.x, w0a.y, w0a.z, w0a.w, w0b.x, w0b.y, w0b.z, w0b.w}, w1[8] = {w1a.x, w1a.y, w1a.z, w1a.w, w1b.x, w1b.y, w1b.z, w1b.w}, w2[8] = {w2a.x, w2a.y, w2a.z, w2a.w, w2b.x, w2b.y, w2b.z, w2b.w};
        const unsigned bgw[4] = {bg.x, bg.y, bg.z, bg.w}, cgw[4] = {cg.x, cg.y, cg.z, cg.w}, hw[4] = {hv.x, hv.y, hv.z, hv.w}, cpw[4] = {cgp.x, cgp.y, cgp.z, cgp.w}, hpw[4] = {hp.x, hp.y, hp.z, hp.w}, cnw[4] = {cgn.x, cgn.y, cgn.z, cgn.w}, hnw[4] = {hn.x, hn.y, hn.z, hn.w};
        unsigned o[4];
#pragma unroll
        for (int e = 0; e < 4; ++e) {
            const float r0 = bfl(bgw[e]) * (w0[2 * e] * bfl(cpw[e]) * bfl(hpw[e]) + w1[2 * e] * bfl(cgw[e]) * bfl(hw[e]) + w2[2 * e] * bfl(cnw[e]) * bfl(hnw[e]));
            const float r1 = bfh(bgw[e]) * (w0[2 * e + 1] * bfh(cpw[e]) * bfh(hpw[e]) + w1[2 * e + 1] * bfh(cgw[e]) * bfh(hw[e]) + w2[2 * e + 1] * bfh(cnw[e]) * bfh(hnw[e]));
            o[e] = pg8::cvt_pk_bf16(r0, r1);
        }
        *(uint4*)(p.mix + (size_t)g * D + ch) = make_uint4(o[0], o[1], o[2], o[3]);
    }
}

typedef short rw_bf16x8 __attribute__((ext_vector_type(8)));
typedef float rw_f32x4 __attribute__((ext_vector_type(4)));
constexpr int RLD = 72, FLD = 68, GLD = 104;
constexpr int RW_UNITS = NB * 12 * (TT / 64) * 2;
template <int K> __device__ __forceinline__ void mm_t(rw_f32x4 (&acc)[2], const bf16_t* A, int lda, const bf16_t* Bt, int ldb, int rb, int ch, int fr, int q) {
#pragma unroll
    for (int ks = 0; ks < K / 32; ++ks) {
        const rw_bf16x8 a = *(const rw_bf16x8*)(A + (16 * rb + fr) * lda + 32 * ks + 8 * q);
#pragma unroll
        for (int nt = 0; nt < 2; ++nt) { const rw_bf16x8 b = *(const rw_bf16x8*)(Bt + (32 * ch + 16 * nt + fr) * ldb + 32 * ks + 8 * q); acc[nt] = __builtin_amdgcn_mfma_f32_16x16x32_bf16(b, a, acc[nt], 0, 0, 0); }
    }
}
__device__ __forceinline__ bool rw_map(int tid, int n, int hh, int& kind, int& c8, int& col, int& rg) {
    const int w = __builtin_amdgcn_readfirstlane(tid >> 6), ln = tid & 63; rg = ln & 7; const int cvl = ln >> 3;
    if (w < 3) { kind = w; c8 = cvl * 8; col = w * 768 + hh * 64 + c8; return true; }
    if (w < 5) { kind = w; c8 = cvl * 8; col = (w == 3 ? 2400 : 2496) + n * 48 + c8; return cvl < 6; }
    if (w < 7) { kind = 5; const int cg = (w - 5) * 8 + cvl; c8 = cg * 8; col = 2304 + c8; return n == 0 && cg < 12; }
    kind = 6; c8 = 0; col = 0; return false;
}
struct RwPre { uint4 raw[10]; float4 m0a, m0b, m1a, m1b; };
__device__ __forceinline__ void rwkv_prefetch(const Params& p, int l, int unit, int tid, RwPre& P) {
    const int n = unit & 1, ci = (unit >> 1) % (TT / 64), bh = (unit >> 1) / (TT / 64), b = bh / 12, hh = bh % 12;
    const int segb = ci < 4 ? 0 : LC, sege = ci < 4 ? LC : TT, s0 = ci * 64;
    int kind, c8, col, rg; const bool act = rw_map(tid, n, hh, kind, c8, col, rg);
#pragma unroll
    for (int i = 0; i < 10; ++i) P.raw[i] = make_uint4(0u, 0u, 0u, 0u);
    if (unit < RW_UNITS && act) {
        const int j0 = 8 * rg;
        const int ta = n == 0 ? s0 + j0 : s0 + 63 - j0 - 7;
        const bf16_t* zp = p.z + (size_t)(b * TT + ta) * ZLD + ZC + col;
#pragma unroll
        for (int i = 0; i < 10; ++i) { const int tk = ta - 1 + i; if (tk >= segb && tk < sege) P.raw[i] = *(const uint4*)(zp + (ptrdiff_t)(i - 1) * ZLD); }
        const float* mu = p.rw_shift + (size_t)l * 2 * RWC;
        P.m0a = *(const float4*)(mu + col); P.m0b = *(const float4*)(mu + col + 4); P.m1a = *(const float4*)(mu + RWC + col); P.m1b = *(const float4*)(mu + RWC + col + 4);
    }
}
__device__ __forceinline__ void rwkv_unit(const Params& p, unsigned char* Lb, int l, int unit, int unit_next, RwPre& P) {
    const int tid = otid(), wid = tid >> 6, lane = tid & 63, rb = wid & 3, ch = wid >> 2, fr = lane & 15, q = lane >> 4;
    const int n = unit & 1, ci = (unit >> 1) % (TT / 64), bh = (unit >> 1) / (TT / 64), b = bh / 12, hh = bh % 12;
    const int segb = ci < 4 ? 0 : LC, sege = ci < 4 ? LC : TT, s0 = ci * 64;
    float* rf = (float*)Lb; float* kf = rf + 64 * FLD; float* red = kf + 64 * FLD;
    bf16_t* Aw = (bf16_t*)(Lb + 36864); bf16_t* Aa = Aw + 64 * RLD; bf16_t* Bw = Aa + 64 * RLD; bf16_t* Ba = Bw + 64 * RLD; bf16_t* Ag = Ba + 64 * RLD; bf16_t* Bg = Ag + 64 * GLD;
    bf16_t* Rt = (bf16_t*)(Lb + 36864); bf16_t* Kt = (bf16_t*)(Lb + 46080); bf16_t* Bt = (bf16_t*)(Lb + 55296); bf16_t* kap = (bf16_t*)(Lb + 64512);
    bf16_t* KtT = (bf16_t*)(Lb + 73728); bf16_t* BtT = (bf16_t*)(Lb + 82944); bf16_t* kapT = (bf16_t*)(Lb + 92160); bf16_t* VT = (bf16_t*)(Lb + 101376);
    float* btot = (float*)(Lb + 110592); float* GCv = btot + 256;
    bf16_t* Akk = (bf16_t*)(Lb + 27648); bf16_t* Ark = (bf16_t*)(Lb + 111872); bf16_t* Arb = (bf16_t*)(Lb + 121088); bf16_t* XT = (bf16_t*)(Lb + 130304);
    bf16_t* const Ms[2] = {(bf16_t*)(Lb + 0), (bf16_t*)(Lb + 46080)}; bf16_t* const MTs[2] = {(bf16_t*)(Lb + 9216), (bf16_t*)(Lb + 55296)}; bf16_t* const Ts[2] = {(bf16_t*)(Lb + 18432), (bf16_t*)(Lb + 64512)};
    const float* mu = p.rw_shift + (size_t)l * 2 * RWC;
    lds_barrier();
    float4 cst[2][5];
#pragma unroll
    for (int nt = 0; nt < 2; ++nt) { const int c = hh * 64 + 32 * ch + 16 * nt + 4 * q;
        cst[nt][0] = *(const float4*)(p.rw_k_k + (size_t)l * 768 + c); cst[nt][1] = *(const float4*)(p.rw_k_a + (size_t)l * 768 + c); cst[nt][2] = *(const float4*)(p.rw_r_k + (size_t)l * 768 + c);
        cst[nt][3] = *(const float4*)(p.rw_w0 + ((size_t)l * 2 + n) * 768 + c); cst[nt][4] = *(const float4*)(p.rw_a0 + ((size_t)l * 2 + n) * 768 + c); }
    const uint4* srcw = (const uint4*)(p.Lwa + (size_t)((l * 2 + n) * 12 + hh) * 2 * 64 * 72);
    const uint4* srcg = (const uint4*)(p.Lg + (size_t)(l * 12 + hh) * 64 * 104);
    const uint4 wv0 = srcw[tid], wv1 = srcw[tid + 512], wv2 = tid < 128 ? srcw[tid + 1024] : make_uint4(0u, 0u, 0u, 0u);
    uint4 gv0 = make_uint4(0u, 0u, 0u, 0u), gv1 = gv0; if (n == 0) { gv0 = srcg[tid]; if (tid < 320) gv1 = srcg[tid + 512]; }
    {
        int kind, c8, col, rg;
        if (rw_map(tid, n, hh, kind, c8, col, rg)) {
            const int j0 = 8 * rg;
            const int ta = n == 0 ? s0 + j0 : s0 + 63 - j0 - 7;
            const float m0[8] = {P.m0a.x, P.m0a.y, P.m0a.z, P.m0a.w, P.m0b.x, P.m0b.y, P.m0b.z, P.m0b.w}, m1[8] = {P.m1a.x, P.m1a.y, P.m1a.z, P.m1a.w, P.m1b.x, P.m1b.y, P.m1b.z, P.m1b.w};
            unsigned vpk[8][4];
#pragma unroll
            for (int i = 0; i < 8; ++i) {
                const int tk = ta + i, j = n == 0 ? tk - s0 : s0 + 63 - tk;
                const uint4 pu = P.raw[i], cu = P.raw[i + 1], nu = P.raw[i + 2];
                const unsigned pw[4] = {pu.x, pu.y, pu.z, pu.w}, cw[4] = {cu.x, cu.y, cu.z, cu.w}, nw[4] = {nu.x, nu.y, nu.z, nu.w};
                float x[8];
#pragma unroll
                for (int e = 0; e < 4; ++e) { const float c0 = bfl(cw[e]), c1 = bfh(cw[e]);
                    x[2 * e] = c0 + m0[2 * e] * (bfl(pw[e]) - c0) + m1[2 * e] * (bfl(nw[e]) - c0); x[2 * e + 1] = c1 + m0[2 * e + 1] * (bfh(pw[e]) - c1) + m1[2 * e + 1] * (bfh(nw[e]) - c1); }
                if (kind == 0) { *(float4*)(rf + j * FLD + c8) = make_float4(x[0], x[1], x[2], x[3]); *(float4*)(rf + j * FLD + c8 + 4) = make_float4(x[4], x[5], x[6], x[7]); }
                else if (kind == 1) { *(float4*)(kf + j * FLD + c8) = make_float4(x[0], x[1], x[2], x[3]); *(float4*)(kf + j * FLD + c8 + 4) = make_float4(x[4], x[5], x[6], x[7]); }
                else if (kind == 2) {
#pragma unroll
                    for (int e = 0; e < 8; ++e) { const unsigned hbits = (unsigned)f2bf(x[e]); vpk[e][i >> 1] = (i & 1) ? (vpk[e][i >> 1] | (hbits << 16)) : hbits; }
                    if (n == 0) { uint4 o; o.x = pg8::cvt_pk_bf16(x[0], x[1]); o.y = pg8::cvt_pk_bf16(x[2], x[3]); o.z = pg8::cvt_pk_bf16(x[4], x[5]); o.w = pg8::cvt_pk_bf16(x[6], x[7]);
                        *(uint4*)(p.rw_vb + ((size_t)(bh * (TT / 64) + ci) * 64 + j) * 64 + c8) = o; } }
                else {
                    bf16_t* dst = kind == 3 ? Aw + j * RLD + c8 : (kind == 4 ? Aa + j * RLD + c8 : Ag + j * GLD + c8);
                    if (kind == 3) {
#pragma unroll
                        for (int e = 0; e < 8; ++e) x[e] = 1.0f - 2.0f * __builtin_amdgcn_rcpf(1.0f + __builtin_amdgcn_exp2f(2.8853900817779268f * x[e])); }
                    else if (kind == 5) {
#pragma unroll
                        for (int e = 0; e < 8; ++e) x[e] = __builtin_amdgcn_rcpf(1.0f + __builtin_amdgcn_exp2f(-1.4426950408889634f * x[e])); }
                    uint4 o; o.x = pg8::cvt_pk_bf16(x[0], x[1]); o.y = pg8::cvt_pk_bf16(x[2], x[3]); o.z = pg8::cvt_pk_bf16(x[4], x[5]); o.w = pg8::cvt_pk_bf16(x[6], x[7]); *(uint4*)dst = o;
                }
            }
            if (kind == 2) {
#pragma unroll
                for (int e = 0; e < 8; ++e) { uint4 o = make_uint4(vpk[e][0], vpk[e][1], vpk[e][2], vpk[e][3]);
                    if (n != 0) o = make_uint4((o.w << 16) | (o.w >> 16), (o.z << 16) | (o.z >> 16), (o.y << 16) | (o.y >> 16), (o.x << 16) | (o.x >> 16));
                    *(uint4*)(VT + (c8 + e) * RLD + j0) = o; }
            }
        }
    }
    for (int i = tid; i < 64 * 16; i += NT) { const int j = i >> 4, c = 48 + (i & 15); Aw[j * RLD + c] = 0; Aa[j * RLD + c] = 0; }
    { uint4* dw = (uint4*)Bw; dw[tid] = wv0; dw[tid + 512] = wv1; if (tid < 128) dw[tid + 1024] = wv2;
      if (n == 0) { uint4* dg = (uint4*)Bg; dg[tid] = gv0; if (tid < 320) dg[tid + 512] = gv1; } }
    rwkv_prefetch(p, l, unit_next, tid, P);
    lds_barrier();
    rw_f32x4 accw[2], acca[2], accg[2];
#pragma unroll
    for (int nt = 0; nt < 2; ++nt) { accw[nt] = (rw_f32x4){0.f, 0.f, 0.f, 0.f}; acca[nt] = accw[nt]; accg[nt] = accw[nt]; }
    mm_t<64>(accw, Aw, RLD, Bw, RLD, rb, ch, fr, q);
    mm_t<64>(acca, Aa, RLD, Ba, RLD, rb, ch, fr, q);
    if (n == 0) mm_t<96>(accg, Ag, GLD, Bg, GLD, rb, ch, fr, q);
    const int t = 16 * rb + fr, s = n == 0 ? s0 + t : s0 + 63 - t, g = b * TT + s;
    float kv[2][4], rv[2][4], kkr[2][4], av[2][4], lw[2][4], kd[2][4], G[2][4]; float ssq = 0.f, bon = 0.f;
#pragma unroll
    for (int nt = 0; nt < 2; ++nt) {
        const int c = 32 * ch + 16 * nt + 4 * q;
        const float4 k4 = *(const float4*)(kf + t * FLD + c), r4 = *(const float4*)(rf + t * FLD + c);
        const float4 kk4 = cst[nt][0], ka4 = cst[nt][1], rk4 = cst[nt][2], w04 = cst[nt][3], a04 = cst[nt][4];
        const float ke[4] = {k4.x, k4.y, k4.z, k4.w}, re[4] = {r4.x, r4.y, r4.z, r4.w}, kke[4] = {kk4.x, kk4.y, kk4.z, kk4.w}, kae[4] = {ka4.x, ka4.y, ka4.z, ka4.w}, rke[4] = {rk4.x, rk4.y, rk4.z, rk4.w}, w0e[4] = {w04.x, w04.y, w04.z, w04.w}, a0e[4] = {a04.x, a04.y, a04.z, a04.w};
#pragma unroll
        for (int j = 0; j < 4; ++j) {
            kv[nt][j] = ke[j]; rv[nt][j] = re[j]; kkr[nt][j] = ke[j] * kke[j]; ssq += kkr[nt][j] * kkr[nt][j];
            const float wpre = w0e[j] + accw[nt][j]; lw[nt][j] = -0.6065306597126334f * __builtin_amdgcn_rcpf(1.0f + __expf(-wpre));
            av[nt][j] = __builtin_amdgcn_rcpf(1.0f + __expf(-(a0e[j] + acca[nt][j])));
            kd[nt][j] = ke[j] * (1.0f + (av[nt][j] - 1.0f) * kae[j]); bon += re[j] * kd[nt][j] * rke[j];
            float x = lw[nt][j];
            x += __int_as_float(__builtin_amdgcn_update_dpp(0, __float_as_int(x), 0x111, 0xF, 0xF, true)); x += __int_as_float(__builtin_amdgcn_update_dpp(0, __float_as_int(x), 0x112, 0xF, 0xF, true));
            x += __int_as_float(__builtin_amdgcn_update_dpp(0, __float_as_int(x), 0x114, 0xF, 0xF, true)); x += __int_as_float(__builtin_amdgcn_update_dpp(0, __float_as_int(x), 0x118, 0xF, 0xF, true));
            G[nt][j] = x; if (fr == 15) btot[rb * 64 + c + j] = x;
        }
    }
    ssq += bperm_f(lane ^ 16, ssq); ssq += bperm_f(lane ^ 32, ssq); bon += bperm_f(lane ^ 16, bon); bon += bperm_f(lane ^ 32, bon);
    if (q == 0) { red[ch * 64 + t] = ssq; red[128 + ch * 64 + t] = bon; }
    lds_barrier();
    const float rnorm = 1.0f / fmaxf(sqrtf(red[t] + red[64 + t]), 1e-12f);
    if (ch == 0 && q == 0) p.bonus[((size_t)n * M + g) * 12 + hh] = red[128 + t] + red[192 + t];
    const size_t uoff = (size_t)unit * 4096;
#pragma unroll
    for (int nt = 0; nt < 2; ++nt)
#pragma unroll
        for (int j = 0; j < 4; ++j) { const int c = 32 * ch + 16 * nt + 4 * q + j; float pre = 0.f, tot = 0.f;
#pragma unroll
            for (int r2 = 0; r2 < 4; ++r2) { const float bt = btot[r2 * 64 + c]; tot += bt; if (r2 < rb) pre += bt; }
            G[nt][j] += pre; if (t == 63) GCv[c] = __expf(tot); }
#pragma unroll
    for (int nt = 0; nt < 2; ++nt) {
        const int c = 32 * ch + 16 * nt + 4 * q;
        float rt[4], kt[4], bt[4], kp[4];
#pragma unroll
        for (int j = 0; j < 4; ++j) { const float gam = __expf(G[nt][j]), ig = __expf(-G[nt][j]), gp = __expf(G[nt][j] - lw[nt][j]); const float kk = kkr[nt][j] * rnorm;
            rt[j] = rv[nt][j] * gam; kt[j] = kd[nt][j] * ig; bt[j] = kk * av[nt][j] * ig; kp[j] = kk * gp;
            KtT[(c + j) * RLD + t] = f2bf(kt[j]); BtT[(c + j) * RLD + t] = f2bf(bt[j]); kapT[(c + j) * RLD + t] = f2bf(kp[j]); }
        uint2 o; o.x = pg8::cvt_pk_bf16(rt[0], rt[1]); o.y = pg8::cvt_pk_bf16(rt[2], rt[3]); *(uint2*)(Rt + t * RLD + c) = o;
        o.x = pg8::cvt_pk_bf16(kt[0], kt[1]); o.y = pg8::cvt_pk_bf16(kt[2], kt[3]); *(uint2*)(Kt + t * RLD + c) = o;
        o.x = pg8::cvt_pk_bf16(bt[0], bt[1]); o.y = pg8::cvt_pk_bf16(bt[2], bt[3]); *(uint2*)(Bt + t * RLD + c) = o;
        o.x = pg8::cvt_pk_bf16(kp[0], kp[1]); o.y = pg8::cvt_pk_bf16(kp[2], kp[3]); *(uint2*)(kap + t * RLD + c) = o;
        if (n == 0) { o.x = pg8::cvt_pk_bf16(accg[nt][0], accg[nt][1]); o.y = pg8::cvt_pk_bf16(accg[nt][2], accg[nt][3]); *(uint2*)(p.rw_gb + ((size_t)(bh * (TT / 64) + ci) * 64 + t) * 64 + c) = o; }
    }
    lds_barrier();
#define RW_ZERO(a) do { a[0] = (rw_f32x4){0.f, 0.f, 0.f, 0.f}; a[1] = a[0]; } while (0)
#define RW_STORE_BF(dst, a) do { _Pragma("unroll") for (int _nt = 0; _nt < 2; ++_nt) { uint2 _o; _o.x = pg8::cvt_pk_bf16(a[_nt][0], a[_nt][1]); _o.y = pg8::cvt_pk_bf16(a[_nt][2], a[_nt][3]); \
        *(uint2*)((dst) + t * RLD + 32 * ch + 16 * _nt + 4 * q) = _o; } } while (0)
    { rw_f32x4 a1[2], a2[2], a3[2], a4[2], a5[2]; RW_ZERO(a1); RW_ZERO(a2); RW_ZERO(a3); RW_ZERO(a4); RW_ZERO(a5);
      mm_t<64>(a1, kap, RLD, Bt, RLD, rb, ch, fr, q);
      mm_t<64>(a2, Bt, RLD, kap, RLD, rb, ch, fr, q);
      mm_t<64>(a3, kap, RLD, Kt, RLD, rb, ch, fr, q);
      mm_t<64>(a4, Rt, RLD, Kt, RLD, rb, ch, fr, q);
      mm_t<64>(a5, Rt, RLD, Bt, RLD, rb, ch, fr, q);
      rw_f32x4 t1[2];
#pragma unroll
      for (int nt = 0; nt < 2; ++nt)
#pragma unroll
          for (int j = 0; j < 4; ++j) { const int cc = 32 * ch + 16 * nt + 4 * q + j;
              a1[nt][j] = cc < t ? -a1[nt][j] : 0.f; t1[nt][j] = a1[nt][j] + (cc == t ? 1.f : 0.f);
              a2[nt][j] = t < cc ? -a2[nt][j] : 0.f;
              a3[nt][j] = cc < t ? a3[nt][j] : 0.f; a4[nt][j] = cc <= t ? a4[nt][j] : 0.f; a5[nt][j] = cc <= t ? a5[nt][j] : 0.f; }
      RW_STORE_BF(Ms[0], a1); RW_STORE_BF(MTs[0], a2); RW_STORE_BF(Ts[0], t1); RW_STORE_BF(Akk, a3); RW_STORE_BF(Ark, a4); RW_STORE_BF(Arb, a5); }
    lds_barrier();
    { rw_f32x4 a1[2], a2[2], a3[2]; RW_ZERO(a1); RW_ZERO(a2); RW_ZERO(a3);
      mm_t<64>(a1, VT, RLD, Akk, RLD, rb, ch, fr, q);
      mm_t<64>(a2, Ms[0], RLD, MTs[0], RLD, rb, ch, fr, q);
      mm_t<64>(a3, MTs[0], RLD, Ms[0], RLD, rb, ch, fr, q);
      RW_STORE_BF(XT, a1); RW_STORE_BF(Ms[1], a2); RW_STORE_BF(MTs[1], a3); }
    lds_barrier();
#pragma unroll
    for (int k = 1; k <= 5; ++k) {
        const bf16_t* Tk = Ts[(k + 1) & 1]; bf16_t* Tn = Ts[k & 1];
        rw_f32x4 a1[2]; RW_ZERO(a1);
        mm_t<64>(a1, Tk, RLD, MTs[k & 1], RLD, rb, ch, fr, q);
#pragma unroll
        for (int nt = 0; nt < 2; ++nt) { const uint2 o = *(const uint2*)(Tk + t * RLD + 32 * ch + 16 * nt + 4 * q); a1[nt][0] += bfl(o.x); a1[nt][1] += bfh(o.x); a1[nt][2] += bfl(o.y); a1[nt][3] += bfh(o.y); }
        RW_STORE_BF(Tn, a1);
        if (k < 5) { rw_f32x4 a2[2], a3[2]; RW_ZERO(a2); RW_ZERO(a3);
            mm_t<64>(a2, Ms[k & 1], RLD, MTs[k & 1], RLD, rb, ch, fr, q);
            mm_t<64>(a3, MTs[k & 1], RLD, Ms[k & 1], RLD, rb, ch, fr, q);
            RW_STORE_BF(Ms[(k + 1) & 1], a2); RW_STORE_BF(MTs[(k + 1) & 1], a3); }
        lds_barrier();
    }
    { rw_f32x4 a1[2], a2[2]; RW_ZERO(a1); RW_ZERO(a2);
      mm_t<64>(a1, kapT, RLD, Ts[1], RLD, rb, ch, fr, q);
      mm_t<64>(a2, XT, RLD, Ts[1], RLD, rb, ch, fr, q);
      RW_STORE_BF(Ms[0], a1); RW_STORE_BF(MTs[0], a2); }
    lds_barrier();
    { const bf16_t* WT = Ms[0]; const bf16_t* U0T = MTs[0];
      rw_f32x4 a1[2]; RW_ZERO(a1); mm_t<64>(a1, BtT, RLD, WT, RLD, rb, ch, fr, q);
      { const float gc = GCv[t];
#pragma unroll
        for (int nt = 0; nt < 2; ++nt) { uint2 o; float e[4];
#pragma unroll
            for (int j = 0; j < 4; ++j) e[j] = gc * ((32 * ch + 16 * nt + 4 * q + j == t ? 1.f : 0.f) - a1[nt][j]);
            o.x = pg8::cvt_pk_bf16(e[0], e[1]); o.y = pg8::cvt_pk_bf16(e[2], e[3]); *(uint2*)(p.rw_P + uoff + t * 64 + 32 * ch + 16 * nt + 4 * q) = o; } }
      rw_f32x4 a2[2], a3[2]; RW_ZERO(a2); RW_ZERO(a3); mm_t<64>(a2, VT, RLD, KtT, RLD, rb, ch, fr, q); mm_t<64>(a3, U0T, RLD, BtT, RLD, rb, ch, fr, q);
#pragma unroll
      for (int nt = 0; nt < 2; ++nt) { const int c = 32 * ch + 16 * nt + 4 * q; const float4 gc4 = *(const float4*)(GCv + c);
          *(float4*)(p.rw_QT + uoff + t * 64 + c) = make_float4(gc4.x * (a2[nt][0] - a3[nt][0]), gc4.y * (a2[nt][1] - a3[nt][1]), gc4.z * (a2[nt][2] - a3[nt][2]), gc4.w * (a2[nt][3] - a3[nt][3])); }
      rw_f32x4 a4[2]; RW_ZERO(a4); mm_t<64>(a4, Arb, RLD, WT, RLD, rb, ch, fr, q);
#pragma unroll
      for (int nt = 0; nt < 2; ++nt) { const int c = 32 * ch + 16 * nt + 4 * q; const uint2 r2 = *(const uint2*)(Rt + t * RLD + c); uint2 o;
          o.x = pg8::cvt_pk_bf16(bfl(r2.x) - a4[nt][0], bfh(r2.x) - a4[nt][1]); o.y = pg8::cvt_pk_bf16(bfl(r2.y) - a4[nt][2], bfh(r2.y) - a4[nt][3]); *(uint2*)(p.rw_Ry + uoff + t * 64 + c) = o; }
      rw_f32x4 a5[2], a6[2]; RW_ZERO(a5); RW_ZERO(a6); mm_t<64>(a5, Ark, RLD, VT, RLD, rb, ch, fr, q); mm_t<64>(a6, Arb, RLD, U0T, RLD, rb, ch, fr, q);
#pragma unroll
      for (int nt = 0; nt < 2; ++nt) { const int c = 32 * ch + 16 * nt + 4 * q; *(float4*)(p.rw_Y0 + uoff + t * 64 + c) = make_float4(a5[nt][0] - a6[nt][0], a5[nt][1] - a6[nt][1], a5[nt][2] - a6[nt][2], a5[nt][3] - a6[nt][3]); } }
#undef RW_ZERO
#undef RW_STORE_BF
}

__device__ __forceinline__ void rwkv_chain(const Params& p, unsigned char* Lb, int chain) {
    const int tid = otid(), wid = tid >> 6, lane = tid & 63, rb = wid & 3, ch = wid >> 2, fr = lane & 15, q = lane >> 4;
    const int n = chain / 48, bh = chain % 48;
    bf16_t* HT[2] = {(bf16_t*)Lb, (bf16_t*)(Lb + 9216)};
    rw_f32x4 hacc[2];
    hacc[0] = (rw_f32x4){0.f, 0.f, 0.f, 0.f}; hacc[1] = hacc[0];
    __syncthreads();
    auto uoff_of = [&](int step) { const int ci = n == 0 ? step : (step < 4 ? 3 - step : (TT / 64 - 1) - (step - 4)); return (size_t)(((bh * (TT / 64) + ci) << 1) | n) * 4096; };
    struct Ops { rw_bf16x8 p0, p1; float4 q0, q1; };
    auto load_ops = [&](int step, Ops& o) { const size_t uo = uoff_of(step); const bf16_t* Pp = p.rw_P + uo + (16 * rb + fr) * 64 + 8 * q; o.p0 = *(const rw_bf16x8*)Pp; o.p1 = *(const rw_bf16x8*)(Pp + 32);
        o.q0 = *(const float4*)(p.rw_QT + uo + (32 * ch + fr) * 64 + 16 * rb + 4 * q); o.q1 = *(const float4*)(p.rw_QT + uo + (32 * ch + 16 + fr) * 64 + 16 * rb + 4 * q); };
    auto do_step = [&](int step, const Ops& o) {
        const size_t uoff = uoff_of(step);
        bf16_t* hb = HT[step & 1];
#pragma unroll
        for (int nt = 0; nt < 2; ++nt) { uint2 w; w.x = pg8::cvt_pk_bf16(hacc[nt][0], hacc[nt][1]); w.y = pg8::cvt_pk_bf16(hacc[nt][2], hacc[nt][3]);
            const int v = 32 * ch + 16 * nt + fr, k0 = 16 * rb + 4 * q;
            *(uint2*)(hb + v * RLD + k0) = w; *(uint2*)(p.rw_H0 + uoff + v * 64 + k0) = w; }
        lds_barrier();
#pragma unroll
        for (int nt = 0; nt < 2; ++nt) {
            const bf16_t* bp = hb + (32 * ch + 16 * nt + fr) * RLD + 8 * q;
            const rw_bf16x8 b0 = *(const rw_bf16x8*)bp, b1 = *(const rw_bf16x8*)(bp + 32);
            const float4 cq = nt == 0 ? o.q0 : o.q1;
            rw_f32x4 c = (rw_f32x4){cq.x, cq.y, cq.z, cq.w};
            c = __builtin_amdgcn_mfma_f32_16x16x32_bf16(o.p0, b0, c, 0, 0, 0);
            hacc[nt] = __builtin_amdgcn_mfma_f32_16x16x32_bf16(o.p1, b1, c, 0, 0, 0);
        }
    };
    Ops A, B; load_ops(0, A); load_ops(1, B);
    for (int step = 0; step < TT / 64; step += 2) {
        do_step(step, A); if (step + 2 < TT / 64) load_ops(step + 2, A);
        do_step(step + 1, B); if (step + 3 < TT / 64) load_ops(step + 3, B);
    }
}

__device__ __forceinline__ void rwkv_out(const Params& p, unsigned char* Lb, int l, int unit3) {
    const int tid = otid(), wid = tid >> 6, lane = tid & 63, rb = wid & 3, ch = wid >> 2, fr = lane & 15, q = lane >> 4;
    const int ci = unit3 % (TT / 64), bh = unit3 / (TT / 64), b = bh / 12, hh = bh % 12;
    float* red = (float*)Lb;
    const int t = 16 * rb + fr, g = b * TT + ci * 64 + t;
    rw_f32x4 y[2]; y[0] = (rw_f32x4){0.f, 0.f, 0.f, 0.f}; y[1] = y[0];
#pragma unroll
    for (int n = 0; n < 2; ++n) {
        const size_t uoff = (size_t)(((bh * (TT / 64) + ci) << 1) | n) * 4096;
        const int row = n == 0 ? t : 63 - t;
        const bf16_t* ap = p.rw_Ry + uoff + row * 64 + 8 * q;
        const rw_bf16x8 a0 = *(const rw_bf16x8*)ap, a1 = *(const rw_bf16x8*)(ap + 32);
#pragma unroll
        for (int nt = 0; nt < 2; ++nt) {
            const int c = 32 * ch + 16 * nt;
            const bf16_t* bp = p.rw_H0 + uoff + (c + fr) * 64 + 8 * q;
            const rw_bf16x8 b0 = *(const rw_bf16x8*)bp, b1 = *(const rw_bf16x8*)(bp + 32);
            const float4 y0 = *(const float4*)(p.rw_Y0 + uoff + row * 64 + c + 4 * q);
            rw_f32x4 acc = (rw_f32x4){y0.x, y0.y, y0.z, y0.w};
            acc = __builtin_amdgcn_mfma_f32_16x16x32_bf16(b0, a0, acc, 0, 0, 0);
            acc = __builtin_amdgcn_mfma_f32_16x16x32_bf16(b1, a1, acc, 0, 0, 0);
            y[nt] += acc;
        }
    }
    float s1 = 0.f, s2 = 0.f;
#pragma unroll
    for (int nt = 0; nt < 2; ++nt)
#pragma unroll
        for (int j = 0; j < 4; ++j) { s1 += y[nt][j]; s2 += y[nt][j] * y[nt][j]; }
    s1 += bperm_f(lane ^ 16, s1); s1 += bperm_f(lane ^ 32, s1); s2 += bperm_f(lane ^ 16, s2); s2 += bperm_f(lane ^ 32, s2);
    __syncthreads();
    if (q == 0) { red[ch * 64 + t] = s1; red[128 + ch * 64 + t] = s2; }
    __syncthreads();
    const float mean = (red[t] + red[64 + t]) * (1.0f / 64.0f), var = fmaxf((red[128 + t] + red[192 + t]) * (1.0f / 64.0f) - mean * mean, 0.f), rstd = rsqrtf(var + 64e-5f);
    const float bon = p.bonus[(size_t)g * 12 + hh] + p.bonus[((size_t)M + g) * 12 + hh];
    const float* gng = p.rw_gn_g + (size_t)l * 768 + hh * 64; const float* gnb = p.rw_gn_b + (size_t)l * 768 + hh * 64;
    const size_t coff = ((size_t)(bh * (TT / 64) + ci) * 64 + t) * 64;
#pragma unroll
    for (int nt = 0; nt < 2; ++nt) {
        const int c = 32 * ch + 16 * nt + 4 * q;
        const float4 gg = *(const float4*)(gng + c), gb = *(const float4*)(gnb + c);
        const uint2 vv = *(const uint2*)(p.rw_vb + coff + c), gt = *(const uint2*)(p.rw_gb + coff + c);
        const float o0 = ((y[nt][0] - mean) * rstd * gg.x + gb.x + bon * bfl(vv.x)) * bfl(gt.x), o1 = ((y[nt][1] - mean) * rstd * gg.y + gb.y + bon * bfh(vv.x)) * bfh(gt.x);
        const float o2 = ((y[nt][2] - mean) * rstd * gg.z + gb.z + bon * bfl(vv.y)) * bfl(gt.y), o3 = ((y[nt][3] - mean) * rstd * gg.w + gb.w + bon * bfh(vv.y)) * bfh(gt.y);
        uint2 o; o.x = pg8::cvt_pk_bf16(o0, o1); o.y = pg8::cvt_pk_bf16(o2, o3);
        *(uint2*)(p.mix + (size_t)g * D + 1280 + hh * 64 + c) = o;
    }
}

typedef short attn_bf16x8 __attribute__((ext_vector_type(8)));
typedef float attn_f32x4 __attribute__((ext_vector_type(4)));
constexpr int ATT_LAT = NB * 12 * 64 * 4, ATT_CTX = NB * 12 * (LC / 16), ATT_TASKS = ATT_LAT + ATT_CTX;
__device__ __forceinline__ attn_bf16x8 ld_frag16(const bf16_t* ptr) { return *(const attn_bf16x8*)ptr; }
__device__ __forceinline__ attn_bf16x8 ld_frag8x2(const bf16_t* p0, const bf16_t* p1) {
    const uint2 a = *(const uint2*)p0, b = *(const uint2*)p1; uint4 r; r.x = a.x; r.y = a.y; r.z = b.x; r.w = b.y; return *(const attn_bf16x8*)&r; }
struct AttnFrag { attn_bf16x8 k[2][2]; attn_bf16x8 v[4]; };
__device__ __forceinline__ void attn_load(AttnFrag& F, const bf16_t* Kh  , const bf16_t* Vh  , int s0  , int qi, int q) {
#pragma unroll
    for (int t = 0; t < 2; ++t)
#pragma unroll
        for (int ks = 0; ks < 2; ++ks) F.k[t][ks] = ld_frag16(Kh + ((size_t)(((s0 >> 4) + t) * 2 + ks) * 16 + qi) * 32 + 8 * q);
#pragma unroll
    for (int db = 0; db < 4; ++db) F.v[db] = ld_frag16(Vh + ((size_t)(s0 >> 5) * 64 + 16 * db + qi) * 32 + 8 * q);
}
__device__ __forceinline__ void attn_compute(const AttnFrag& F, const attn_bf16x8 (&qf)[2], int lane, float& m, float& l, attn_f32x4 (&oacc)[4],
                                             bool win, const float* brow  , unsigned vmask  , const int (&boff)[8]) {
    attn_f32x4 st[2];
#pragma unroll
    for (int t = 0; t < 2; ++t) {
        attn_f32x4 z4 = {0.f, 0.f, 0.f, 0.f};
        z4 = __builtin_amdgcn_mfma_f32_16x16x32_bf16(F.k[t][0], qf[0], z4, 0, 0, 0);
        st[t] = __builtin_amdgcn_mfma_f32_16x16x32_bf16(F.k[t][1], qf[1], z4, 0, 0, 0);
    }
    float sc[8]; float mx = -1e30f;
#pragma unroll
    for (int i = 0; i < 8; ++i) {
        float s = st[i >> 2][i & 3] * 0.18033688011112042f;
        if (win) s = ((vmask >> i) & 1u) ? s + brow[boff[i]] : -1e30f;
        sc[i] = s; mx = fmaxf(mx, s);
    }
    mx = fmaxf(mx, bperm_f(lane ^ 16, mx)); mx = fmaxf(mx, bperm_f(lane ^ 32, mx));
    if (__any(mx > m)) {
        const float mn = fmaxf(m, mx), alpha = __builtin_amdgcn_exp2f(m - mn);
        l *= alpha; m = mn;
#pragma unroll
        for (int db = 0; db < 4; ++db) oacc[db] *= alpha;
    }
    float ps = 0.f; float pv[8];
#pragma unroll
    for (int i = 0; i < 8; ++i) { pv[i] = __builtin_amdgcn_exp2f(sc[i] - m); ps += pv[i]; }
    l += ps;
    uint4 pk; pk.x = pg8::cvt_pk_bf16(pv[0], pv[1]); pk.y = pg8::cvt_pk_bf16(pv[2], pv[3]); pk.z = pg8::cvt_pk_bf16(pv[4], pv[5]); pk.w = pg8::cvt_pk_bf16(pv[6], pv[7]);
    const attn_bf16x8 pb = *(const attn_bf16x8*)&pk;
#pragma unroll
    for (int db = 0; db < 4; ++db) oacc[db] = __builtin_amdgcn_mfma_f32_16x16x32_bf16(F.v[db], pb, oacc[db], 0, 0, 0);
}
constexpr int ATT_LAT2 = NB * 12 * 64 * 2, ATT_CTX2 = NB * 12 * (LC / 32), ATT_TASKS2 = ATT_LAT2 + ATT_CTX2;
__device__ __forceinline__ void attn_task2(const Params& p, const float* rpbs  , int task) {
    const int lane = otid() & 63, qi = lane & 15, q = lane >> 4;
    const bool lat = task < ATT_LAT2;
    int bh, qrow = 0, qp;
    if (lat) { bh = task >> 7; const int rem = task & 127; qrow = rem >> 1; qp = rem & 1; }
    else { const int t2 = task - ATT_LAT2; bh = t2 >> 3; qp = t2 & 7; }
    const int b = bh / 12, hh = bh % 12;
    const bf16_t* Kh = p.Ka + (size_t)bh * TT * 64; const bf16_t* Vh = p.Vt + (size_t)bh * 64 * TT;
    int sq[2]; attn_bf16x8 qa[2][2], qr[2][2];
#pragma unroll
    for (int u = 0; u < 2; ++u) {
        sq[u] = lat ? LC + qrow * 64 + (2 * qp + u) * 16 + qi : (2 * qp + u) * 16 + qi;
        const bf16_t* qp0 = p.Qa + ((size_t)bh * TT + sq[u]) * 64 + 8 * q; qa[u][0] = ld_frag16(qp0); qa[u][1] = ld_frag16(qp0 + 32); qr[u][0] = qa[u][0]; qr[u][1] = qa[u][1];
        if (lat) { const bf16_t* qp1 = p.Qr + ((size_t)bh * L + (sq[u] - LC)) * 64 + 8 * q; qr[u][0] = ld_frag16(qp1); qr[u][1] = ld_frag16(qp1 + 32); }
    }
    const int krow0 = min(max(qrow - 4, 0), 56);
    bool need0[2], need1[2]; unsigned vm0[2], vm1[2]; int boff[2][8];
#pragma unroll
    for (int u = 0; u < 2; ++u) { const int qb = 2 * qp + u, qc = qb * 16 + qi, kcol0 = min(max(qc - 8, 0), 48);
        const int clo = min(max(qb * 16 - 8, 0), 48), chi = min(max(qb * 16 + 7, 0), 48) + 16; need0[u] = clo < 32; need1[u] = chi > 32; vm0[u] = 0u; vm1[u] = 0u;
#pragma unroll
        for (int i = 0; i < 8; ++i) { const int kc = 16 * (i >> 2) + 4 * q + (i & 3); boff[u][i] = kc - qc + 15; vm0[u] |= ((unsigned)(kc - kcol0) < 16u ? 1u : 0u) << i; vm1[u] |= ((unsigned)(kc + 32 - kcol0) < 16u ? 1u : 0u) << i; } }
    const bool cb0 = need0[0] || need0[1], cb1 = need1[0] || need1[1]; const int ncb = (cb0 && cb1) ? 2 : 1, cbo = cb0 ? 0 : 1;
    const int nsteps = lat ? 8 + 8 * ncb : 8;
    float m[2] = {-1e30f, -1e30f}, l[2] = {0.f, 0.f}; attn_f32x4 oacc[2][4];
#pragma unroll
    for (int u = 0; u < 2; ++u)
#pragma unroll
        for (int db = 0; db < 4; ++db) oacc[u][db] = (attn_f32x4){0.f, 0.f, 0.f, 0.f};
#define ATT_S0(s, s0v, krv, cbv) do { if ((s) < 8) { s0v = (s) * 32; krv = 0; cbv = 0; } else { const int _w = (s) - 8; krv = ncb == 2 ? (_w >> 1) : _w; cbv = ncb == 2 ? (_w & 1) : cbo; s0v = LC + (krow0 + krv) * 64 + cbv * 32; } } while (0)
#define ATT_LOAD(F, s) do { int _s0, _kr, _cb; ATT_S0((s), _s0, _kr, _cb); attn_load(F, Kh, Vh, _s0, qi, q); } while (0)
#define ATT_COMP(F, s) do { int _s0, _kr, _cb; ATT_S0((s), _s0, _kr, _cb); const bool _w = (s) >= 8; const float* _br = rpbs + hh * 465 + (krow0 + _kr - qrow + 7) * 31; \
        _Pragma("unroll") for (int u = 0; u < 2; ++u) if (!_w || (_cb == 0 ? need0[u] : need1[u])) attn_compute(F, _w ? qr[u] : qa[u], lane, m[u], l[u], oacc[u], _w, _br + _cb * 32, _cb ? vm1[u] : vm0[u], boff[u]); } while (0)
    AttnFrag FA, FB;
    ATT_LOAD(FA, 0);
    for (int s = 0; s < nsteps; s += 2) {
        ATT_LOAD(FB, s + 1);
        ATT_COMP(FA, s);
        if (s + 2 < nsteps) ATT_LOAD(FA, s + 2);
        ATT_COMP(FB, s + 1);
    }
#undef ATT_S0
#undef ATT_LOAD
#undef ATT_COMP
#pragma unroll
    for (int u = 0; u < 2; ++u) {
        float lt = l[u]; lt += bperm_f(lane ^ 16, lt); lt += bperm_f(lane ^ 32, lt);
        const float rinv = 1.0f / lt;
        bf16_t* op = p.mix + (size_t)(b * TT + sq[u]) * D + 512 + hh * 64 + 4 * q;
#pragma unroll
        for (int db = 0; db < 4; ++db) { uint2 w; w.x = pg8::cvt_pk_bf16(oacc[u][db][0] * rinv, oacc[u][db][1] * rinv); w.y = pg8::cvt_pk_bf16(oacc[u][db][2] * rinv, oacc[u][db][3] * rinv); *(uint2*)(op + 16 * db) = w; }
    }
}

constexpr int RT_LD = 2052;
__device__ __forceinline__ void phase_router(const Params& p, unsigned char* Lb, int l, int bid, int nb) {
    const int tix = otid(), wid = tix >> 6, lane = tix & 63;
    float* At = (float*)Lb;
    float* Pp = At + 16 * RT_LD;
    int* ent = (int*)(Pp + 2 * 16 * 64);
    int* lcnt = ent + 480 * 4; int* lbase = lcnt + 64;
    const float* gam = p.norm2_g + (size_t)l * D;
    __syncthreads();
    if (tix < 64) lcnt[tix] = 0;
    int nloc = 0;
    const bool latonly = (l == 1);
    for (int tile = bid; tile < (latonly ? NB * L / 16 : M / 16); tile += nb, ++nloc) {
        const int g0 = latonly ? (tile >> 8) * TT + LC + (tile & 255) * 16 : tile * 16;
        __syncthreads();
#pragma unroll 1
        for (int rr = 0; rr < 2; ++rr) {
            const int r = 2 * wid + rr, g = g0 + r;
            const float* xr = p.xcur + (size_t)g * D;
            float4 v[8]; float ss = 0.f;
#pragma unroll
            for (int i = 0; i < 8; ++i) { v[i] = *(const float4*)(xr + (i * 64 + lane) * 4); ss += v[i].x * v[i].x + v[i].y * v[i].y + v[i].z * v[i].z + v[i].w * v[i].w; }
            ss = wave_sum(ss);
            const float rs = rsqrtf(ss * (1.0f / D) + 1e-6f);
            const float* mrow = p.mod + (size_t)(l * 5 + modrow(g)) * 6 * D; const float* sh = mrow + 3 * D; const float* sc = mrow + 4 * D;
#pragma unroll
            for (int i = 0; i < 8; ++i) {
                const int d = (i * 64 + lane) * 4;
                const float4 gg = *(const float4*)(gam + d), s4 = *(const float4*)(sh + d), c4 = *(const float4*)(sc + d);
                float4 o;
                o.x = v[i].x * rs * gg.x * (1.0f + c4.x) + s4.x; o.y = v[i].y * rs * gg.y * (1.0f + c4.y) + s4.y; o.z = v[i].z * rs * gg.z * (1.0f + c4.z) + s4.z; o.w = v[i].w * rs * gg.w * (1.0f + c4.w) + s4.w;
                uint2 pk; pk.x = pg8::cvt_pk_bf16(o.x, o.y); pk.y = pg8::cvt_pk_bf16(o.z, o.w);
                *(uint2*)(p.h + (size_t)g * D + d) = pk;
                *(float4*)(At + r * RT_LD + d) = o;
            }
        }
        __syncthreads();
        {
            const int nt = wid & 3, kh = wid >> 2, fr = lane & 15, q = lane >> 4;
            pg8::f32x4 acc = {0.f, 0.f, 0.f, 0.f};
            const float* wp = p.Wr + (((size_t)(l * 128 + kh * 64) * 4 + nt) * 64 + lane) * 4;
            const float* ap = At + fr * RT_LD + kh * 1024 + 4 * q;
#pragma unroll 16
            for (int j = 0; j < 64; ++j) {
                const float4 a4 = *(const float4*)(ap + 16 * j), b4 = *(const float4*)(wp + (size_t)j * 1024);
                acc = __builtin_amdgcn_mfma_f32_16x16x4f32(a4.x, b4.x, acc, 0, 0, 0); acc = __builtin_amdgcn_mfma_f32_16x16x4f32(a4.y, b4.y, acc, 0, 0, 0);
                acc = __builtin_amdgcn_mfma_f32_16x16x4f32(a4.z, b4.z, acc, 0, 0, 0); acc = __builtin_amdgcn_mfma_f32_16x16x4f32(a4.w, b4.w, acc, 0, 0, 0);
            }
#pragma unroll
            for (int jj = 0; jj < 4; ++jj) Pp[(kh * 16 + 4 * q + jj) * 64 + 16 * nt + fr] = acc[jj];
        }
        __syncthreads();
#pragma unroll 1
        for (int rr = 0; rr < 2; ++rr) {
            const int r = 2 * wid + rr, g = g0 + r;
            const float score = 1.0f / (1.0f + expf(-(Pp[r * 64 + lane] + Pp[(16 + r) * 64 + lane])));
            float val = score + p.router_bias[l * NEXP + lane];
            int myidx[TOPK]; float mysc[TOPK]; float tot = 0.f;
#pragma unroll
            for (int k = 0; k < TOPK; ++k) {
                float bv = val; int bi = lane;
#pragma unroll
                for (int o = 32; o >= 1; o >>= 1) { const float ov = bperm_f(lane ^ o, bv); const int oi = bperm_i(lane ^ o, bi); if (ov > bv || (ov == bv && oi < bi)) { bv = ov; bi = oi; } }
                const float sc_k = bperm_f(bi, score);
                myidx[k] = bi; mysc[k] = sc_k; tot += sc_k;
                if (lane == bi) val = -INFINITY;
            }
            if (lane < TOPK) {
                int e = myidx[0]; float w = mysc[0];
#pragma unroll
                for (int k = 1; k < TOPK; ++k) if (lane == k) { e = myidx[k]; w = mysc[k]; }
                w = w / tot * 2.5f;
                p.sel[g * TOPK + lane] = e; p.selw[g * TOPK + lane] = w;
                const int lp = atomicAdd(&lcnt[e], 1);
                int* en = ent + ((nloc * 16 + r) * TOPK + lane) * 4; en[0] = e; en[1] = __float_as_int(w); en[2] = g * 8 + lane; en[3] = lp;
            }
        }
    }
    __syncthreads();
    if (tix < 64) lbase[tix] = lcnt[tix] ? atomicAdd(p.cnt + l * NEXP + tix, lcnt[tix]) : 0;
    __syncthreads();
    for (int i = tix; i < nloc * 16 * TOPK; i += NT) {
        const int e = ent[i * 4], gk = ent[i * 4 + 2], pos = lbase[e] + ent[i * 4 + 3];
        p.ltok[(size_t)e * LCAP + pos] = gk >> 3; p.lw[(size_t)e * LCAP + pos] = __int_as_float(ent[i * 4 + 1]); p.tpos[(gk >> 3) * TOPK + (gk & 7)] = pos;
    }
}

constexpr int MAXU = 17;
__device__ __forceinline__ void moe_tables(const Params& p, LAS int* tab, int lc) {
    const int tix = otid();
    __syncthreads();
    if (tix == 0) { int ts = 0, of = 0;
        for (int e = 0; e < NEXP; ++e) { const int c = __hip_atomic_load(p.cnt + lc * NEXP + e, __ATOMIC_RELAXED, __HIP_MEMORY_SCOPE_AGENT); tab[e] = ts; tab[66 + e] = of; tab[132 + e] = c; ts += (c + 255) / 256; of += (c + 255) / 256 * 256; }
        tab[NEXP] = ts; tab[66 + NEXP] = of; ts += M / 256; of += M;
        tab[65] = ts; tab[66 + 65] = of; }
    __syncthreads();
}
struct MoeSched {
    const LAS int* tab; const LAS unsigned* rowtab; int NPN, G, c, total; unsigned rowbytes; const char* Bt; const char* Bte  ; size_t bstride;
    __device__ __forceinline__ bool next(int i, pg8::Unit& u) const {
        const int Lq = i * G + c; if (Lq >= total) return false;
        const int rt = Lq / NPN; u.pn = Lq - rt * NPN;
        int lo = 0, hi = 64;
        while (lo < hi) { const int mid = (lo + hi + 1) >> 1; if (tab[mid] <= rt) lo = mid; else hi = mid - 1; }
        u.e = lo; u.pm = rt - tab[lo]; u.ord = i; return true;
    }
    __device__ __forceinline__ unsigned arow(const pg8::Unit& u, int r) const { return rowtab[u.ord * 256 + r] * rowbytes; }
    __device__ __forceinline__ const char* bptr(const pg8::Unit& u) const { return (u.e < CV_EEARLY ? Bte : Bt) + (size_t)u.e * bstride + (size_t)u.pn * 256 * rowbytes; }
};
struct EpiGU {
    bf16_t* U; const LAS int* tab;
    __device__ __forceinline__ void operator()(const pg8::f32x4 (&acc)[2][2][4][2], const pg8::Unit& u, int wr, int wc, int fr, int fq) const {
        const int cn = (u.e < NEXP ? tab[132 + u.e] : M), off = tab[66 + u.e], col0 = u.pn * 128 + wc * 32 + 8 * fq;
#pragma unroll
        for (int ai = 0; ai < 2; ++ai)
#pragma unroll
            for (int m = 0; m < 4; ++m) { const int i = u.pm * 256 + ai * 128 + wr * 64 + m * 16 + fr;
                if (i < cn) { float o[8];
#pragma unroll
                    for (int n = 0; n < 2; ++n)
#pragma unroll
                        for (int j = 0; j < 4; ++j) { const float gv = acc[ai][0][m][n][j], uv = acc[ai][1][m][n][j]; o[n * 4 + j] = gv * __builtin_amdgcn_rcpf(1.0f + __expf(-gv)) * uv; }
                    pg8::u32x4 w; w.x = pg8::cvt_pk_bf16(o[0], o[1]); w.y = pg8::cvt_pk_bf16(o[2], o[3]); w.z = pg8::cvt_pk_bf16(o[4], o[5]); w.w = pg8::cvt_pk_bf16(o[6], o[7]);
                    *(pg8::u32x4*)(U + (size_t)(off + i) * DE + col0) = w; } }
    }
};
struct EpiDown {
    bf16_t* Y; const LAS int* tab;
    __device__ __forceinline__ void operator()(const pg8::f32x4 (&acc)[2][2][4][2], const pg8::Unit& u, int wr, int wc, int fr, int fq) const {
        const int cn = (u.e < NEXP ? tab[132 + u.e] : M), off = tab[66 + u.e], col0 = u.pn * 256 + wc * 32 + 8 * fq;
#pragma unroll
        for (int ai = 0; ai < 2; ++ai)
#pragma unroll
            for (int m = 0; m < 4; ++m) { const int i = u.pm * 256 + ai * 128 + wr * 64 + m * 16 + fr;
                if (i < cn) { bf16_t* rowp = Y + (size_t)(off + i) * D + col0;
#pragma unroll
                    for (int bj = 0; bj < 2; ++bj) { const pg8::f32x4 v0 = acc[ai][bj][m][0], v1 = acc[ai][bj][m][1];
                        pg8::u32x4 w; w.x = pg8::cvt_pk_bf16(v0[0], v0[1]); w.y = pg8::cvt_pk_bf16(v0[2], v0[3]); w.z = pg8::cvt_pk_bf16(v1[0], v1[1]); w.w = pg8::cvt_pk_bf16(v1[2], v1[3]);
                        *(pg8::u32x4*)(rowp + bj * 128) = w; } } }
    }
};
template <bool DOWN>
__device__ __forceinline__ void phase_gemm_moe(const Params& p, LAS unsigned char* stage, LAS int* tab, LAS unsigned* rowtab, int l, int bid, int nb) {
    const int tix = otid();
    moe_tables(p, tab, l);
    MoeSched S; S.tab = tab; S.rowtab = rowtab; S.NPN = DOWN ? 8 : 4; S.total = tab[65] * S.NPN; S.G = l == 0 ? gemm_wgs(S.total, nb) : nb; S.c = (S.G % 8 == 0) ? (bid % 8) * (S.G / 8) + bid / 8 : bid;
    const bool gemm_wg = bid < S.G;
    S.rowbytes = DOWN ? DE * 2 : D * 2; S.Bt = DOWN ? (const char*)p.WdnT : (const char*)p.WguT; S.Bte = l == 0 ? S.Bt : (DOWN ? (const char*)p.WdnE : (const char*)p.WguE); S.bstride = DOWN ? (size_t)D * DE * 2 : (size_t)1024 * D * 2;
    if (gemm_wg) for (int i = 0; i < MAXU; ++i) { pg8::Unit u; if (!S.next(i, u)) break;
        if (tix < 256) { const int idx = u.pm * 256 + tix, cn = (u.e < NEXP ? tab[132 + u.e] : M); unsigned v;
            if (DOWN) v = (unsigned)(tab[66 + u.e] + idx); else v = idx < cn ? (u.e < NEXP ? (unsigned)p.ltok[(size_t)u.e * LCAP + idx] : (unsigned)idx) : (unsigned)M;
            rowtab[i * 256 + tix] = v; } }
    __syncthreads();
    if (gemm_wg) {
        if (DOWN) { EpiDown E; E.Y = p.Y; E.tab = tab; pg8::gemm_phase<true>(stage, (const char*)p.U, DE, S, E); }
        else { EpiGU E; E.U = p.U; E.tab = tab; pg8::gemm_phase<true>(stage, (const char*)p.h, D, S, E); } }
    if (l == 0) convert_until(p, (float*)(unsigned char*)stage, p.cvc + (DOWN ? 3 : 2), S.G, gemm_wg);
}
__device__ __forceinline__ void phase_final(const Params& p, LAS int* tab, int bid, int nb) {
    moe_tables(p, tab, 1);
    const int tix = otid();
    const int wid = tix >> 6, lane = tix & 63;
    float4 vn[8]; CombPre cn;
    { const int r = bid * 8 + wid; if (r < NB * L) { const int g = (r / L) * TT + LC + r % L; const float* xr = p.xcur + (size_t)g * D;
#pragma unroll
        for (int i = 0; i < 8; ++i) vn[i] = *(const float4*)(xr + (i * 64 + lane) * 4);
        comb_prefetch(p, g, cn); } }
    for (int r = bid * 8 + wid; r < NB * L; r += nb * 8) {
        const int b = r / L, t = r % L;
        float4 v[8]; float ss = 0.f; CombPre cc = cn;
#pragma unroll
        for (int i = 0; i < 8; ++i) v[i] = vn[i];
        { const int rn = r + nb * 8; if (rn < NB * L) { const int gn = (rn / L) * TT + LC + rn % L; const float* xr = p.xcur + (size_t)gn * D;
#pragma unroll
            for (int i = 0; i < 8; ++i) vn[i] = *(const float4*)(xr + (i * 64 + lane) * 4);
            comb_prefetch(p, gn, cn); } }
        moe_combine_row(p, tab, 1, b * TT + LC + t, lane, cc, v);
#pragma unroll
        for (int i = 0; i < 8; ++i) ss += v[i].x * v[i].x + v[i].y * v[i].y + v[i].z * v[i].z + v[i].w * v[i].w;
        ss = wave_sum(ss); const float rs = rsqrtf(ss * (1.0f / D) + 1e-6f);
#pragma unroll
        for (int i = 0; i < 8; ++i) { const int d = (i * 64 + lane) * 4; const float4 gg = *(const float4*)(p.final_g + d);
            float4 o; o.x = v[i].x * rs * gg.x; o.y = v[i].y * rs * gg.y; o.z = v[i].z * rs * gg.z; o.w = v[i].w * rs * gg.w;
            *(float4*)(p.out + (size_t)r * D + d) = o; }
    }
}


constexpr int LDS_BYTES = 160 * 1024;
extern __shared__ __attribute__((aligned(16))) unsigned char dyn_lds_raw[];
__device__ __forceinline__ LAS unsigned char* lds_las(unsigned off) { asm volatile("" : "+s"(off)); return (LAS unsigned char*)(unsigned long)off; }
__device__ __forceinline__ int obid() { int b = blockIdx.x; asm volatile("" : "+s"(b)); return b; }
__device__ __forceinline__ int onb() { int b = gridDim.x; asm volatile("" : "+s"(b)); return b; }
typedef const __attribute__((address_space(4))) Params* KParams;
__device__ __forceinline__ KParams kp_opaque(KParams q) { asm volatile("" : "+s"(q)); return q; }
#define PPH (*(const Params*)kp_opaque(kp))
__global__ __launch_bounds__(512, 2) void mega(Params p_byval) {
    const KParams kp = (KParams)__builtin_amdgcn_kernarg_segment_ptr();
    if (threadIdx.x == 0) *(uint4*)dyn_lds_raw = make_uint4(0u, 0u, 0u, 0u);
    __syncthreads();
    XcdBarrier bar = xcd_barrier_post(PPH.bar, (volatile LAS unsigned*)dyn_lds_raw);
    const unsigned lds0 = (unsigned)(unsigned long long)(LAS unsigned char*)dyn_lds_raw;
#define LDSB ((unsigned char*)lds_las(lds0 + 1024u))
#define lds ((float*)LDSB)
#define stage (lds_las(lds0 + 1024u))
#define tab ((LAS int*)lds_las(lds0 + 1024u + 131072u))
#define rowtab ((LAS unsigned*)lds_las(lds0 + 1024u + 131072u + 1024u))
#define bid (obid())
#define nb (onb())
    phase_copy(PPH, bid, nb);
    phase_router_w(PPH, bid, nb);
    phase_lora_w(PPH, bid, nb);
    phase_adaln(PPH, lds, bid, nb);
    xcd_barrier(bar);
#pragma unroll 1
    for (int l = 0; l < 2; ++l) {
        phase_norm<0>(PPH, lds, tab, l, bid, nb);
        { int first = 0; if (l == 1) { first = __hip_atomic_load(PPH.cvc, __ATOMIC_RELAXED, __HIP_MEMORY_SCOPE_AGENT); first = first < CV_EARLY ? first : CV_EARLY; }
          phase_convert(PPH, lds, l, first, bid, nb); }
        xcd_barrier(bar);
        phase_gemm_in(PPH, stage, l, bid, nb);
        xcd_barrier(bar);
        phase_prep(PPH, lds, l, bid, nb);
        { const int b1 = obid(), n1 = onb(); RwPre pre; rwkv_prefetch(PPH, l, b1, otid(), pre); for (int unit = b1; unit < RW_UNITS; unit += n1) rwkv_unit(PPH, LDSB, l, unit, unit + n1, pre); }
        xcd_barrier(bar);
        { const int tix = otid(), wid = __builtin_amdgcn_readfirstlane(tix >> 6); const int bid_l = obid(), nb_l = onb();
          float* const rp_l = lds + 32768;
          { const Params& pr = PPH; for (int i = tix; i < 12 * 465; i += NT) rp_l[i] = pr.rpb[(size_t)l * 12 * 465 + i] * 1.4426950408889634f; }
          __syncthreads();
          if (bid_l < 96) rwkv_chain(PPH, LDSB, bid_l);
          { const int wt = nb_l > 96 ? 96 + 2 * (nb_l - 96) : nb_l, w0 = nb_l > 96 ? (bid_l < 96 ? bid_l : 96 + 2 * (bid_l - 96)) : bid_l, w1 = nb_l > 96 ? (bid_l < 96 ? bid_l + 1 : 96 + 2 * (bid_l - 95)) : bid_l + 1;
            const int lo = (int)((long)w0 * ATT_LAT2 / wt), hi = (int)((long)w1 * ATT_LAT2 / wt); for (int task = lo + wid; task < hi; task += 8) attn_task2(PPH, rp_l, task); }
          if (l == 0) for (int task = ATT_LAT2 + bid_l * 8 + wid; task < ATT_TASKS2; task += nb_l * 8) attn_task2(PPH, rp_l, task); }
        xcd_barrier(bar);
        { const int b1 = obid(), n1 = onb(); for (int u3 = b1; u3 < RW_UNITS / 2; u3 += n1) if (l == 0 || u3 % (TT / 64) >= 4) rwkv_out(PPH, LDSB, l, u3); }
        xcd_barrier(bar);
        phase_gemm_out(PPH, stage, l, bid, nb);
        xcd_barrier(bar);
        phase_router(PPH, LDSB, l, bid, nb);
        xcd_barrier(bar);
        phase_gemm_moe<false>(PPH, stage, tab, rowtab, l, bid, nb);
        xcd_barrier(bar);
        phase_gemm_moe<true>(PPH, stage, tab, rowtab, l, bid, nb);
        xcd_barrier(bar);
    }
    phase_final(PPH, tab, bid, nb);
}

#undef bid
#undef nb
#undef LDSB
#undef lds
#undef stage
#undef tab
#undef rowtab
extern "C" void kernel_launch(void* const* d_in, const int* in_sizes, int n_in, void* d_out, int out_size, void* d_ws, size_t ws_size, hipStream_t stream) {
    static int grid = 0;
    if (grid == 0) {
        int dev = 0, cus = 0, per_cu = 0;
        if (hipGetDevice(&dev) != hipSuccess || hipDeviceGetAttribute(&cus, hipDeviceAttributeMultiprocessorCount, dev) != hipSuccess) { grid = -1; return; }
        if (hipFuncSetAttribute((const void*)mega, hipFuncAttributeMaxDynamicSharedMemorySize, LDS_BYTES) != hipSuccess) { grid = -1; return; }
        if (hipOccupancyMaxActiveBlocksPerMultiprocessor(&per_cu, (const void*)mega, NT, LDS_BYTES) != hipSuccess || per_cu < 1) { grid = -1; return; }
        (void)hipGetLastError();
        grid = cus;
        if (grid < 96) { grid = -1; return; }
    }
    if (grid < 0) return;
    Params p{};
    const float** pf = (const float**)&p;
    for (int i = 0; i < 32; ++i) pf[i] = (const float*)d_in[i];
    p.out = (float*)d_out;
    char* w = (char*)d_ws; size_t o = 0;
    auto take = [&](size_t bytes) { char* r = w + o; o += (bytes + 255) & ~(size_t)255; return r; };
    p.bar = (unsigned*)take(XCD_BAR_WORDS * 4 + 2 * NEXP * 4 + 64);
    p.cnt = (int*)(p.bar + XCD_BAR_WORDS); p.cvc = p.cnt + 2 * NEXP;
    p.mod = (float*)take((size_t)2 * 5 * 6 * D * 4);
    p.xcur = (float*)take((size_t)M * D * 4);
    p.h = (bf16_t*)take((size_t)(M + 1) * D * 2);
    p.mix = (bf16_t*)take((size_t)M * D * 2);
    p.z = (bf16_t*)take((size_t)M * ZLD * 2);
    p.Y = p.z;
    p.streams = (float*)take((size_t)RW_UNITS * 4096 * 16);
    p.bonus = (float*)take((size_t)2 * M * 12 * 4);
    { char* sb = (char*)p.streams; const size_t U = (size_t)RW_UNITS * 4096;
      p.rw_P = (bf16_t*)sb; sb += U * 2; p.rw_Ry = (bf16_t*)sb; sb += U * 2; p.rw_H0 = (bf16_t*)sb; sb += U * 2; p.rw_QT = (float*)sb; sb += U * 4; p.rw_Y0 = (float*)sb; sb += U * 4;
      p.rw_vb = (bf16_t*)sb; sb += U; p.rw_gb = (bf16_t*)sb; sb += U; }
    p.tpos = (int*)take((size_t)M * TOPK * 4);
    p.sel = (int*)take((size_t)M * TOPK * 4);
    p.selw = (float*)take((size_t)M * TOPK * 4);
    p.ltok = (int*)take((size_t)NEXP * LCAP * 4);
    p.lw = (float*)take((size_t)NEXP * LCAP * 4);
    p.U = (bf16_t*)take((size_t)(UROWS + M) * DE * 2);
    p.WinT = (bf16_t*)take((size_t)ZLD * D * 2);
    p.WoutT = (bf16_t*)take((size_t)2 * D * D * 2);
    p.WguT = (bf16_t*)take((size_t)65 * 1024 * D * 2); p.WguE = (bf16_t*)take((size_t)CV_EEARLY * 1024 * D * 2);
    p.WdnT = (bf16_t*)take((size_t)65 * D * DE * 2); p.WdnE = (bf16_t*)take((size_t)CV_EEARLY * D * DE * 2);
    p.Qa = (bf16_t*)take((size_t)NB * 12 * TT * 64 * 2);
    p.Qr = (bf16_t*)take((size_t)NB * 12 * L * 64 * 2);
    p.Ka = (bf16_t*)take((size_t)NB * 12 * TT * 64 * 2);
    p.Vt = (bf16_t*)take((size_t)NB * 12 * 64 * TT * 2);
    p.Wr = (float*)take((size_t)2 * D * NEXP * 4);
    p.Lwa = (bf16_t*)take((size_t)2 * 2 * 12 * 2 * 64 * 72 * 2);
    p.Lg = (bf16_t*)take((size_t)2 * 12 * 64 * 104 * 2);
    if (o > ws_size) return;
    if (hipMemsetAsync(p.bar, 0, XCD_BAR_WORDS * sizeof(unsigned) + 2 * NEXP * 4 + 64, stream) != hipSuccess) return;
    hipLaunchKernelGGL(mega, dim3(grid), dim3(NT), LDS_BYTES, stream, p);
}
```

```cpp
#include <hip/hip_runtime.h>
#include <stdint.h>

typedef unsigned short bf16_t;

constexpr int D = 2048, NB = 4, L = 4096, LC = 256, TT = L + LC, M = NB * TT;
constexpr int IN_COLS = 6432, ZLD = 6656;
constexpr int ZA = 0, ZB = 1536, ZC = 3840, RWC = 2592;
constexpr int NEXP = 64, TOPK = 6, DE = 512;
constexpr int CNT_STRIDE = 32;
constexpr int NSTR = 10, SSTR = NSTR * 768;
constexpr int LCAP = M;
constexpr int UROWS = M * TOPK + NEXP * 256;
constexpr int NT = 512;

struct Params {
    const float *x, *c, *ctx, *c_ctx, *norm1_g, *norm2_g, *ada_w, *ada_b, *w_in, *conv_w, *rpb, *rw_shift, *rw_w0, *rw_w_up, *rw_a0, *rw_a_up, *rw_g_up,
        *rw_k_k, *rw_k_a, *rw_r_k, *rw_gn_g, *rw_gn_b, *w_out, *router_w, *router_bias, *exp_gate, *exp_up, *exp_down, *sh_gate, *sh_up, *sh_down, *final_g;
    float* out;
    unsigned* bar; float* mod; float* xcur; bf16_t* h; bf16_t* z; bf16_t* mix; float* streams; float* bonus; float* ydir;
    int* sel; float* selw; int* cnt; int* ltok; float* lw; bf16_t* U; bf16_t *WinT, *WoutT, *WguT, *WdnT; bf16_t *Qa, *Qr, *Ka, *Vt; bf16_t* Y; int* tpos; bf16_t *rw_P, *rw_Ry, *rw_H0, *rw_vb, *rw_gb; float *rw_QT, *rw_Y0; float* Wr; bf16_t *Lwa, *Lg; int* cvc; bf16_t *WguE, *WdnE;
};

__device__ __forceinline__ float bf2f(bf16_t b) { return __uint_as_float(((unsigned)b) << 16); }
__device__ __forceinline__ bf16_t f2bf(float f) { unsigned u = __float_as_uint(f); u += 0x7FFFu + ((u >> 16) & 1u); return (bf16_t)(u >> 16); }
__device__ __forceinline__ float sigmoidf_(float x) { return 1.0f / (1.0f + __expf(-x)); }
template <int CTRL, int RMASK> __device__ __forceinline__ float dpp_f(float old, float v) { return __int_as_float(__builtin_amdgcn_update_dpp(__float_as_int(old), __float_as_int(v), CTRL, RMASK, 0xF, false)); }
__device__ __forceinline__ float wave_sum(float v) {
    v += dpp_f<0xB1, 0xF>(0.f, v);
    v += dpp_f<0x4E, 0xF>(0.f, v);
    v += dpp_f<0x141, 0xF>(0.f, v);
    v += dpp_f<0x140, 0xF>(0.f, v);
    v += dpp_f<0x142, 0xA>(0.f, v);
    v += dpp_f<0x143, 0xC>(0.f, v);
    return __int_as_float(__builtin_amdgcn_readlane(__float_as_int(v), 63));
}
template <int CTRL> __device__ __forceinline__ void amax_dpp(float& bv, int& bi) {
    const float ov = dpp_f<CTRL, 0xF>(bv, bv); const int oi = __builtin_amdgcn_update_dpp(bi, bi, CTRL, 0xF, 0xF, false);
    if (ov > bv || (ov == bv && oi < bi)) { bv = ov; bi = oi; }
}
__device__ __forceinline__ float wave_max(float v) {
    v = fmaxf(v, dpp_f<0xB1, 0xF>(v, v));
    v = fmaxf(v, dpp_f<0x4E, 0xF>(v, v));
    v = fmaxf(v, dpp_f<0x141, 0xF>(v, v));
    v = fmaxf(v, dpp_f<0x140, 0xF>(v, v));
    v = fmaxf(v, dpp_f<0x142, 0xA>(v, v));
    v = fmaxf(v, dpp_f<0x143, 0xC>(v, v));
    return __int_as_float(__builtin_amdgcn_readlane(__float_as_int(v), 63));
}
__device__ __forceinline__ float bperm_f(int srclane, float v) { return __int_as_float(__builtin_amdgcn_ds_bpermute(srclane << 2, __float_as_int(v))); }
__device__ __forceinline__ int bperm_i(int srclane, int v) { return __builtin_amdgcn_ds_bpermute(srclane << 2, v); }
__device__ __forceinline__ int otid() { int t = threadIdx.x; asm volatile("" : "+v"(t)); return t; }
#define LOAD_FENCE8(a) asm volatile("" : "+v"((a)[0]), "+v"((a)[1]), "+v"((a)[2]), "+v"((a)[3]), "+v"((a)[4]), "+v"((a)[5]), "+v"((a)[6]), "+v"((a)[7]))
#define LOAD_FENCE4(a) asm volatile("" : "+v"((a)[0]), "+v"((a)[1]), "+v"((a)[2]), "+v"((a)[3]))
__device__ __forceinline__ void lds_barrier() { asm volatile("s_waitcnt lgkmcnt(0)" ::: "memory"); __builtin_amdgcn_s_barrier(); asm volatile("" ::: "memory"); }
__device__ __forceinline__ float bfl(unsigned u) { return __uint_as_float(u << 16); }
__device__ __forceinline__ float bfh(unsigned u) { return __uint_as_float(u & 0xffff0000u); }
__device__ __forceinline__ const float* in_row(const Params& p, int g) { const int b = g / TT, s = g - b * TT; return s < LC ? p.ctx + (size_t)(b * LC + s) * D : p.x + (size_t)(b * L + (s - LC)) * D; }
__device__ __forceinline__ int modrow(int g) { const int b = g / TT, s = g - b * TT; return s < LC ? 4 : b; }

#define XB_TMO      128
#define XB_XCNT(j)  (256  + 64 * (j))
#define XB_XSUB(j)  (1280 + 64 * (j))
#define XB_XGEN(j)  (2304 + 64 * (j))
#define XB_TOP      3328
#define XB_TOPGEN   3392
#define XCD_BAR_WORDS 3456
#define XB_SPIN_CAP (1u << 22)
#define LAS __attribute__((address_space(3)))

__device__ __forceinline__ unsigned xb_ld(unsigned* p)              { return __hip_atomic_load(p, __ATOMIC_RELAXED, __HIP_MEMORY_SCOPE_AGENT); }
__device__ __forceinline__ unsigned xb_add(unsigned* p, unsigned v) { return __hip_atomic_fetch_add(p, v, __ATOMIC_RELAXED, __HIP_MEMORY_SCOPE_AGENT); }
__device__ __forceinline__ unsigned xb_xcc_id() { return (unsigned)__builtin_amdgcn_s_getreg((3 << 11) | 20) & 0xFu; }
#define XB_SPIN(cond, bar) do { unsigned _sp = 0; while (cond) { __builtin_amdgcn_s_sleep(1); \
    if ((++_sp & 255u) == 0u) { if (xb_ld(&(bar)[XB_TMO])) break; if (_sp > XB_SPIN_CAP) { atomicAdd(&(bar)[XB_TMO], 1u); break; } } } } while (0)

struct XcdBarrier {
    unsigned* bar; unsigned x;
    volatile LAS unsigned* st;
};

__device__ __forceinline__ XcdBarrier xcd_barrier_post(unsigned* bar, volatile LAS unsigned* st) {
    XcdBarrier b; b.bar = bar; b.x = xb_xcc_id(); b.st = st;
    if (threadIdx.x == 0) (void)xb_add(&bar[XB_XCNT(b.x)], 1u);
    return b;
}
__device__ __forceinline__ void xcd_barrier_complete(unsigned* bar, unsigned x, unsigned& nloc, unsigned& nx) {
    const unsigned G = gridDim.x * gridDim.y * gridDim.z;
    unsigned sum, cnt, mine, sp = 0u;
    for (;;) {
        sum = 0u; cnt = 0u; mine = 0u;
#pragma unroll
        for (unsigned j = 0; j < 16; ++j) { const unsigned c = xb_ld(&bar[XB_XCNT(j)]); sum += c; cnt += (c > 0u) ? 1u : 0u; mine = (j == x) ? c : mine; }
        if (sum == G) break;
        __builtin_amdgcn_s_sleep(1);
        if ((++sp & 255u) == 0u) { if (xb_ld(&bar[XB_TMO])) break; if (sp > XB_SPIN_CAP) { atomicAdd(&bar[XB_TMO], 1u); break; } }
    }
    nloc = mine > 0u ? mine : 1u; nx = cnt > 0u ? cnt : 1u;
}

__device__ __forceinline__ void xcd_barrier(const XcdBarrier& b) {
    asm volatile("s_waitcnt vmcnt(0)" ::: "memory");
    __syncthreads();
    if (threadIdx.x == 0) {
        unsigned* bar = b.bar; const unsigned bx = xb_xcc_id();
        __builtin_amdgcn_s_waitcnt(0);
        unsigned nloc = b.st[0], nx = b.st[1];
        if (nloc == 0u) { xcd_barrier_complete(bar, bx, nloc, nx); b.st[0] = nloc; b.st[1] = nx; }
        const unsigned old = xb_add(&bar[XB_XSUB(bx)], 1u);
        const unsigned gen = old / nloc;
        if (old + 1u == (gen + 1u) * nloc) {
            __builtin_amdgcn_fence(__ATOMIC_RELEASE, "agent");
            asm volatile("s_waitcnt vmcnt(0)" ::: "memory");
            const unsigned og = xb_add(&bar[XB_TOP], 1u);
            const unsigned tg = og / nx;
            if (og + 1u == (tg + 1u) * nx) xb_add(&bar[XB_TOPGEN], 1u);
            else XB_SPIN(xb_ld(&bar[XB_TOPGEN]) == tg, bar);
            __builtin_amdgcn_fence(__ATOMIC_ACQUIRE, "agent");
            xb_add(&bar[XB_XGEN(bx)], 1u);
            asm volatile("s_waitcnt vmcnt(0)" ::: "memory");
        } else {
            XB_SPIN(xb_ld(&bar[XB_XGEN(bx)]) == gen, bar);
            __builtin_amdgcn_fence(__ATOMIC_ACQUIRE, "agent");
            asm volatile("s_waitcnt vmcnt(0)" ::: "memory");
        }
    }
    __syncthreads();
}


__device__ __forceinline__ void phase_copy(const Params& p, int bid, int nb) {
    const int tix = otid();
    if (bid == 0) for (int i = tix; i < D; i += NT) p.h[(size_t)M * D + i] = 0;
}

__device__ __forceinline__ void phase_router_w(const Params& p, int bid, int nb) {
    const int tix = otid();
    for (int i = bid * NT + tix; i < 2 * D * NEXP; i += nb * NT) {
        const int c = i & 3, n = (i >> 2) & 15, q = (i >> 6) & 3, nt = (i >> 8) & 3, j = (i >> 10) & 127, l = i >> 17;
        p.Wr[i] = p.router_w[((size_t)l * D + 16 * j + 4 * q + c) * NEXP + 16 * nt + n];
    }
}
__device__ __forceinline__ void phase_lora_w(const Params& p, int bid, int nb) {
    const int tix = otid();
    for (int i = bid * NT + tix; i < 2 * 2 * 12 * 2 * 64 * 72; i += nb * NT) {
        const int r = i % 72, c = (i / 72) & 63, which = (i / (72 * 64)) & 1, hh = (i / (72 * 64 * 2)) % 12, n = (i / (72 * 64 * 2 * 12)) & 1, l = i / (72 * 64 * 2 * 12 * 2);
        const float* src = (which == 0 ? p.rw_w_up : p.rw_a_up) + ((size_t)(l * 2 + n) * 48) * 768 + hh * 64 + c;
        p.Lwa[i] = r < 48 ? f2bf(src[(size_t)r * 768]) : (bf16_t)0;
    }
    for (int i = bid * NT + tix; i < 2 * 12 * 64 * 104; i += nb * NT) {
        const int r = i % 104, c = (i / 104) & 63, hh = (i / (104 * 64)) % 12, l = i / (104 * 64 * 12);
        p.Lg[i] = r < 96 ? f2bf(p.rw_g_up[((size_t)l * 96 + r) * 768 + hh * 64 + c]) : (bf16_t)0;
    }
}
__device__ __forceinline__ void phase_adaln(const Params& p, float* lds, int bid, int nb) {
    const int tix = otid();
    float* cond = lds;
    float* red = lds + 5 * D;
    for (int i = tix; i < 5 * D; i += NT) { const int r = i / D, d = i % D; const float v = r < 4 ? p.c[r * D + d] : p.c_ctx[d]; cond[i] = v * sigmoidf_(v); }
    __syncthreads();
    const int tid = tix, cg = tid & 15, ks = tid >> 4, wid = tid >> 6, lane = tid & 63;
    const int nitems = 2 * (6 * D / 64);
    for (int it = bid; it < nitems; it += nb) {
        const int l = it / (6 * D / 64), c0 = (it % (6 * D / 64)) * 64 + cg * 4;
        const float* W = p.ada_w + (size_t)l * D * 6 * D + c0;
        float4 acc[5];
#pragma unroll
        for (int r = 0; r < 5; ++r) acc[r] = make_float4(0.f, 0.f, 0.f, 0.f);
#pragma unroll 8
        for (int k = ks; k < D; k += 32) {
            const float4 w = *(const float4*)(W + (size_t)k * 6 * D);
#pragma unroll
            for (int r = 0; r < 5; ++r) { const float cv = cond[r * D + k]; acc[r].x += cv * w.x; acc[r].y += cv * w.y; acc[r].z += cv * w.z; acc[r].w += cv * w.w; }
        }
#pragma unroll
        for (int r = 0; r < 5; ++r) {
            acc[r].x += bperm_f(lane ^ 16, acc[r].x); acc[r].x += bperm_f(lane ^ 32, acc[r].x);
            acc[r].y += bperm_f(lane ^ 16, acc[r].y); acc[r].y += bperm_f(lane ^ 32, acc[r].y);
            acc[r].z += bperm_f(lane ^ 16, acc[r].z); acc[r].z += bperm_f(lane ^ 32, acc[r].z);
            acc[r].w += bperm_f(lane ^ 16, acc[r].w); acc[r].w += bperm_f(lane ^ 32, acc[r].w);
        }
        __syncthreads();
        if (lane < 16) {
#pragma unroll
            for (int r = 0; r < 5; ++r) { float* q = red + ((wid * 16 + lane) * 20 + r * 4); q[0] = acc[r].x; q[1] = acc[r].y; q[2] = acc[r].z; q[3] = acc[r].w; }
        }
        __syncthreads();
        if (tid < 16 * 20) {
            const int cgi = tid / 20, rj = tid % 20, r = rj / 4, j = rj % 4;
            float s = 0.f;
#pragma unroll
            for (int w = 0; w < 8; ++w) s += red[(w * 16 + cgi) * 20 + rj];
            const int col = (it % (6 * D / 64)) * 64 + cgi * 4 + j;
            p.mod[(size_t)(l * 5 + r) * 6 * D + col] = s + p.ada_b[(size_t)l * 6 * D + col];
        }
    }
}

__device__ __forceinline__ void moe_tables(const Params& p, LAS int* tab, int lc);

struct CombPre { int e[TOPK], tp[TOPK]; float w[TOPK]; };
__device__ __forceinline__ void comb_prefetch(const Params& p, int g, CombPre& c) {
#pragma unroll
    for (int k = 0; k < TOPK; ++k) { c.e[k] = p.sel[g * TOPK + k]; c.tp[k] = p.tpos[g * TOPK + k]; c.w[k] = p.selw[g * TOPK + k]; }
}
__device__ __forceinline__ void moe_combine_row(const Params& p, const LAS int* tab, int lm  , int g, int lane, const CombPre& c, float4 (&v)[8]) {
    int slot[TOPK + 1]; float w[TOPK + 1];
#pragma unroll
    for (int k = 0; k < TOPK; ++k) { slot[k] = tab[66 + c.e[k]] + c.tp[k]; w[k] = c.w[k]; }
    slot[TOPK] = tab[66 + NEXP] + g; w[TOPK] = 1.0f;
    const float* gt = p.mod + (size_t)(lm * 5 + modrow(g)) * 6 * D + 5 * D;
#pragma unroll
    for (int i = 0; i < 8; ++i) {
        const int d = (i * 64 + lane) * 4; float a0 = 0.f, a1 = 0.f, a2 = 0.f, a3 = 0.f;
#pragma unroll
        for (int k = 0; k <= TOPK; ++k) { const uint2 y = *(const uint2*)(p.Y + (size_t)slot[k] * D + d);
            a0 += w[k] * __uint_as_float(y.x << 16); a1 += w[k] * __uint_as_float(y.x & 0xffff0000u); a2 += w[k] * __uint_as_float(y.y << 16); a3 += w[k] * __uint_as_float(y.y & 0xffff0000u); }
        const float4 g4 = *(const float4*)(gt + d);
        v[i].x += g4.x * a0; v[i].y += g4.y * a1; v[i].z += g4.z * a2; v[i].w += g4.w * a3;
    }
}

typedef float nf32x4 __attribute__((ext_vector_type(4)));
template <int WHICH>
__device__ __forceinline__ void phase_norm(const Params& p, float* lds, LAS int* tab, int l, int bid, int nb) {
    const bool comb = (WHICH == 0 && l > 0);
    if (comb) moe_tables(p, tab, l - 1);
    const int tix = otid();
    const int wid = tix >> 6, lane = tix & 63;
    const float* gam = (WHICH == 0 ? p.norm1_g : p.norm2_g) + (size_t)l * D;
    float* frow = lds + wid * D;
    float4 vn[8]; CombPre cn;
    { const int g = bid * 8 + wid; if (g < M) { const float* xr = (WHICH == 0 && l == 0) ? in_row(p, g) : p.xcur + (size_t)g * D;
#pragma unroll
        for (int i = 0; i < 8; ++i) vn[i] = *(const float4*)(xr + (i * 64 + lane) * 4);
        if (comb) comb_prefetch(p, g, cn); } }
    for (int g = bid * 8 + wid; g < M; g += nb * 8) {
        float4 v[8]; float ss = 0.f; CombPre cc;
#pragma unroll
        for (int i = 0; i < 8; ++i) v[i] = vn[i];
        if (comb) cc = cn;
        { const int gn = g + nb * 8; if (gn < M) { const float* xr = (WHICH == 0 && l == 0) ? in_row(p, gn) : p.xcur + (size_t)gn * D;
#pragma unroll
            for (int i = 0; i < 8; ++i) vn[i] = *(const float4*)(xr + (i * 64 + lane) * 4);
            if (comb) comb_prefetch(p, gn, cn); } }
        if (comb) moe_combine_row(p, tab, l - 1, g, lane, cc, v);
#pragma unroll
        for (int i = 0; i < 8; ++i) ss += v[i].x * v[i].x + v[i].y * v[i].y + v[i].z * v[i].z + v[i].w * v[i].w;
        ss = wave_sum(ss);
        const float rs = rsqrtf(ss * (1.0f / D) + 1e-6f);
        const float* mrow = p.mod + (size_t)(l * 5 + modrow(g)) * 6 * D;
        const float* sh = mrow + (WHICH == 0 ? 0 : 3) * D; const float* sc = mrow + (WHICH == 0 ? 1 : 4) * D;
        uint2 hp[8];
#pragma unroll
        for (int hf = 0; hf < 2; ++hf) {
            nf32x4 ga[4], sa[4], ca[4];
#pragma unroll
            for (int i = 0; i < 4; ++i) { const int d = ((hf * 4 + i) * 64 + lane) * 4; ga[i] = *(const nf32x4*)(gam + d); sa[i] = *(const nf32x4*)(sh + d); ca[i] = *(const nf32x4*)(sc + d); }
            LOAD_FENCE4(ga); LOAD_FENCE4(sa); LOAD_FENCE4(ca);
#pragma unroll
            for (int i = 0; i < 4; ++i) {
                const float4 x4 = v[hf * 4 + i];
                float4 o;
                o.x = x4.x * rs * ga[i][0] * (1.0f + ca[i][0]) + sa[i][0]; o.y = x4.y * rs * ga[i][1] * (1.0f + ca[i][1]) + sa[i][1];
                o.z = x4.z * rs * ga[i][2] * (1.0f + ca[i][2]) + sa[i][2]; o.w = x4.w * rs * ga[i][3] * (1.0f + ca[i][3]) + sa[i][3];
                hp[hf * 4 + i].x = (unsigned)f2bf(o.x) | ((unsigned)f2bf(o.y) << 16); hp[hf * 4 + i].y = (unsigned)f2bf(o.z) | ((unsigned)f2bf(o.w) << 16);
                if (WHICH == 1) *(float4*)(frow + ((hf * 4 + i) * 64 + lane) * 4) = o;
            }
        }
#pragma unroll
        for (int i = 0; i < 8; ++i) { const int d = (i * 64 + lane) * 4; *(uint2*)(p.h + (size_t)g * D + d) = hp[i]; if (comb) *(float4*)(p.xcur + (size_t)g * D + d) = v[i]; }
        if (WHICH == 1) {
            const float* rw = p.router_w + (size_t)l * D * NEXP + lane;
            float a0 = 0.f, a1 = 0.f, a2 = 0.f, a3 = 0.f;
            for (int k = 0; k < D; k += 4) {
                const float4 f = *(const float4*)(frow + k);
                a0 += f.x * rw[(size_t)(k + 0) * NEXP]; a1 += f.y * rw[(size_t)(k + 1) * NEXP]; a2 += f.z * rw[(size_t)(k + 2) * NEXP]; a3 += f.w * rw[(size_t)(k + 3) * NEXP];
            }
            const float score = 1.0f / (1.0f + expf(-((a0 + a1) + (a2 + a3))));
            float val = score + p.router_bias[l * NEXP + lane];
            int myidx[TOPK]; float mysc[TOPK]; float tot = 0.f;
#pragma unroll
            for (int k = 0; k < TOPK; ++k) {
                float bv = val; int bi = lane;
                amax_dpp<0xB1>(bv, bi); amax_dpp<0x4E>(bv, bi); amax_dpp<0x141>(bv, bi); amax_dpp<0x140>(bv, bi);
#pragma unroll
                for (int o = 16; o <= 32; o <<= 1) { const float ov = bperm_f(lane ^ o, bv); const int oi = bperm_i(lane ^ o, bi); if (ov > bv || (ov == bv && oi < bi)) { bv = ov; bi = oi; } }
                const float sc_k = bperm_f(bi, score);
                myidx[k] = bi; mysc[k] = sc_k; tot += sc_k;
                if (lane == bi) val = -INFINITY;
            }
            if (lane == 0) {
#pragma unroll
                for (int k = 0; k < TOPK; ++k) { p.sel[g * TOPK + k] = myidx[k]; p.selw[g * TOPK + k] = mysc[k] / tot * 2.5f; }
            }
        }
    }
}


namespace pg8 {
typedef short bf16x8 __attribute__((ext_vector_type(8)));
typedef float f32x4 __attribute__((ext_vector_type(4)));
typedef unsigned u32x4 __attribute__((ext_vector_type(4)));
constexpr int BM = 256, BK = 64, HALF = 128, HTB = HALF * BK * 2  , STAGE_BYTES = 8 * HTB, NXCD = 8, WGM = 8;
__device__ __forceinline__ int lds_byte(int r, int c) { const int st = (r >> 4) * 2 + (c >> 5), rr = r & 15, cc = c & 31, ob = rr * 64 + cc * 2; return st * 1024 + (ob ^ (((ob >> 9) & 1) << 5)); }
__device__ __forceinline__ void stage_rc(int b, int& R, int& C) { const int st = b / 1024, sb = b % 1024, swz = sb ^ (((sb >> 9) & 1) << 5); R = (st >> 1) * 16 + swz / 64; C = (st & 1) * 32 + (swz % 64) / 2; }
__device__ __forceinline__ int perm32(int rho) { const int n = rho >> 4, i = rho & 15; return 8 * (i >> 2) + 4 * n + (i & 3); }
typedef float cvt_f32x2 __attribute__((ext_vector_type(2)));
typedef __bf16 cvt_bf16x2 __attribute__((ext_vector_type(2)));
__device__ __forceinline__ unsigned cvt_pk_bf16(float lo, float hi) { const cvt_f32x2 v = {lo, hi}; const cvt_bf16x2 b = __builtin_convertvector(v, cvt_bf16x2); return __builtin_bit_cast(unsigned, b); }
struct Unit { int pm, pn, e, ord; };
template <bool PERM, class Sched, class Epi>
__device__ __forceinline__ void gemm_phase(LAS unsigned char* lds, const char* Abase, const int K, const Sched& S, const Epi& E) {
    const int tid = otid(), wid = __builtin_amdgcn_readfirstlane(tid >> 6), lane = tid & 63, wr = wid >> 2, wc = wid & 3, fr = lane & 15, fq = lane >> 4;
    const int nt = K / BK;
    unsigned voffB[2];
#pragma unroll
    for (int i = 0; i < 2; ++i) { int R, C; stage_rc(tid * 16 + i * 8192, R, C); const int Rb = PERM ? ((R & ~31) + perm32(R & 31)) : R; voffB[i] = (unsigned)(Rb * K + C) * 2u; }
    const size_t kstep = (size_t)(BK * 2);
    const size_t hstep = (size_t)HALF * K * 2;
    const unsigned ldsw = (unsigned)wid * 1024u;
    const int aoff = lds_byte(wr * 64 + fr, fq * 8), boff = lds_byte(wc * 32 + fr, fq * 8);
#define PG8_SA(b, h) (((b) * 2 + (h)) * HTB)
#define PG8_SB(b, h) ((4 + (b) * 2 + (h)) * HTB)
#define PG8_STAGE(bufoff, gbase, voff) do { _Pragma("unroll") for (int _i = 0; _i < 2; ++_i) \
        __builtin_amdgcn_global_load_lds((const unsigned*)((const char*)(gbase) + (voff)[_i]), (LAS unsigned*)(lds + (bufoff) + ldsw + _i * 8192), 16, 0, 0); } while (0)
#define PG8_LDA(dst, b, h) do { _Pragma("unroll") for (int m = 0; m < 4; ++m) _Pragma("unroll") for (int k = 0; k < 2; ++k) dst[m][k] = *(const LAS bf16x8*)(lds + PG8_SA(b, h) + aoff + m * 2048 + k * 1024); } while (0)
#define PG8_LDB(dst, b, h) do { _Pragma("unroll") for (int n = 0; n < 2; ++n) _Pragma("unroll") for (int k = 0; k < 2; ++k) dst[n][k] = *(const LAS bf16x8*)(lds + PG8_SB(b, h) + boff + n * 2048 + k * 1024); } while (0)
#define PG8_MMA(ai, bj, At, Bt) do { __builtin_amdgcn_s_setprio(1); _Pragma("unroll") for (int m = 0; m < 4; ++m) _Pragma("unroll") for (int n = 0; n < 2; ++n) _Pragma("unroll") for (int k = 0; k < 2; ++k) \
        acc[ai][bj][m][n] = __builtin_amdgcn_mfma_f32_16x16x32_bf16(Bt[n][k], At[m][k], acc[ai][bj][m][n], 0, 0, 0); __builtin_amdgcn_s_setprio(0); } while (0)
#define PG8_WAIT_V(n) asm volatile("s_waitcnt vmcnt(" #n ")" ::: "memory")
#define PG8_WAIT_L(n) asm volatile("s_waitcnt lgkmcnt(" #n ")" ::: "memory")
#define PG8_BAR __builtin_amdgcn_s_barrier()
#define PG8_SCHED __builtin_amdgcn_sched_barrier(0)
#define PG8_ROWS(u, v) do { const int _t = otid(); _Pragma("unroll") for (int _i = 0; _i < 2; ++_i) { int _R, _C; stage_rc(_t * 16 + _i * 8192, _R, _C); \
        _Pragma("unroll") for (int _h = 0; _h < 2; ++_h) v[_h][_i] = S.arow(u, _h * HALF + _R) + (unsigned)(_C * 2); } } while (0)
    Unit cur, nxt; int ui = 0;
    if (!S.next(0, cur)) return;
    f32x4 acc[2][2][4][2];
#pragma unroll
    for (int a = 0; a < 2; ++a)
#pragma unroll
        for (int b = 0; b < 2; ++b)
#pragma unroll
            for (int m = 0; m < 4; ++m)
#pragma unroll
                for (int n = 0; n < 2; ++n) acc[a][b][m][n] = (f32x4){0.f, 0.f, 0.f, 0.f};
    bf16x8 At[4][2], B0[2][2], B1[2][2];
    unsigned va[2][2];
    PG8_ROWS(cur, va);
    const char* cB = S.bptr(cur);
    PG8_STAGE(PG8_SB(0, 0), cB, voffB); PG8_STAGE(PG8_SA(0, 0), Abase, va[0]); PG8_STAGE(PG8_SB(0, 1), cB + hstep, voffB); PG8_STAGE(PG8_SA(0, 1), Abase, va[1]);
    if (wr == 1) PG8_BAR;
    PG8_WAIT_V(4); PG8_BAR;
    PG8_STAGE(PG8_SB(1, 0), cB + kstep, voffB); PG8_STAGE(PG8_SA(1, 0), Abase + kstep, va[0]); PG8_STAGE(PG8_SB(1, 1), cB + hstep + kstep, voffB);
    PG8_WAIT_V(6); PG8_BAR;
    for (;;) {
        const bool has_next = S.next(ui + 1, nxt);
        const char* nB = has_next ? S.bptr(nxt) : cB;
        for (int t = 0; t < nt; t += 2) {
            const bool last = (t == nt - 2);
            const char* a1 = Abase + (size_t)(t + 1) * kstep;
            const char* a2 = last ? Abase : Abase + (size_t)(t + 2) * kstep; const char* b2 = last ? nB : cB + (size_t)(t + 2) * kstep;
            const char* a3 = a2 + kstep; const char* b3 = b2 + kstep;
            PG8_LDB(B0, 0, 0); PG8_SCHED; PG8_LDA(At, 0, 0); PG8_STAGE(PG8_SA(1, 1), a1, va[1]);
            PG8_WAIT_L(8); PG8_BAR; PG8_WAIT_L(0); PG8_MMA(0, 0, At, B0); PG8_BAR; PG8_SCHED;
            if (last && has_next) { PG8_ROWS(nxt, va); }
            PG8_LDB(B1, 0, 1); PG8_STAGE(PG8_SB(0, 0), b2, voffB);
            PG8_BAR; PG8_WAIT_L(0); PG8_MMA(0, 1, At, B1); PG8_BAR;
            PG8_LDA(At, 0, 1); PG8_STAGE(PG8_SA(0, 0), a2, va[0]);
            PG8_BAR; PG8_WAIT_L(0); PG8_MMA(1, 0, At, B0); PG8_BAR; PG8_SCHED;
            PG8_STAGE(PG8_SB(0, 1), b2 + hstep, voffB);
            PG8_WAIT_V(6); PG8_BAR; PG8_MMA(1, 1, At, B1); PG8_BAR;
            PG8_LDB(B0, 1, 0); PG8_SCHED; PG8_LDA(At, 1, 0); PG8_STAGE(PG8_SA(0, 1), a2, va[1]);
            PG8_WAIT_L(8); PG8_BAR; PG8_WAIT_L(0); PG8_MMA(0, 0, At, B0); PG8_BAR; PG8_SCHED;
            PG8_LDB(B1, 1, 1); PG8_STAGE(PG8_SB(1, 0), b3, voffB);
            PG8_BAR; PG8_WAIT_L(0); PG8_MMA(0, 1, At, B1); PG8_BAR;
            PG8_LDA(At, 1, 1); PG8_STAGE(PG8_SA(1, 0), a3, va[0]);
            PG8_BAR; PG8_WAIT_L(0); PG8_MMA(1, 0, At, B0); PG8_BAR; PG8_SCHED;
            PG8_STAGE(PG8_SB(1, 1), b3 + hstep, voffB);
            PG8_WAIT_V(6); PG8_BAR; PG8_MMA(1, 1, At, B1); PG8_BAR;
        }
        E(acc, cur, wr, wc, fr, fq);
        if (!has_next) break;
#pragma unroll
        for (int a = 0; a < 2; ++a)
#pragma unroll
            for (int b = 0; b < 2; ++b)
#pragma unroll
                for (int m = 0; m < 4; ++m)
#pragma unroll
                    for (int n = 0; n < 2; ++n) acc[a][b][m][n] = (f32x4){0.f, 0.f, 0.f, 0.f};
        cur = nxt; cB = nB; ++ui;
    }
    PG8_WAIT_V(0);
    if (wr == 0) PG8_BAR;
    PG8_BAR;
#undef PG8_SA
#undef PG8_SB
#undef PG8_STAGE
#undef PG8_LDA
#undef PG8_LDB
#undef PG8_MMA
#undef PG8_WAIT_V
#undef PG8_WAIT_L
#undef PG8_BAR
#undef PG8_SCHED
#undef PG8_ROWS
}
struct DenseSched {
    int nM, nN, nwg, G, c; const char* Bt; unsigned rowbytes; int skipctx;
    __device__ __forceinline__ bool next(int i, Unit& u) const {
        const long L = (long)i * G + c; if (L >= nwg) return false;
        int wgid = (int)L; { const int q = nwg / NXCD, r = nwg % NXCD, xcd = wgid % NXCD, off = wgid / NXCD; wgid = (xcd < r ? xcd * (q + 1) : r * (q + 1) + (xcd - r) * q) + off; }
        const int nig = WGM * nN, gid = wgid / nig, fm = gid * WGM, gsz = (nM - fm) < WGM ? (nM - fm) : WGM;
        u.pm = fm + ((wgid % nig) % gsz); u.pn = (wgid % nig) / gsz; u.e = 0; u.ord = i; if (skipctx) u.pm = (u.pm >> 4) * 17 + 1 + (u.pm & 15); return true;
    }
    __device__ __forceinline__ unsigned arow(const Unit& u, int r) const { return (unsigned)(u.pm * BM + r) * rowbytes; }
    __device__ __forceinline__ const char* bptr(const Unit& u) const { return Bt + (size_t)u.pn * BM * rowbytes; }
};
}

struct CvTile { const float* src; bf16_t* dst; int ldn, nvalid, k0, n0, K, split; };
constexpr int CV_IN = 32 * 26, CV_OUT = 32 * 8, CV_PER_E = 32 * 2 + 32 * 2 + 8 * 8, CV_TOTAL = CV_IN + CV_OUT + 65 * CV_PER_E, CV_EEARLY = 32, CV_EARLY = CV_IN + CV_OUT + CV_EEARLY * CV_PER_E;
__device__ __forceinline__ CvTile cv_desc(const Params& p, int l, int it) {
    const int r1 = it - CV_IN, r2 = r1 - CV_OUT;
    const bool is_in = it < CV_IN, is_out = !is_in && r1 < CV_OUT;
    const int e = r2 >= 0 ? r2 / CV_PER_E : 0, re = r2 >= 0 ? r2 % CV_PER_E : 0;
    const bool is_gu = !is_in && !is_out && re < 128, up = re >= 64, is_dn = !is_in && !is_out && !is_gu;
    const int rg = re & 63, rd = re - 128;
    const float* sgu = e < NEXP ? (up ? p.exp_up : p.exp_gate) + ((size_t)l * NEXP + e) * D * DE : (up ? p.sh_up : p.sh_gate) + (size_t)l * D * DE;
    const float* sdn = e < NEXP ? p.exp_down + ((size_t)l * NEXP + e) * DE * D : p.sh_down + (size_t)l * DE * D;
    CvTile t;
    t.src = is_in ? p.w_in + (size_t)l * D * IN_COLS : (is_out ? p.w_out + (size_t)l * D * D : (is_gu ? sgu : sdn));
    const bool early = l == 1 && e < CV_EEARLY;
    t.dst = is_in ? p.WinT : (is_out ? p.WoutT + (size_t)l * D * D : (is_gu ? (early ? p.WguE : p.WguT) + (size_t)e * 1024 * D : (early ? p.WdnE : p.WdnT) + (size_t)e * D * DE));
    t.ldn = is_in ? IN_COLS : (is_gu ? DE : D); t.nvalid = t.ldn;
    t.k0 = (is_in ? it / 26 : (is_out ? r1 / 8 : (is_gu ? rg / 2 : rd / 8))) * 64;
    t.n0 = (is_in ? it % 26 : (is_out ? r1 % 8 : (is_gu ? rg % 2 : rd % 8))) * 256;
    t.K = is_dn ? DE : D; t.split = is_gu ? (up ? 2 : 1) : 0;
    return t;
}
__device__ __forceinline__ void cv_load(const CvTile& t, int tid, pg8::f32x4 (&v)[8]) {
    const int kp = tid >> 6, c4 = (tid & 63) * 4;
#pragma unroll
    for (int j = 0; j < 8; ++j) v[j] = (t.n0 + c4 < t.nvalid) ? *(const pg8::f32x4*)(t.src + (size_t)(t.k0 + 8 * kp + j) * t.ldn + t.n0 + c4) : (pg8::f32x4){0.f, 0.f, 0.f, 0.f};
}
__device__ __forceinline__ void cv_store(const CvTile& t, int tid, bf16_t* T  , const pg8::f32x4 (&v)[8]) {
    const int kp = tid >> 6, c4 = (tid & 63) * 4;
    uint4 o;
    o.x = pg8::cvt_pk_bf16(v[0][0], v[1][0]); o.y = pg8::cvt_pk_bf16(v[2][0], v[3][0]); o.z = pg8::cvt_pk_bf16(v[4][0], v[5][0]); o.w = pg8::cvt_pk_bf16(v[6][0], v[7][0]); *(uint4*)(T + (c4 + 0) * 72 + 8 * kp) = o;
    o.x = pg8::cvt_pk_bf16(v[0][1], v[1][1]); o.y = pg8::cvt_pk_bf16(v[2][1], v[3][1]); o.z = pg8::cvt_pk_bf16(v[4][1], v[5][1]); o.w = pg8::cvt_pk_bf16(v[6][1], v[7][1]); *(uint4*)(T + (c4 + 1) * 72 + 8 * kp) = o;
    o.x = pg8::cvt_pk_bf16(v[0][2], v[1][2]); o.y = pg8::cvt_pk_bf16(v[2][2], v[3][2]); o.z = pg8::cvt_pk_bf16(v[4][2], v[5][2]); o.w = pg8::cvt_pk_bf16(v[6][2], v[7][2]); *(uint4*)(T + (c4 + 2) * 72 + 8 * kp) = o;
    o.x = pg8::cvt_pk_bf16(v[0][3], v[1][3]); o.y = pg8::cvt_pk_bf16(v[2][3], v[3][3]); o.z = pg8::cvt_pk_bf16(v[4][3], v[5][3]); o.w = pg8::cvt_pk_bf16(v[6][3], v[7][3]); *(uint4*)(T + (c4 + 3) * 72 + 8 * kp) = o;
    lds_barrier();
#pragma unroll
    for (int j = 0; j < 4; ++j) {
        const int q = tid + 512 * j, nl = q >> 3, kc = q & 7, n = t.n0 + nl;
        const size_t drow = t.split == 0 ? (size_t)n : (size_t)((n >> 7) * 256 + (t.split == 2 ? 128 : 0) + (n & 127));
        *(uint4*)(t.dst + drow * t.K + t.k0 + kc * 8) = *(const uint4*)(T + nl * 72 + kc * 8);
    }
}
__device__ __forceinline__ void phase_convert(const Params& p, float* lds, int l, int first  , int bid, int nb) {
    const int tid = otid();
    bf16_t* T0 = (bf16_t*)lds; bf16_t* T1 = T0 + 256 * 72;
    pg8::f32x4 va[8], vb[8];
    __syncthreads();
    int it = first + bid;
    if (it < CV_TOTAL) cv_load(cv_desc(p, l, it), tid, va);
    for (; it < CV_TOTAL; it += 2 * nb) {
        const bool has1 = it + nb < CV_TOTAL, has2 = it + 2 * nb < CV_TOTAL;
        if (has1) cv_load(cv_desc(p, l, it + nb), tid, vb);
        cv_store(cv_desc(p, l, it), tid, T0, va);
        if (has2) cv_load(cv_desc(p, l, it + 2 * nb), tid, va);
        if (has1) cv_store(cv_desc(p, l, it + nb), tid, T1, vb);
    }
    __syncthreads();
}

constexpr int CVG = 6;
__device__ __forceinline__ int gemm_wgs(int total, int nb) { const int rounds = (total + nb - 1) / nb; int g = rounds > 0 ? ((total + rounds - 1) / rounds + 7) & ~7 : nb; return g < nb ? g : nb; }
__device__ __forceinline__ void convert_until(const Params& p, float* lds, int* done, int G, bool report) {
    const int tid = otid();
    bf16_t* T0 = (bf16_t*)lds; bf16_t* T1 = T0 + 256 * 72; int* sh = (int*)(T1 + 256 * 72);
    __syncthreads();
    if (report && tid == 0) atomicAdd(done, 1);
    for (;;) {
        __syncthreads();
        if (tid == 0) *sh = __hip_atomic_load(done, __ATOMIC_RELAXED, __HIP_MEMORY_SCOPE_AGENT) >= G ? CV_EARLY : atomicAdd(p.cvc, CVG);
        __syncthreads();
        const int base = *sh; if (base >= CV_EARLY) break;
        const int end = base + CVG < CV_EARLY ? base + CVG : CV_EARLY;
        pg8::f32x4 va[8], vb[8];
        int it = base; cv_load(cv_desc(p, 1, it), tid, va);
        for (; it < end; it += 2) {
            const bool has1 = it + 1 < end, has2 = it + 2 < end;
            if (has1) cv_load(cv_desc(p, 1, it + 1), tid, vb);
            cv_store(cv_desc(p, 1, it), tid, T0, va);
            if (has2) cv_load(cv_desc(p, 1, it + 2), tid, va);
            if (has1) cv_store(cv_desc(p, 1, it + 1), tid, T1, vb);
        }
    }
    __syncthreads();
}

struct EpiZ {
    bf16_t* z;
    __device__ __forceinline__ void operator()(const pg8::f32x4 (&acc)[2][2][4][2], const pg8::Unit& u, int wr, int wc, int fr, int fq) const {
        const int row0 = u.pm * 256 + wr * 64 + fr, col0 = u.pn * 256 + wc * 32 + 8 * fq;
#pragma unroll
        for (int ai = 0; ai < 2; ++ai)
#pragma unroll
            for (int m = 0; m < 4; ++m) { bf16_t* rowp = z + (size_t)(row0 + ai * 128 + m * 16) * ZLD + col0;
#pragma unroll
                for (int bj = 0; bj < 2; ++bj) { const pg8::f32x4 v0 = acc[ai][bj][m][0], v1 = acc[ai][bj][m][1];
                    pg8::u32x4 w; w.x = pg8::cvt_pk_bf16(v0[0], v0[1]); w.y = pg8::cvt_pk_bf16(v0[2], v0[3]); w.z = pg8::cvt_pk_bf16(v1[0], v1[1]); w.w = pg8::cvt_pk_bf16(v1[2], v1[3]);
                    *(pg8::u32x4*)(rowp + bj * 128) = w; } }
    }
};
struct EpiOut {
    float* xcur; const float* mod; int l; const float* xin; const float* cin;
    __device__ __forceinline__ void rows(int k, int row0, int col0, float*& xr, const float*& gt, const float*& xs) const {
        const int g = row0 + (k >> 2) * 128 + (k & 3) * 16; xr = xcur + (size_t)g * D + col0; gt = mod + (size_t)(l * 5 + modrow(g)) * 6 * D + 2 * D + col0;
        const int gb = g / TT, gs = g - gb * TT; xs = l != 0 ? xr : (gs < LC ? cin + (size_t)(gb * LC + gs) * D : xin + (size_t)(gb * L + (gs - LC)) * D) + col0;
    }
    __device__ __forceinline__ void operator()(const pg8::f32x4 (&acc)[2][2][4][2], const pg8::Unit& u, int wr, int wc, int fr, int fq) const {
        const int row0 = u.pm * 256 + wr * 64 + fr, col0 = u.pn * 256 + wc * 32 + 4 * fq;
        pg8::f32x4 xv[2][4], gv[2][4];
        { float* xr; const float* gt; const float* xs; rows(0, row0, col0, xr, gt, xs);
#pragma unroll
          for (int c = 0; c < 4; ++c) { const int co = (c >> 1) * 128 + (c & 1) * 16; xv[0][c] = *(const pg8::f32x4*)(xs + co); gv[0][c] = *(const pg8::f32x4*)(gt + co); } }
#pragma unroll
        for (int k = 0; k < 8; ++k) {
            if (k + 1 < 8) { float* xr; const float* gt; const float* xs; rows(k + 1, row0, col0, xr, gt, xs);
#pragma unroll
                for (int c = 0; c < 4; ++c) { const int co = (c >> 1) * 128 + (c & 1) * 16; xv[(k + 1) & 1][c] = *(const pg8::f32x4*)(xs + co); gv[(k + 1) & 1][c] = *(const pg8::f32x4*)(gt + co); } }
            float* xr; const float* gt; const float* xs; rows(k, row0, col0, xr, gt, xs);
#pragma unroll
            for (int c = 0; c < 4; ++c) { const int co = (c >> 1) * 128 + (c & 1) * 16; *(pg8::f32x4*)(xr + co) = xv[k & 1][c] + gv[k & 1][c] * acc[k >> 2][c >> 1][k & 3][c & 1]; }
        }
    }
};
__device__ __forceinline__ void phase_gemm_in(const Params& p, LAS unsigned char* stage, int l, int bid, int nb) {
    pg8::DenseSched S; S.nM = M / 256; S.nN = ZLD / 256; S.nwg = S.nM * S.nN; S.G = nb; S.c = bid; S.Bt = (const char*)p.WinT; S.rowbytes = D * 2; S.skipctx = 0;
    EpiZ E; E.z = p.z;
    pg8::gemm_phase<true>(stage, (const char*)p.h, D, S, E);
}
__device__ __forceinline__ void phase_gemm_out(const Params& p, LAS unsigned char* stage, int l, int bid, int nb) {
    pg8::DenseSched S; S.skipctx = (l == 1); S.nM = S.skipctx ? NB * L / 256 : M / 256; S.nN = D / 256; S.nwg = S.nM * S.nN; S.G = l == 0 ? gemm_wgs(S.nwg, nb) : nb; S.c = bid; S.Bt = (const char*)(p.WoutT + (size_t)l * D * D); S.rowbytes = D * 2;
    EpiOut E; E.xcur = p.xcur; E.mod = p.mod; E.l = l; E.xin = p.x; E.cin = p.ctx;
    if (bid < S.G) pg8::gemm_phase<false>(stage, (const char*)p.mix, D, S, E);
    if (l == 0) convert_until(p, (float*)(unsigned char*)stage, p.cvc + 1, S.G, bid < S.G);
}
__device__ __forceinline__ void phase_prep(const Params& p, float* lds, int l, int bid, int nb) {
    const int tix = otid();
    const int tid = tix;
    {
        float* cst = lds;
        __syncthreads();
        for (int i = tid; i < 1024; i += NT) { const int pos = i >> 4, f = i & 15; float sn, cs; sincosf((float)pos * expf(-(float)f * (9.210340371976184f / 16.0f)), &sn, &cs); cst[i] = cs; cst[1024 + i] = sn; }
        __syncthreads();
        const int lane = tid & 63, wid = tid >> 6;
        const int tl = lane >> 3, dv = lane & 7, axis = dv >> 2, half = (dv >> 1) & 1, f0 = 8 * (dv & 1);
        bf16_t* Tw = (bf16_t*)(lds + 2048) + wid * (64 * 72);
        for (int wt = bid * 8 + wid; wt < NB * 12 * (TT / 64); wt += nb * 8) {
            const int tile = wt % (TT / 64), bh = wt / (TT / 64), b = bh / 12, hh = bh % 12, s0 = tile * 64;
#pragma unroll 2
            for (int i = 0; i < 8; ++i) {
                const int s = s0 + 8 * i + tl; const bf16_t* zr = p.z + (size_t)(b * TT + s) * ZLD + ZB + hh * 64 + 8 * dv;
                const uint4 q8 = *(const uint4*)zr, k8 = *(const uint4*)(zr + 768), v8 = *(const uint4*)(zr + 1536);
                *(uint4*)(p.Qa + ((size_t)bh * TT + s) * 64 + 8 * dv) = q8;
                const unsigned vw[4] = {v8.x, v8.y, v8.z, v8.w};
#pragma unroll
                for (int e = 0; e < 4; ++e) { Tw[(8 * dv + 2 * e) * 72 + 8 * i + tl] = (bf16_t)(vw[e] & 0xffffu); Tw[(8 * dv + 2 * e + 1) * 72 + 8 * i + tl] = (bf16_t)(vw[e] >> 16); }
                uint4 ko = k8;
                if (s >= LC) {
                    const int t = s - LC, pos = axis == 0 ? (t >> 6) : (t & 63);
                    const unsigned qw[4] = {q8.x, q8.y, q8.z, q8.w}, kw[4] = {k8.x, k8.y, k8.z, k8.w};
                    unsigned qo[4], kq[4];
#pragma unroll
                    for (int e = 0; e < 4; ++e) {
                        const unsigned qpw = (unsigned)bperm_i(lane ^ 2, (int)qw[e]), kpw = (unsigned)bperm_i(lane ^ 2, (int)kw[e]);
                        const float c0 = cst[pos * 16 + f0 + 2 * e], s0f = cst[1024 + pos * 16 + f0 + 2 * e], c1 = cst[pos * 16 + f0 + 2 * e + 1], s1f = cst[1024 + pos * 16 + f0 + 2 * e + 1];
                        const float qa0 = bfl(qw[e]), qa1 = bfh(qw[e]), qb0 = bfl(qpw), qb1 = bfh(qpw), ka0 = bfl(kw[e]), ka1 = bfh(kw[e]), kb0 = bfl(kpw), kb1 = bfh(kpw);
                        const float sg = half == 0 ? -1.f : 1.f;
                        qo[e] = pg8::cvt_pk_bf16(qa0 * c0 + sg * qb0 * s0f, qa1 * c1 + sg * qb1 * s1f);
                        kq[e] = pg8::cvt_pk_bf16(ka0 * c0 + sg * kb0 * s0f, ka1 * c1 + sg * kb1 * s1f);
                    }
                    *(uint4*)(p.Qr + ((size_t)bh * L + t) * 64 + 8 * dv) = make_uint4(qo[0], qo[1], qo[2], qo[3]);
                    ko = make_uint4(kq[0], kq[1], kq[2], kq[3]);
                }
                *(uint4*)(p.Ka + ((((size_t)bh * (TT / 16) + (s >> 4)) * 2 + (dv >> 2)) * 16 + (s & 15)) * 32 + 8 * (dv & 3)) = ko;
            }
            __builtin_amdgcn_wave_barrier();
#pragma unroll 2
            for (int i = 0; i < 8; ++i) {
                const int item = i * 64 + lane, q4 = item & 3, d = (item >> 2) & 63, blk = item >> 8;
                const uint2 lo = *(const uint2*)(Tw + d * 72 + blk * 32 + 4 * q4), hi = *(const uint2*)(Tw + d * 72 + blk * 32 + 16 + 4 * q4);
                *(uint4*)(p.Vt + (((size_t)bh * (TT / 32) + tile * 2 + blk) * 64 + d) * 32 + 8 * q4) = make_uint4(lo.x, lo.y, hi.x, hi.y); }
            __builtin_amdgcn_wave_barrier();
        }
        __syncthreads();
    }
    const float* cw = p.conv_w + (size_t)l * 3 * 512;
    for (int i = bid * NT + tid; i < M * 64; i += nb * NT) {
        const int ch = (i & 63) * 8, g = i >> 6, s = g % TT;
        const bf16_t* zr = p.z + (size_t)g * ZLD + ch;
        const uint4 bg = *(const uint4*)zr, cg = *(const uint4*)(zr + 512), hv = *(const uint4*)(zr + 1024);
        uint4 cgp = make_uint4(0u, 0u, 0u, 0u), hp = cgp, cgn = cgp, hn = cgp;
        if (s != 0 && s != LC) { cgp = *(const uint4*)(zr + 512 - ZLD); hp = *(const uint4*)(zr + 1024 - ZLD); }
        if (s != LC - 1 && s != TT - 1) { cgn = *(const uint4*)(zr + 512 + ZLD); hn = *(const uint4*)(zr + 1024 + ZLD); }
        const float4 w0a = *(const float4*)(cw + ch), w0b = *(const float4*)(cw + ch + 4), w1a = *(const float4*)(cw + 512 + ch), w1b = *(const float4*)(cw + 512 + ch + 4), w2a = *(const float4*)(cw + 1024 + ch), w2b = *(const float4*)(cw + 1024 + ch + 4);
        const float w0[8] = {w0a.x, w0a.y, w0a.z, w0a.w, w0b.x, w0b.y, w0b.z, w0b.w}, w1[8] = {w1a.x, w1a.y, w1a.z, w1a.w, w1b.x, w1b.y, w1b.z, w1b.w}, w2[8] = {w2a.x, w2a.y, w2a.z, w2a.w, w2b.x, w2b.y, w2b.z, w2b.w};
        const unsigned bgw[4] = {bg.x, bg.y, bg.z, bg.w}, cgw[4] = {cg.x, cg.y, cg.z, cg.w}, hw[4] = {hv.x, hv.y, hv.z, hv.w}, cpw[4] = {cgp.x, cgp.y, cgp.z, cgp.w}, hpw[4] = {hp.x, hp.y, hp.z, hp.w}, cnw[4] = {cgn.x, cgn.y, cgn.z, cgn.w}, hnw[4] = {hn.x, hn.y, hn.z, hn.w};
        unsigned o[4];
#pragma unroll
        for (int e = 0; e < 4; ++e) {
            const float r0 = bfl(bgw[e]) * (w0[2 * e] * bfl(cpw[e]) * bfl(hpw[e]) + w1[2 * e] * bfl(cgw[e]) * bfl(hw[e]) + w2[2 * e] * bfl(cnw[e]) * bfl(hnw[e]));
            const float r1 = bfh(bgw[e]) * (w0[2 * e + 1] * bfh(cpw[e]) * bfh(hpw[e]) + w1[2 * e + 1] * bfh(cgw[e]) * bfh(hw[e]) + w2[2 * e + 1] * bfh(cnw[e]) * bfh(hnw[e]));
            o[e] = pg8::cvt_pk_bf16(r0, r1);
        }
        *(uint4*)(p.mix + (size_t)g * D + ch) = make_uint4(o[0], o[1], o[2], o[3]);
    }
}

typedef short rw_bf16x8 __attribute__((ext_vector_type(8)));
typedef float rw_f32x4 __attribute__((ext_vector_type(4)));
constexpr int RLD = 72, FLD = 68, GLD = 104;
constexpr int RW_UNITS = NB * 12 * (TT / 64) * 2;
template <int K> __device__ __forceinline__ void mm_t(rw_f32x4 (&acc)[2], const bf16_t* A, int lda, const bf16_t* Bt, int ldb, int rb, int ch, int fr, int q) {
#pragma unroll
    for (int ks = 0; ks < K / 32; ++ks) {
        const rw_bf16x8 a = *(const rw_bf16x8*)(A + (16 * rb + fr) * lda + 32 * ks + 8 * q);
#pragma unroll
        for (int nt = 0; nt < 2; ++nt) { const rw_bf16x8 b = *(const rw_bf16x8*)(Bt + (32 * ch + 16 * nt + fr) * ldb + 32 * ks + 8 * q); acc[nt] = __builtin_amdgcn_mfma_f32_16x16x32_bf16(b, a, acc[nt], 0, 0, 0); }
    }
}
__device__ __forceinline__ bool rw_map(int tid, int n, int hh, int& kind, int& c8, int& col, int& rg) {
    const int w = __builtin_amdgcn_readfirstlane(tid >> 6), ln = tid & 63; rg = ln & 7; const int cvl = ln >> 3;
    if (w < 3) { kind = w; c8 = cvl * 8; col = w * 768 + hh * 64 + c8; return true; }
    if (w < 5) { kind = w; c8 = cvl * 8; col = (w == 3 ? 2400 : 2496) + n * 48 + c8; return cvl < 6; }
    if (w < 7) { kind = 5; const int cg = (w - 5) * 8 + cvl; c8 = cg * 8; col = 2304 + c8; return n == 0 && cg < 12; }
    kind = 6; c8 = 0; col = 0; return false;
}
struct RwPre { uint4 raw[10]; float4 m0a, m0b, m1a, m1b; };
__device__ __forceinline__ void rwkv_prefetch(const Params& p, int l, int unit, int tid, RwPre& P) {
    const int n = unit & 1, ci = (unit >> 1) % (TT / 64), bh = (unit >> 1) / (TT / 64), b = bh / 12, hh = bh % 12;
    const int segb = ci < 4 ? 0 : LC, sege = ci < 4 ? LC : TT, s0 = ci * 64;
    int kind, c8, col, rg; const bool act = rw_map(tid, n, hh, kind, c8, col, rg);
#pragma unroll
    for (int i = 0; i < 10; ++i) P.raw[i] = make_uint4(0u, 0u, 0u, 0u);
    if (unit < RW_UNITS && act) {
        const int j0 = 8 * rg;
        const int ta = n == 0 ? s0 + j0 : s0 + 63 - j0 - 7;
        const bf16_t* zp = p.z + (size_t)(b * TT + ta) * ZLD + ZC + col;
#pragma unroll
        for (int i = 0; i < 10; ++i) { const int tk = ta - 1 + i; if (tk >= segb && tk < sege) P.raw[i] = *(const uint4*)(zp + (ptrdiff_t)(i - 1) * ZLD); }
        const float* mu = p.rw_shift + (size_t)l * 2 * RWC;
        P.m0a = *(const float4*)(mu + col); P.m0b = *(const float4*)(mu + col + 4); P.m1a = *(const float4*)(mu + RWC + col); P.m1b = *(const float4*)(mu + RWC + col + 4);
    }
}
__device__ __forceinline__ void rwkv_unit(const Params& p, unsigned char* Lb, int l, int unit, int unit_next, RwPre& P) {
    const int tid = otid(), wid = tid >> 6, lane = tid & 63, rb = wid & 3, ch = wid >> 2, fr = lane & 15, q = lane >> 4;
    const int n = unit & 1, ci = (unit >> 1) % (TT / 64), bh = (unit >> 1) / (TT / 64), b = bh / 12, hh = bh % 12;
    const int segb = ci < 4 ? 0 : LC, sege = ci < 4 ? LC : TT, s0 = ci * 64;
    float* rf = (float*)Lb; float* kf = rf + 64 * FLD; float* red = kf + 64 * FLD;
    bf16_t* Aw = (bf16_t*)(Lb + 36864); bf16_t* Aa = Aw + 64 * RLD; bf16_t* Bw = Aa + 64 * RLD; bf16_t* Ba = Bw + 64 * RLD; bf16_t* Ag = Ba + 64 * RLD; bf16_t* Bg = Ag + 64 * GLD;
    bf16_t* Rt = (bf16_t*)(Lb + 36864); bf16_t* Kt = (bf16_t*)(Lb + 46080); bf16_t* Bt = (bf16_t*)(Lb + 55296); bf16_t* kap = (bf16_t*)(Lb + 64512);
    bf16_t* KtT = (bf16_t*)(Lb + 73728); bf16_t* BtT = (bf16_t*)(Lb + 82944); bf16_t* kapT = (bf16_t*)(Lb + 92160); bf16_t* VT = (bf16_t*)(Lb + 101376);
    float* btot = (float*)(Lb + 110592); float* GCv = btot + 256;
    bf16_t* Akk = (bf16_t*)(Lb + 27648); bf16_t* Ark = (bf16_t*)(Lb + 111872); bf16_t* Arb = (bf16_t*)(Lb + 121088); bf16_t* XT = (bf16_t*)(Lb + 130304);
    bf16_t* const Ms[2] = {(bf16_t*)(Lb + 0), (bf16_t*)(Lb + 46080)}; bf16_t* const MTs[2] = {(bf16_t*)(Lb + 9216), (bf16_t*)(Lb + 55296)}; bf16_t* const Ts[2] = {(bf16_t*)(Lb + 18432), (bf16_t*)(Lb + 64512)};
    const float* mu = p.rw_shift + (size_t)l * 2 * RWC;
    lds_barrier();
    float4 cst[2][5];
#pragma unroll
    for (int nt = 0; nt < 2; ++nt) { const int c = hh * 64 + 32 * ch + 16 * nt + 4 * q;
        cst[nt][0] = *(const float4*)(p.rw_k_k + (size_t)l * 768 + c); cst[nt][1] = *(const float4*)(p.rw_k_a + (size_t)l * 768 + c); cst[nt][2] = *(const float4*)(p.rw_r_k + (size_t)l * 768 + c);
        cst[nt][3] = *(const float4*)(p.rw_w0 + ((size_t)l * 2 + n) * 768 + c); cst[nt][4] = *(const float4*)(p.rw_a0 + ((size_t)l * 2 + n) * 768 + c); }
    const uint4* srcw = (const uint4*)(p.Lwa + (size_t)((l * 2 + n) * 12 + hh) * 2 * 64 * 72);
    const uint4* srcg = (const uint4*)(p.Lg + (size_t)(l * 12 + hh) * 64 * 104);
    const uint4 wv0 = srcw[tid], wv1 = srcw[tid + 512], wv2 = tid < 128 ? srcw[tid + 1024] : make_uint4(0u, 0u, 0u, 0u);
    uint4 gv0 = make_uint4(0u, 0u, 0u, 0u), gv1 = gv0; if (n == 0) { gv0 = srcg[tid]; if (tid < 320) gv1 = srcg[tid + 512]; }
    {
        int kind, c8, col, rg;
        if (rw_map(tid, n, hh, kind, c8, col, rg)) {
            const int j0 = 8 * rg;
            const int ta = n == 0 ? s0 + j0 : s0 + 63 - j0 - 7;
            const float m0[8] = {P.m0a.x, P.m0a.y, P.m0a.z, P.m0a.w, P.m0b.x, P.m0b.y, P.m0b.z, P.m0b.w}, m1[8] = {P.m1a.x, P.m1a.y, P.m1a.z, P.m1a.w, P.m1b.x, P.m1b.y, P.m1b.z, P.m1b.w};
            unsigned vpk[8][4];
#pragma unroll
            for (int i = 0; i < 8; ++i) {
                const int tk = ta + i, j = n == 0 ? tk - s0 : s0 + 63 - tk;
                const uint4 pu = P.raw[i], cu = P.raw[i + 1], nu = P.raw[i + 2];
                const unsigned pw[4] = {pu.x, pu.y, pu.z, pu.w}, cw[4] = {cu.x, cu.y, cu.z, cu.w}, nw[4] = {nu.x, nu.y, nu.z, nu.w};
                float x[8];
#pragma unroll
                for (int e = 0; e < 4; ++e) { const float c0 = bfl(cw[e]), c1 = bfh(cw[e]);
                    x[2 * e] = c0 + m0[2 * e] * (bfl(pw[e]) - c0) + m1[2 * e] * (bfl(nw[e]) - c0); x[2 * e + 1] = c1 + m0[2 * e + 1] * (bfh(pw[e]) - c1) + m1[2 * e + 1] * (bfh(nw[e]) - c1); }
                if (kind == 0) { *(float4*)(rf + j * FLD + c8) = make_float4(x[0], x[1], x[2], x[3]); *(float4*)(rf + j * FLD + c8 + 4) = make_float4(x[4], x[5], x[6], x[7]); }
                else if (kind == 1) { *(float4*)(kf + j * FLD + c8) = make_float4(x[0], x[1], x[2], x[3]); *(float4*)(kf + j * FLD + c8 + 4) = make_float4(x[4], x[5], x[6], x[7]); }
                else if (kind == 2) {
#pragma unroll
                    for (int e = 0; e < 8; ++e) { const unsigned hbits = (unsigned)f2bf(x[e]); vpk[e][i >> 1] = (i & 1) ? (vpk[e][i >> 1] | (hbits << 16)) : hbits; }
                    if (n == 0) { uint4 o; o.x = pg8::cvt_pk_bf16(x[0], x[1]); o.y = pg8::cvt_pk_bf16(x[2], x[3]); o.z = pg8::cvt_pk_bf16(x[4], x[5]); o.w = pg8::cvt_pk_bf16(x[6], x[7]);
                        *(uint4*)(p.rw_vb + ((size_t)(bh * (TT / 64) + ci) * 64 + j) * 64 + c8) = o; } }
                else {
                    bf16_t* dst = kind == 3 ? Aw + j * RLD + c8 : (kind == 4 ? Aa + j * RLD + c8 : Ag + j * GLD + c8);
                    if (kind == 3) {
#pragma unroll
                        for (int e = 0; e < 8; ++e) x[e] = 1.0f - 2.0f * __builtin_amdgcn_rcpf(1.0f + __builtin_amdgcn_exp2f(2.8853900817779268f * x[e])); }
                    else if (kind == 5) {
#pragma unroll
                        for (int e = 0; e < 8; ++e) x[e] = __builtin_amdgcn_rcpf(1.0f + __builtin_amdgcn_exp2f(-1.4426950408889634f * x[e])); }
                    uint4 o; o.x = pg8::cvt_pk_bf16(x[0], x[1]); o.y = pg8::cvt_pk_bf16(x[2], x[3]); o.z = pg8::cvt_pk_bf16(x[4], x[5]); o.w = pg8::cvt_pk_bf16(x[6], x[7]); *(uint4*)dst = o;
                }
            }
            if (kind == 2) {
#pragma unroll
                for (int e = 0; e < 8; ++e) { uint4 o = make_uint4(vpk[e][0], vpk[e][1], vpk[e][2], vpk[e][3]);
                    if (n != 0) o = make_uint4((o.w << 16) | (o.w >> 16), (o.z << 16) | (o.z >> 16), (o.y << 16) | (o.y >> 16), (o.x << 16) | (o.x >> 16));
                    *(uint4*)(VT + (c8 + e) * RLD + j0) = o; }
            }
        }
    }
    for (int i = tid; i < 64 * 16; i += NT) { const int j = i >> 4, c = 48 + (i & 15); Aw[j * RLD + c] = 0; Aa[j * RLD + c] = 0; }
    { uint4* dw = (uint4*)Bw; dw[tid] = wv0; dw[tid + 512] = wv1; if (tid < 128) dw[tid + 1024] = wv2;
      if (n == 0) { uint4* dg = (uint4*)Bg; dg[tid] = gv0; if (tid < 320) dg[tid + 512] = gv1; } }
    rwkv_prefetch(p, l, unit_next, tid, P);
    lds_barrier();
    rw_f32x4 accw[2], acca[2], accg[2];
#pragma unroll
    for (int nt = 0; nt < 2; ++nt) { accw[nt] = (rw_f32x4){0.f, 0.f, 0.f, 0.f}; acca[nt] = accw[nt]; accg[nt] = accw[nt]; }
    mm_t<64>(accw, Aw, RLD, Bw, RLD, rb, ch, fr, q);
    mm_t<64>(acca, Aa, RLD, Ba, RLD, rb, ch, fr, q);
    if (n == 0) mm_t<96>(accg, Ag, GLD, Bg, GLD, rb, ch, fr, q);
    const int t = 16 * rb + fr, s = n == 0 ? s0 + t : s0 + 63 - t, g = b * TT + s;
    float kv[2][4], rv[2][4], kkr[2][4], av[2][4], lw[2][4], kd[2][4], G[2][4]; float ssq = 0.f, bon = 0.f;
#pragma unroll
    for (int nt = 0; nt < 2; ++nt) {
        const int c = 32 * ch + 16 * nt + 4 * q;
        const float4 k4 = *(const float4*)(kf + t * FLD + c), r4 = *(const float4*)(rf + t * FLD + c);
        const float4 kk4 = cst[nt][0], ka4 = cst[nt][1], rk4 = cst[nt][2], w04 = cst[nt][3], a04 = cst[nt][4];
        const float ke[4] = {k4.x, k4.y, k4.z, k4.w}, re[4] = {r4.x, r4.y, r4.z, r4.w}, kke[4] = {kk4.x, kk4.y, kk4.z, kk4.w}, kae[4] = {ka4.x, ka4.y, ka4.z, ka4.w}, rke[4] = {rk4.x, rk4.y, rk4.z, rk4.w}, w0e[4] = {w04.x, w04.y, w04.z, w04.w}, a0e[4] = {a04.x, a04.y, a04.z, a04.w};
#pragma unroll
        for (int j = 0; j < 4; ++j) {
            kv[nt][j] = ke[j]; rv[nt][j] = re[j]; kkr[nt][j] = ke[j] * kke[j]; ssq += kkr[nt][j] * kkr[nt][j];
            const float wpre = w0e[j] + accw[nt][j]; lw[nt][j] = -0.6065306597126334f * __builtin_amdgcn_rcpf(1.0f + __expf(-wpre));
            av[nt][j] = __builtin_amdgcn_rcpf(1.0f + __expf(-(a0e[j] + acca[nt][j])));
            kd[nt][j] = ke[j] * (1.0f + (av[nt][j] - 1.0f) * kae[j]); bon += re[j] * kd[nt][j] * rke[j];
            float x = lw[nt][j];
            x += __int_as_float(__builtin_amdgcn_update_dpp(0, __float_as_int(x), 0x111, 0xF, 0xF, true)); x += __int_as_float(__builtin_amdgcn_update_dpp(0, __float_as_int(x), 0x112, 0xF, 0xF, true));
            x += __int_as_float(__builtin_amdgcn_update_dpp(0, __float_as_int(x), 0x114, 0xF, 0xF, true)); x += __int_as_float(__builtin_amdgcn_update_dpp(0, __float_as_int(x), 0x118, 0xF, 0xF, true));
            G[nt][j] = x; if (fr == 15) btot[rb * 64 + c + j] = x;
        }
    }
    ssq += bperm_f(lane ^ 16, ssq); ssq += bperm_f(lane ^ 32, ssq); bon += bperm_f(lane ^ 16, bon); bon += bperm_f(lane ^ 32, bon);
    if (q == 0) { red[ch * 64 + t] = ssq; red[128 + ch * 64 + t] = bon; }
    lds_barrier();
    const float rnorm = 1.0f / fmaxf(sqrtf(red[t] + red[64 + t]), 1e-12f);
    if (ch == 0 && q == 0) p.bonus[((size_t)n * M + g) * 12 + hh] = red[128 + t] + red[192 + t];
    const size_t uoff = (size_t)unit * 4096;
#pragma unroll
    for (int nt = 0; nt < 2; ++nt)
#pragma unroll
        for (int j = 0; j < 4; ++j) { const int c = 32 * ch + 16 * nt + 4 * q + j; float pre = 0.f, tot = 0.f;
#pragma unroll
            for (int r2 = 0; r2 < 4; ++r2) { const float bt = btot[r2 * 64 + c]; tot += bt; if (r2 < rb) pre += bt; }
            G[nt][j] += pre; if (t == 63) GCv[c] = __expf(tot); }
#pragma unroll
    for (int nt = 0; nt < 2; ++nt) {
        const int c = 32 * ch + 16 * nt + 4 * q;
        float rt[4], kt[4], bt[4], kp[4];
#pragma unroll
        for (int j = 0; j < 4; ++j) { const float gam = __expf(G[nt][j]), ig = __expf(-G[nt][j]), gp = __expf(G[nt][j] - lw[nt][j]); const float kk = kkr[nt][j] * rnorm;
            rt[j] = rv[nt][j] * gam; kt[j] = kd[nt][j] * ig; bt[j] = kk * av[nt][j] * ig; kp[j] = kk * gp;
            KtT[(c + j) * RLD + t] = f2bf(kt[j]); BtT[(c + j) * RLD + t] = f2bf(bt[j]); kapT[(c + j) * RLD + t] = f2bf(kp[j]); }
        uint2 o; o.x = pg8::cvt_pk_bf16(rt[0], rt[1]); o.y = pg8::cvt_pk_bf16(rt[2], rt[3]); *(uint2*)(Rt + t * RLD + c) = o;
        o.x = pg8::cvt_pk_bf16(kt[0], kt[1]); o.y = pg8::cvt_pk_bf16(kt[2], kt[3]); *(uint2*)(Kt + t * RLD + c) = o;
        o.x = pg8::cvt_pk_bf16(bt[0], bt[1]); o.y = pg8::cvt_pk_bf16(bt[2], bt[3]); *(uint2*)(Bt + t * RLD + c) = o;
        o.x = pg8::cvt_pk_bf16(kp[0], kp[1]); o.y = pg8::cvt_pk_bf16(kp[2], kp[3]); *(uint2*)(kap + t * RLD + c) = o;
        if (n == 0) { o.x = pg8::cvt_pk_bf16(accg[nt][0], accg[nt][1]); o.y = pg8::cvt_pk_bf16(accg[nt][2], accg[nt][3]); *(uint2*)(p.rw_gb + ((size_t)(bh * (TT / 64) + ci) * 64 + t) * 64 + c) = o; }
    }
    lds_barrier();
#define RW_ZERO(a) do { a[0] = (rw_f32x4){0.f, 0.f, 0.f, 0.f}; a[1] = a[0]; } while (0)
#define RW_STORE_BF(dst, a) do { _Pragma("unroll") for (int _nt = 0; _nt < 2; ++_nt) { uint2 _o; _o.x = pg8::cvt_pk_bf16(a[_nt][0], a[_nt][1]); _o.y = pg8::cvt_pk_bf16(a[_nt][2], a[_nt][3]); \
        *(uint2*)((dst) + t * RLD + 32 * ch + 16 * _nt + 4 * q) = _o; } } while (0)
    { rw_f32x4 a1[2], a2[2], a3[2], a4[2], a5[2]; RW_ZERO(a1); RW_ZERO(a2); RW_ZERO(a3); RW_ZERO(a4); RW_ZERO(a5);
      mm_t<64>(a1, kap, RLD, Bt, RLD, rb, ch, fr, q);
      mm_t<64>(a2, Bt, RLD, kap, RLD, rb, ch, fr, q);
      mm_t<64>(a3, kap, RLD, Kt, RLD, rb, ch, fr, q);
      mm_t<64>(a4, Rt, RLD, Kt, RLD, rb, ch, fr, q);
      mm_t<64>(a5, Rt, RLD, Bt, RLD, rb, ch, fr, q);
      rw_f32x4 t1[2];
#pragma unroll
      for (int nt = 0; nt < 2; ++nt)
#pragma unroll
          for (int j = 0; j < 4; ++j) { const int cc = 32 * ch + 16 * nt + 4 * q + j;
              a1[nt][j] = cc < t ? -a1[nt][j] : 0.f; t1[nt][j] = a1[nt][j] + (cc == t ? 1.f : 0.f);
              a2[nt][j] = t < cc ? -a2[nt][j] : 0.f;
              a3[nt][j] = cc < t ? a3[nt][j] : 0.f; a4[nt][j] = cc <= t ? a4[nt][j] : 0.f; a5[nt][j] = cc <= t ? a5[nt][j] : 0.f; }
      RW_STORE_BF(Ms[0], a1); RW_STORE_BF(MTs[0], a2); RW_STORE_BF(Ts[0], t1); RW_STORE_BF(Akk, a3); RW_STORE_BF(Ark, a4); RW_STORE_BF(Arb, a5); }
    lds_barrier();
    { rw_f32x4 a1[2], a2[2], a3[2]; RW_ZERO(a1); RW_ZERO(a2); RW_ZERO(a3);
      mm_t<64>(a1, VT, RLD, Akk, RLD, rb, ch, fr, q);
      mm_t<64>(a2, Ms[0], RLD, MTs[0], RLD, rb, ch, fr, q);
      mm_t<64>(a3, MTs[0], RLD, Ms[0], RLD, rb, ch, fr, q);
      RW_STORE_BF(XT, a1); RW_STORE_BF(Ms[1], a2); RW_STORE_BF(MTs[1], a3); }
    lds_barrier();
#pragma unroll
    for (int k = 1; k <= 5; ++k) {
        const bf16_t* Tk = Ts[(k + 1) & 1]; bf16_t* Tn = Ts[k & 1];
        rw_f32x4 a1[2]; RW_ZERO(a1);
        mm_t<64>(a1, Tk, RLD, MTs[k & 1], RLD, rb, ch, fr, q);
#pragma unroll
        for (int nt = 0; nt < 2; ++nt) { const uint2 o = *(const uint2*)(Tk + t * RLD + 32 * ch + 16 * nt + 4 * q); a1[nt][0] += bfl(o.x); a1[nt][1] += bfh(o.x); a1[nt][2] += bfl(o.y); a1[nt][3] += bfh(o.y); }
        RW_STORE_BF(Tn, a1);
        if (k < 5) { rw_f32x4 a2[2], a3[2]; RW_ZERO(a2); RW_ZERO(a3);
            mm_t<64>(a2, Ms[k & 1], RLD, MTs[k & 1], RLD, rb, ch, fr, q);
            mm_t<64>(a3, MTs[k & 1], RLD, Ms[k & 1], RLD, rb, ch, fr, q);
            RW_STORE_BF(Ms[(k + 1) & 1], a2); RW_STORE_BF(MTs[(k + 1) & 1], a3); }
        lds_barrier();
    }
    { rw_f32x4 a1[2], a2[2]; RW_ZERO(a1); RW_ZERO(a2);
      mm_t<64>(a1, kapT, RLD, Ts[1], RLD, rb, ch, fr, q);
      mm_t<64>(a2, XT, RLD, Ts[1], RLD, rb, ch, fr, q);
      RW_STORE_BF(Ms[0], a1); RW_STORE_BF(MTs[0], a2); }
    lds_barrier();
    { const bf16_t* WT = Ms[0]; const bf16_t* U0T = MTs[0];
      rw_f32x4 a1[2]; RW_ZERO(a1); mm_t<64>(a1, BtT, RLD, WT, RLD, rb, ch, fr, q);
      { const float gc = GCv[t];
#pragma unroll
        for (int nt = 0; nt < 2; ++nt) { uint2 o; float e[4];
#pragma unroll
            for (int j = 0; j < 4; ++j) e[j] = gc * ((32 * ch + 16 * nt + 4 * q + j == t ? 1.f : 0.f) - a1[nt][j]);
            o.x = pg8::cvt_pk_bf16(e[0], e[1]); o.y = pg8::cvt_pk_bf16(e[2], e[3]); *(uint2*)(p.rw_P + uoff + t * 64 + 32 * ch + 16 * nt + 4 * q) = o; } }
      rw_f32x4 a2[2], a3[2]; RW_ZERO(a2); RW_ZERO(a3); mm_t<64>(a2, VT, RLD, KtT, RLD, rb, ch, fr, q); mm_t<64>(a3, U0T, RLD, BtT, RLD, rb, ch, fr, q);
#pragma unroll
      for (int nt = 0; nt < 2; ++nt) { const int c = 32 * ch + 16 * nt + 4 * q; const float4 gc4 = *(const float4*)(GCv + c);
          *(float4*)(p.rw_QT + uoff + t * 64 + c) = make_float4(gc4.x * (a2[nt][0] - a3[nt][0]), gc4.y * (a2[nt][1] - a3[nt][1]), gc4.z * (a2[nt][2] - a3[nt][2]), gc4.w * (a2[nt][3] - a3[nt][3])); }
      rw_f32x4 a4[2]; RW_ZERO(a4); mm_t<64>(a4, Arb, RLD, WT, RLD, rb, ch, fr, q);
#pragma unroll
      for (int nt = 0; nt < 2; ++nt) { const int c = 32 * ch + 16 * nt + 4 * q; const uint2 r2 = *(const uint2*)(Rt + t * RLD + c); uint2 o;
          o.x = pg8::cvt_pk_bf16(bfl(r2.x) - a4[nt][0], bfh(r2.x) - a4[nt][1]); o.y = pg8::cvt_pk_bf16(bfl(r2.y) - a4[nt][2], bfh(r2.y) - a4[nt][3]); *(uint2*)(p.rw_Ry + uoff + t * 64 + c) = o; }
      rw_f32x4 a5[2], a6[2]; RW_ZERO(a5); RW_ZERO(a6); mm_t<64>(a5, Ark, RLD, VT, RLD, rb, ch, fr, q); mm_t<64>(a6, Arb, RLD, U0T, RLD, rb, ch, fr, q);
#pragma unroll
      for (int nt = 0; nt < 2; ++nt) { const int c = 32 * ch + 16 * nt + 4 * q; *(float4*)(p.rw_Y0 + uoff + t * 64 + c) = make_float4(a5[nt][0] - a6[nt][0], a5[nt][1] - a6[nt][1], a5[nt][2] - a6[nt][2], a5[nt][3] - a6[nt][3]); } }
#undef RW_ZERO
#undef RW_STORE_BF
}

__device__ __forceinline__ void rwkv_chain(const Params& p, unsigned char* Lb, int chain) {
    const int tid = otid(), wid = tid >> 6, lane = tid & 63, rb = wid & 3, ch = wid >> 2, fr = lane & 15, q = lane >> 4;
    const int n = chain / 48, bh = chain % 48;
    bf16_t* HT[2] = {(bf16_t*)Lb, (bf16_t*)(Lb + 9216)};
    rw_f32x4 hacc[2];
    hacc[0] = (rw_f32x4){0.f, 0.f, 0.f, 0.f}; hacc[1] = hacc[0];
    __syncthreads();
    auto uoff_of = [&](int step) { const int ci = n == 0 ? step : (step < 4 ? 3 - step : (TT / 64 - 1) - (step - 4)); return (size_t)(((bh * (TT / 64) + ci) << 1) | n) * 4096; };
    struct Ops { rw_bf16x8 p0, p1; float4 q0, q1; };
    auto load_ops = [&](int step, Ops& o) { const size_t uo = uoff_of(step); const bf16_t* Pp = p.rw_P + uo + (16 * rb + fr) * 64 + 8 * q; o.p0 = *(const rw_bf16x8*)Pp; o.p1 = *(const rw_bf16x8*)(Pp + 32);
        o.q0 = *(const float4*)(p.rw_QT + uo + (32 * ch + fr) * 64 + 16 * rb + 4 * q); o.q1 = *(const float4*)(p.rw_QT + uo + (32 * ch + 16 + fr) * 64 + 16 * rb + 4 * q); };
    auto do_step = [&](int step, const Ops& o) {
        const size_t uoff = uoff_of(step);
        bf16_t* hb = HT[step & 1];
#pragma unroll
        for (int nt = 0; nt < 2; ++nt) { uint2 w; w.x = pg8::cvt_pk_bf16(hacc[nt][0], hacc[nt][1]); w.y = pg8::cvt_pk_bf16(hacc[nt][2], hacc[nt][3]);
            const int v = 32 * ch + 16 * nt + fr, k0 = 16 * rb + 4 * q;
            *(uint2*)(hb + v * RLD + k0) = w; *(uint2*)(p.rw_H0 + uoff + v * 64 + k0) = w; }
        lds_barrier();
#pragma unroll
        for (int nt = 0; nt < 2; ++nt) {
            const bf16_t* bp = hb + (32 * ch + 16 * nt + fr) * RLD + 8 * q;
            const rw_bf16x8 b0 = *(const rw_bf16x8*)bp, b1 = *(const rw_bf16x8*)(bp + 32);
            const float4 cq = nt == 0 ? o.q0 : o.q1;
            rw_f32x4 c = (rw_f32x4){cq.x, cq.y, cq.z, cq.w};
            c = __builtin_amdgcn_mfma_f32_16x16x32_bf16(o.p0, b0, c, 0, 0, 0);
            hacc[nt] = __builtin_amdgcn_mfma_f32_16x16x32_bf16(o.p1, b1, c, 0, 0, 0);
        }
    };
    Ops A, B; load_ops(0, A); load_ops(1, B);
    for (int step = 0; step < TT / 64; step += 2) {
        do_step(step, A); if (step + 2 < TT / 64) load_ops(step + 2, A);
        do_step(step + 1, B); if (step + 3 < TT / 64) load_ops(step + 3, B);
    }
}

__device__ __forceinline__ void rwkv_out(const Params& p, unsigned char* Lb, int l, int unit3) {
    const int tid = otid(), wid = tid >> 6, lane = tid & 63, rb = wid & 3, ch = wid >> 2, fr = lane & 15, q = lane >> 4;
    const int ci = unit3 % (TT / 64), bh = unit3 / (TT / 64), b = bh / 12, hh = bh % 12;
    float* red = (float*)Lb;
    const int t = 16 * rb + fr, g = b * TT + ci * 64 + t;
    rw_f32x4 y[2]; y[0] = (rw_f32x4){0.f, 0.f, 0.f, 0.f}; y[1] = y[0];
#pragma unroll
    for (int n = 0; n < 2; ++n) {
        const size_t uoff = (size_t)(((bh * (TT / 64) + ci) << 1) | n) * 4096;
        const int row = n == 0 ? t : 63 - t;
        const bf16_t* ap = p.rw_Ry + uoff + row * 64 + 8 * q;
        const rw_bf16x8 a0 = *(const rw_bf16x8*)ap, a1 = *(const rw_bf16x8*)(ap + 32);
#pragma unroll
        for (int nt = 0; nt < 2; ++nt) {
            const int c = 32 * ch + 16 * nt;
            const bf16_t* bp = p.rw_H0 + uoff + (c + fr) * 64 + 8 * q;
            const rw_bf16x8 b0 = *(const rw_bf16x8*)bp, b1 = *(const rw_bf16x8*)(bp + 32);
            const float4 y0 = *(const float4*)(p.rw_Y0 + uoff + row * 64 + c + 4 * q);
            rw_f32x4 acc = (rw_f32x4){y0.x, y0.y, y0.z, y0.w};
            acc = __builtin_amdgcn_mfma_f32_16x16x32_bf16(b0, a0, acc, 0, 0, 0);
            acc = __builtin_amdgcn_mfma_f32_16x16x32_bf16(b1, a1, acc, 0, 0, 0);
            y[nt] += acc;
        }
    }
    float s1 = 0.f, s2 = 0.f;
#pragma unroll
    for (int nt = 0; nt < 2; ++nt)
#pragma unroll
        for (int j = 0; j < 4; ++j) { s1 += y[nt][j]; s2 += y[nt][j] * y[nt][j]; }
    s1 += bperm_f(lane ^ 16, s1); s1 += bperm_f(lane ^ 32, s1); s2 += bperm_f(lane ^ 16, s2); s2 += bperm_f(lane ^ 32, s2);
    __syncthreads();
    if (q == 0) { red[ch * 64 + t] = s1; red[128 + ch * 64 + t] = s2; }
    __syncthreads();
    const float mean = (red[t] + red[64 + t]) * (1.0f / 64.0f), var = fmaxf((red[128 + t] + red[192 + t]) * (1.0f / 64.0f) - mean * mean, 0.f), rstd = rsqrtf(var + 64e-5f);
    const float bon = p.bonus[(size_t)g * 12 + hh] + p.bonus[((size_t)M + g) * 12 + hh];
    const float* gng = p.rw_gn_g + (size_t)l * 768 + hh * 64; const float* gnb = p.rw_gn_b + (size_t)l * 768 + hh * 64;
    const size_t coff = ((size_t)(bh * (TT / 64) + ci) * 64 + t) * 64;
#pragma unroll
    for (int nt = 0; nt < 2; ++nt) {
        const int c = 32 * ch + 16 * nt + 4 * q;
        const float4 gg = *(const float4*)(gng + c), gb = *(const float4*)(gnb + c);
        const uint2 vv = *(const uint2*)(p.rw_vb + coff + c), gt = *(const uint2*)(p.rw_gb + coff + c);
        const float o0 = ((y[nt][0] - mean) * rstd * gg.x + gb.x + bon * bfl(vv.x)) * bfl(gt.x), o1 = ((y[nt][1] - mean) * rstd * gg.y + gb.y + bon * bfh(vv.x)) * bfh(gt.x);
        const float o2 = ((y[nt][2] - mean) * rstd * gg.z + gb.z + bon * bfl(vv.y)) * bfl(gt.y), o3 = ((y[nt][3] - mean) * rstd * gg.w + gb.w + bon * bfh(vv.y)) * bfh(gt.y);
        uint2 o; o.x = pg8::cvt_pk_bf16(o0, o1); o.y = pg8::cvt_pk_bf16(o2, o3);
        *(uint2*)(p.mix + (size_t)g * D + 1280 + hh * 64 + c) = o;
    }
}

typedef short attn_bf16x8 __attribute__((ext_vector_type(8)));
typedef float attn_f32x4 __attribute__((ext_vector_type(4)));
constexpr int ATT_LAT = NB * 12 * 64 * 4, ATT_CTX = NB * 12 * (LC / 16), ATT_TASKS = ATT_LAT + ATT_CTX;
__device__ __forceinline__ attn_bf16x8 ld_frag16(const bf16_t* ptr) { return *(const attn_bf16x8*)ptr; }
__device__ __forceinline__ attn_bf16x8 ld_frag8x2(const bf16_t* p0, const bf16_t* p1) {
    const uint2 a = *(const uint2*)p0, b = *(const uint2*)p1; uint4 r; r.x = a.x; r.y = a.y; r.z = b.x; r.w = b.y; return *(const attn_bf16x8*)&r; }
struct AttnFrag { attn_bf16x8 k[2][2]; attn_bf16x8 v[4]; };
__device__ __forceinline__ void attn_load(AttnFrag& F, const bf16_t* Kh  , const bf16_t* Vh  , int s0  , int qi, int q) {
#pragma unroll
    for (int t = 0; t < 2; ++t)
#pragma unroll
        for (int ks = 0; ks < 2; ++ks) F.k[t][ks] = ld_frag16(Kh + ((size_t)(((s0 >> 4) + t) * 2 + ks) * 16 + qi) * 32 + 8 * q);
#pragma unroll
    for (int db = 0; db < 4; ++db) F.v[db] = ld_frag16(Vh + ((size_t)(s0 >> 5) * 64 + 16 * db + qi) * 32 + 8 * q);
}
__device__ __forceinline__ void attn_compute(const AttnFrag& F, const attn_bf16x8 (&qf)[2], int lane, float& m, float& l, attn_f32x4 (&oacc)[4],
                                             bool win, const float* brow  , unsigned vmask  , const int (&boff)[8]) {
    attn_f32x4 st[2];
#pragma unroll
    for (int t = 0; t < 2; ++t) {
        attn_f32x4 z4 = {0.f, 0.f, 0.f, 0.f};
        z4 = __builtin_amdgcn_mfma_f32_16x16x32_bf16(F.k[t][0], qf[0], z4, 0, 0, 0);
        st[t] = __builtin_amdgcn_mfma_f32_16x16x32_bf16(F.k[t][1], qf[1], z4, 0, 0, 0);
    }
    float sc[8]; float mx = -1e30f;
#pragma unroll
    for (int i = 0; i < 8; ++i) {
        float s = st[i >> 2][i & 3] * 0.18033688011112042f;
        if (win) s = ((vmask >> i) & 1u) ? s + brow[boff[i]] : -1e30f;
        sc[i] = s; mx = fmaxf(mx, s);
    }
    mx = fmaxf(mx, bperm_f(lane ^ 16, mx)); mx = fmaxf(mx, bperm_f(lane ^ 32, mx));
    if (__any(mx > m)) {
        const float mn = fmaxf(m, mx), alpha = __builtin_amdgcn_exp2f(m - mn);
        l *= alpha; m = mn;
#pragma unroll
        for (int db = 0; db < 4; ++db) oacc[db] *= alpha;
    }
    float ps = 0.f; float pv[8];
#pragma unroll
    for (int i = 0; i < 8; ++i) { pv[i] = __builtin_amdgcn_exp2f(sc[i] - m); ps += pv[i]; }
    l += ps;
    uint4 pk; pk.x = pg8::cvt_pk_bf16(pv[0], pv[1]); pk.y = pg8::cvt_pk_bf16(pv[2], pv[3]); pk.z = pg8::cvt_pk_bf16(pv[4], pv[5]); pk.w = pg8::cvt_pk_bf16(pv[6], pv[7]);
    const attn_bf16x8 pb = *(const attn_bf16x8*)&pk;
#pragma unroll
    for (int db = 0; db < 4; ++db) oacc[db] = __builtin_amdgcn_mfma_f32_16x16x32_bf16(F.v[db], pb, oacc[db], 0, 0, 0);
}
constexpr int ATT_LAT2 = NB * 12 * 64 * 2, ATT_CTX2 = NB * 12 * (LC / 32), ATT_TASKS2 = ATT_LAT2 + ATT_CTX2;
__device__ __forceinline__ void attn_task2(const Params& p, const float* rpbs  , int task) {
    const int lane = otid() & 63, qi = lane & 15, q = lane >> 4;
    const bool lat = task < ATT_LAT2;
    int bh, qrow = 0, qp;
    if (lat) { bh = task >> 7; const int rem = task & 127; qrow = rem >> 1; qp = rem & 1; }
    else { const int t2 = task - ATT_LAT2; bh = t2 >> 3; qp = t2 & 7; }
    const int b = bh / 12, hh = bh % 12;
    const bf16_t* Kh = p.Ka + (size_t)bh * TT * 64; const bf16_t* Vh = p.Vt + (size_t)bh * 64 * TT;
    int sq[2]; attn_bf16x8 qa[2][2], qr[2][2];
#pragma unroll
    for (int u = 0; u < 2; ++u) {
        sq[u] = lat ? LC + qrow * 64 + (2 * qp + u) * 16 + qi : (2 * qp + u) * 16 + qi;
        const bf16_t* qp0 = p.Qa + ((size_t)bh * TT + sq[u]) * 64 + 8 * q; qa[u][0] = ld_frag16(qp0); qa[u][1] = ld_frag16(qp0 + 32); qr[u][0] = qa[u][0]; qr[u][1] = qa[u][1];
        if (lat) { const bf16_t* qp1 = p.Qr + ((size_t)bh * L + (sq[u] - LC)) * 64 + 8 * q; qr[u][0] = ld_frag16(qp1); qr[u][1] = ld_frag16(qp1 + 32); }
    }
    const int krow0 = min(max(qrow - 4, 0), 56);
    bool need0[2], need1[2]; unsigned vm0[2], vm1[2]; int boff[2][8];
#pragma unroll
    for (int u = 0; u < 2; ++u) { const int qb = 2 * qp + u, qc = qb * 16 + qi, kcol0 = min(max(qc - 8, 0), 48);
        const int clo = min(max(qb * 16 - 8, 0), 48), chi = min(max(qb * 16 + 7, 0), 48) + 16; need0[u] = clo < 32; need1[u] = chi > 32; vm0[u] = 0u; vm1[u] = 0u;
#pragma unroll
        for (int i = 0; i < 8; ++i) { const int kc = 16 * (i >> 2) + 4 * q + (i & 3); boff[u][i] = kc - qc + 15; vm0[u] |= ((unsigned)(kc - kcol0) < 16u ? 1u : 0u) << i; vm1[u] |= ((unsigned)(kc + 32 - kcol0) < 16u ? 1u : 0u) << i; } }
    const bool cb0 = need0[0] || need0[1], cb1 = need1[0] || need1[1]; const int ncb = (cb0 && cb1) ? 2 : 1, cbo = cb0 ? 0 : 1;
    const int nsteps = lat ? 8 + 8 * ncb : 8;
    float m[2] = {-1e30f, -1e30f}, l[2] = {0.f, 0.f}; attn_f32x4 oacc[2][4];
#pragma unroll
    for (int u = 0; u < 2; ++u)
#pragma unroll
        for (int db = 0; db < 4; ++db) oacc[u][db] = (attn_f32x4){0.f, 0.f, 0.f, 0.f};
#define ATT_S0(s, s0v, krv, cbv) do { if ((s) < 8) { s0v = (s) * 32; krv = 0; cbv = 0; } else { const int _w = (s) - 8; krv = ncb == 2 ? (_w >> 1) : _w; cbv = ncb == 2 ? (_w & 1) : cbo; s0v = LC + (krow0 + krv) * 64 + cbv * 32; } } while (0)
#define ATT_LOAD(F, s) do { int _s0, _kr, _cb; ATT_S0((s), _s0, _kr, _cb); attn_load(F, Kh, Vh, _s0, qi, q); } while (0)
#define ATT_COMP(F, s) do { int _s0, _kr, _cb; ATT_S0((s), _s0, _kr, _cb); const bool _w = (s) >= 8; const float* _br = rpbs + hh * 465 + (krow0 + _kr - qrow + 7) * 31; \
        _Pragma("unroll") for (int u = 0; u < 2; ++u) if (!_w || (_cb == 0 ? need0[u] : need1[u])) attn_compute(F, _w ? qr[u] : qa[u], lane, m[u], l[u], oacc[u], _w, _br + _cb * 32, _cb ? vm1[u] : vm0[u], boff[u]); } while (0)
    AttnFrag FA, FB;
    ATT_LOAD(FA, 0);
    for (int s = 0; s < nsteps; s += 2) {
        ATT_LOAD(FB, s + 1);
        ATT_COMP(FA, s);
        if (s + 2 < nsteps) ATT_LOAD(FA, s + 2);
        ATT_COMP(FB, s + 1);
    }
#undef ATT_S0
#undef ATT_LOAD
#undef ATT_COMP
#pragma unroll
    for (int u = 0; u < 2; ++u) {
        float lt = l[u]; lt += bperm_f(lane ^ 16, lt); lt += bperm_f(lane ^ 32, lt);
        const float rinv = 1.0f / lt;
        bf16_t* op = p.mix + (size_t)(b * TT + sq[u]) * D + 512 + hh * 64 + 4 * q;
#pragma unroll
        for (int db = 0; db < 4; ++db) { uint2 w; w.x = pg8::cvt_pk_bf16(oacc[u][db][0] * rinv, oacc[u][db][1] * rinv); w.y = pg8::cvt_pk_bf16(oacc[u][db][2] * rinv, oacc[u][db][3] * rinv); *(uint2*)(op + 16 * db) = w; }
    }
}

constexpr int RT_LD = 2052;
__device__ __forceinline__ void phase_router(const Params& p, unsigned char* Lb, int l, int bid, int nb) {
    const int tix = otid(), wid = tix >> 6, lane = tix & 63;
    float* At = (float*)Lb;
    float* Pp = At + 16 * RT_LD;
    int* ent = (int*)(Pp + 2 * 16 * 64);
    int* lcnt = ent + 480 * 4; int* lbase = lcnt + 64;
    const float* gam = p.norm2_g + (size_t)l * D;
    __syncthreads();
    if (tix < 64) lcnt[tix] = 0;
    int nloc = 0;
    const bool latonly = (l == 1);
    const int ntiles = latonly ? NB * L / 16 : M / 16;
    const float rbias = p.router_bias[l * NEXP + lane];
    float4 vx[2][8];
#define RT_G0(t) (latonly ? ((t) >> 8) * TT + LC + ((t) & 255) * 16 : (t) * 16)
#define RT_ISSUE(t) do { const float* _x = p.xcur + (size_t)(RT_G0(t) + 2 * wid) * D; _Pragma("unroll") for (int _r = 0; _r < 2; ++_r) _Pragma("unroll") for (int _i = 0; _i < 8; ++_i) vx[_r][_i] = *(const float4*)(_x + (size_t)_r * D + (_i * 64 + lane) * 4); } while (0)
    if (bid < ntiles) RT_ISSUE(bid);
    for (int tile = bid; tile < ntiles; tile += nb, ++nloc) {
        const int g0 = RT_G0(tile);
        lds_barrier();
        uint2 hpk[2][8];
        {
            float rsv[2];
#pragma unroll
            for (int rr = 0; rr < 2; ++rr) { float ss = 0.f;
#pragma unroll
                for (int i = 0; i < 8; ++i) ss += vx[rr][i].x * vx[rr][i].x + vx[rr][i].y * vx[rr][i].y + vx[rr][i].z * vx[rr][i].z + vx[rr][i].w * vx[rr][i].w;
                ss = wave_sum(ss); rsv[rr] = rsqrtf(ss * (1.0f / D) + 1e-6f); }
            const float* mrow = p.mod + (size_t)(l * 5 + modrow(g0)) * 6 * D; const float* sh = mrow + 3 * D; const float* sc = mrow + 4 * D;
#pragma unroll
            for (int hf = 0; hf < 2; ++hf) {
                pg8::f32x4 ga[4], sa[4], ca[4];
#pragma unroll
                for (int i = 0; i < 4; ++i) { const int d = ((hf * 4 + i) * 64 + lane) * 4; ga[i] = *(const pg8::f32x4*)(gam + d); sa[i] = *(const pg8::f32x4*)(sh + d); ca[i] = *(const pg8::f32x4*)(sc + d); }
                LOAD_FENCE4(ga); LOAD_FENCE4(sa); LOAD_FENCE4(ca);
#pragma unroll
                for (int rr = 0; rr < 2; ++rr) {
                    const int r = 2 * wid + rr; const float rs = rsv[rr];
#pragma unroll
                    for (int i = 0; i < 4; ++i) {
                        const int d = ((hf * 4 + i) * 64 + lane) * 4; const float4 x4 = vx[rr][hf * 4 + i];
                        float4 o;
                        o.x = x4.x * rs * ga[i][0] * (1.0f + ca[i][0]) + sa[i][0]; o.y = x4.y * rs * ga[i][1] * (1.0f + ca[i][1]) + sa[i][1]; o.z = x4.z * rs * ga[i][2] * (1.0f + ca[i][2]) + sa[i][2]; o.w = x4.w * rs * ga[i][3] * (1.0f + ca[i][3]) + sa[i][3];
                        hpk[rr][hf * 4 + i].x = pg8::cvt_pk_bf16(o.x, o.y); hpk[rr][hf * 4 + i].y = pg8::cvt_pk_bf16(o.z, o.w);
                        *(float4*)(At + r * RT_LD + d) = o;
                    }
                }
            }
        }
        lds_barrier();
        {
            const int nt = wid & 3, kh = wid >> 2, fr = lane & 15, q = lane >> 4;
            pg8::f32x4 acc = {0.f, 0.f, 0.f, 0.f};
            const float* wp = p.Wr + (((size_t)(l * 128 + kh * 64) * 4 + nt) * 64 + lane) * 4;
            const float* ap = At + fr * RT_LD + kh * 1024 + 4 * q;
            float4 bc[16], a8[8];
#pragma unroll 1
            for (int jb = 0; jb < 4; ++jb) {
#pragma unroll
                for (int j = 0; j < 16; ++j) bc[j] = *(const float4*)(wp + (size_t)(jb * 16 + j) * 1024);
#pragma unroll
                for (int hb = 0; hb < 2; ++hb) {
#pragma unroll
                    for (int j = 0; j < 8; ++j) a8[j] = *(const float4*)(ap + 16 * (jb * 16 + hb * 8 + j));
                    __builtin_amdgcn_sched_barrier(0);
#pragma unroll
                    for (int j = 0; j < 8; ++j) {
                        acc = __builtin_amdgcn_mfma_f32_16x16x4f32(a8[j].x, bc[hb * 8 + j].x, acc, 0, 0, 0); acc = __builtin_amdgcn_mfma_f32_16x16x4f32(a8[j].y, bc[hb * 8 + j].y, acc, 0, 0, 0);
                        acc = __builtin_amdgcn_mfma_f32_16x16x4f32(a8[j].z, bc[hb * 8 + j].z, acc, 0, 0, 0); acc = __builtin_amdgcn_mfma_f32_16x16x4f32(a8[j].w, bc[hb * 8 + j].w, acc, 0, 0, 0);
                    }
                    __builtin_amdgcn_sched_barrier(0);
                }
            }
#pragma unroll
            for (int jj = 0; jj < 4; ++jj) Pp[(kh * 16 + 4 * q + jj) * 64 + 16 * nt + fr] = acc[jj];
        }
#pragma unroll
        for (int rr = 0; rr < 2; ++rr)
#pragma unroll
            for (int i = 0; i < 8; ++i) *(uint2*)(p.h + (size_t)(g0 + 2 * wid + rr) * D + (i * 64 + lane) * 4) = hpk[rr][i];
        { const int tn = tile + nb < ntiles ? tile + nb : tile; RT_ISSUE(tn); }
        lds_barrier();
#pragma unroll
        for (int rr = 0; rr < 2; ++rr) {
            const int r = 2 * wid + rr, g = g0 + r;
            const float score = 1.0f / (1.0f + expf(-(Pp[r * 64 + lane] + Pp[(16 + r) * 64 + lane])));
            float val = score + rbias;
            int myidx[TOPK]; float mysc[TOPK]; float tot = 0.f;
#pragma unroll
            for (int k = 0; k < TOPK; ++k) {
                float bv = val; int bi = lane;
                amax_dpp<0xB1>(bv, bi); amax_dpp<0x4E>(bv, bi); amax_dpp<0x141>(bv, bi); amax_dpp<0x140>(bv, bi);
#pragma unroll
                for (int o = 16; o <= 32; o <<= 1) { const float ov = bperm_f(lane ^ o, bv); const int oi = bperm_i(lane ^ o, bi); if (ov > bv || (ov == bv && oi < bi)) { bv = ov; bi = oi; } }
                const float sc_k = bperm_f(bi, score);
                myidx[k] = bi; mysc[k] = sc_k; tot += sc_k;
                if (lane == bi) val = -INFINITY;
            }
            if (lane < TOPK) {
                int e = myidx[0]; float w = mysc[0];
#pragma unroll
                for (int k = 1; k < TOPK; ++k) if (lane == k) { e = myidx[k]; w = mysc[k]; }
                w = w / tot * 2.5f;
                p.sel[g * TOPK + lane] = e; p.selw[g * TOPK + lane] = w;
                const int lp = atomicAdd(&lcnt[e], 1);
                int* en = ent + ((nloc * 16 + r) * TOPK + lane) * 4; en[0] = e; en[1] = __float_as_int(w); en[2] = g * 8 + lane; en[3] = lp;
            }
        }
    }
    __syncthreads();
    if (tix < 64) lbase[tix] = lcnt[tix] ? atomicAdd(p.cnt + (l * NEXP + tix) * CNT_STRIDE, lcnt[tix]) : 0;
    __syncthreads();
    for (int i = tix; i < nloc * 16 * TOPK; i += NT) {
        const int e = ent[i * 4], gk = ent[i * 4 + 2], pos = lbase[e] + ent[i * 4 + 3];
        p.ltok[(size_t)e * LCAP + pos] = gk >> 3; p.lw[(size_t)e * LCAP + pos] = __int_as_float(ent[i * 4 + 1]); p.tpos[(gk >> 3) * TOPK + (gk & 7)] = pos;
    }
}

constexpr int MAXU = 17;
__device__ __forceinline__ void moe_tables(const Params& p, LAS int* tab, int lc) {
    const int tix = otid();
    __syncthreads();
    if (tix < 64) {
        const int c = __hip_atomic_load(p.cnt + (lc * NEXP + tix) * CNT_STRIDE, __ATOMIC_RELAXED, __HIP_MEMORY_SCOPE_AGENT), t = (c + 255) / 256;
        int x = t;
#pragma unroll
        for (int o = 1; o < 64; o <<= 1) { const int y = bperm_i((tix - o) & 63, x); if (tix >= o) x += y; }
        const int ex = x - t;
        tab[tix] = ex; tab[66 + tix] = ex * 256; tab[132 + tix] = c;
        if (tix == 63) { int ts = x, of = x * 256; tab[NEXP] = ts; tab[66 + NEXP] = of; ts += M / 256; of += M;
            tab[65] = ts; tab[66 + 65] = of; } }
    __syncthreads();
}
struct MoeSched {
    const LAS int* tab; const LAS unsigned* rowtab; int NPN, G, c, total; unsigned rowbytes; const char* Bt; const char* Bte  ; size_t bstride;
    __device__ __forceinline__ bool next(int i, pg8::Unit& u) const {
        const int Lq = i * G + c; if (Lq >= total) return false;
        const int rt = Lq / NPN; u.pn = Lq - rt * NPN;
        int lo = 0, hi = 64;
        while (lo < hi) { const int mid = (lo + hi + 1) >> 1; if (tab[mid] <= rt) lo = mid; else hi = mid - 1; }
        u.e = lo; u.pm = rt - tab[lo]; u.ord = i; return true;
    }
    __device__ __forceinline__ unsigned arow(const pg8::Unit& u, int r) const { return rowtab[u.ord * 256 + r] * rowbytes; }
    __device__ __forceinline__ const char* bptr(const pg8::Unit& u) const { return (u.e < CV_EEARLY ? Bte : Bt) + (size_t)u.e * bstride + (size_t)u.pn * 256 * rowbytes; }
};
struct EpiGU {
    bf16_t* U; const LAS int* tab;
    __device__ __forceinline__ void operator()(const pg8::f32x4 (&acc)[2][2][4][2], const pg8::Unit& u, int wr, int wc, int fr, int fq) const {
        const int cn = (u.e < NEXP ? tab[132 + u.e] : M), off = tab[66 + u.e], col0 = u.pn * 128 + wc * 32 + 8 * fq;
#pragma unroll
        for (int ai = 0; ai < 2; ++ai)
#pragma unroll
            for (int m = 0; m < 4; ++m) { const int i = u.pm * 256 + ai * 128 + wr * 64 + m * 16 + fr;
                if (i < cn) { float o[8];
#pragma unroll
                    for (int n = 0; n < 2; ++n)
#pragma unroll
                        for (int j = 0; j < 4; ++j) { const float gv = acc[ai][0][m][n][j], uv = acc[ai][1][m][n][j]; o[n * 4 + j] = gv * __builtin_amdgcn_rcpf(1.0f + __expf(-gv)) * uv; }
                    pg8::u32x4 w; w.x = pg8::cvt_pk_bf16(o[0], o[1]); w.y = pg8::cvt_pk_bf16(o[2], o[3]); w.z = pg8::cvt_pk_bf16(o[4], o[5]); w.w = pg8::cvt_pk_bf16(o[6], o[7]);
                    *(pg8::u32x4*)(U + (size_t)(off + i) * DE + col0) = w; } }
    }
};
struct EpiDown {
    bf16_t* Y; const LAS int* tab;
    __device__ __forceinline__ void operator()(const pg8::f32x4 (&acc)[2][2][4][2], const pg8::Unit& u, int wr, int wc, int fr, int fq) const {
        const int cn = (u.e < NEXP ? tab[132 + u.e] : M), off = tab[66 + u.e], col0 = u.pn * 256 + wc * 32 + 8 * fq;
#pragma unroll
        for (int ai = 0; ai < 2; ++ai)
#pragma unroll
            for (int m = 0; m < 4; ++m) { const int i = u.pm * 256 + ai * 128 + wr * 64 + m * 16 + fr;
                if (i < cn) { bf16_t* rowp = Y + (size_t)(off + i) * D + col0;
#pragma unroll
                    for (int bj = 0; bj < 2; ++bj) { const pg8::f32x4 v0 = acc[ai][bj][m][0], v1 = acc[ai][bj][m][1];
                        pg8::u32x4 w; w.x = pg8::cvt_pk_bf16(v0[0], v0[1]); w.y = pg8::cvt_pk_bf16(v0[2], v0[3]); w.z = pg8::cvt_pk_bf16(v1[0], v1[1]); w.w = pg8::cvt_pk_bf16(v1[2], v1[3]);
                        *(pg8::u32x4*)(rowp + bj * 128) = w; } } }
    }
};
template <bool DOWN>
__device__ __forceinline__ void phase_gemm_moe(const Params& p, LAS unsigned char* stage, LAS int* tab, LAS unsigned* rowtab, int l, int bid, int nb) {
    const int tix = otid();
    moe_tables(p, tab, l);
    MoeSched S; S.tab = tab; S.rowtab = rowtab; S.NPN = DOWN ? 8 : 4; S.total = tab[65] * S.NPN; S.G = l == 0 ? gemm_wgs(S.total, nb) : nb; S.c = (S.G % 8 == 0) ? (bid % 8) * (S.G / 8) + bid / 8 : bid;
    const bool gemm_wg = bid < S.G;
    S.rowbytes = DOWN ? DE * 2 : D * 2; S.Bt = DOWN ? (const char*)p.WdnT : (const char*)p.WguT; S.Bte = l == 0 ? S.Bt : (DOWN ? (const char*)p.WdnE : (const char*)p.WguE); S.bstride = DOWN ? (size_t)D * DE * 2 : (size_t)1024 * D * 2;
    if (gemm_wg) for (int i = 0; i < MAXU; ++i) { pg8::Unit u; if (!S.next(i, u)) break;
        if (tix < 256) { const int idx = u.pm * 256 + tix, cn = (u.e < NEXP ? tab[132 + u.e] : M); unsigned v;
            if (DOWN) v = (unsigned)(tab[66 + u.e] + idx); else v = idx < cn ? (u.e < NEXP ? (unsigned)p.ltok[(size_t)u.e * LCAP + idx] : (unsigned)idx) : (unsigned)M;
            rowtab[i * 256 + tix] = v; } }
    __syncthreads();
    if (gemm_wg) {
        if (DOWN) { EpiDown E; E.Y = p.Y; E.tab = tab; pg8::gemm_phase<true>(stage, (const char*)p.U, DE, S, E); }
        else { EpiGU E; E.U = p.U; E.tab = tab; pg8::gemm_phase<true>(stage, (const char*)p.h, D, S, E); } }
    if (l == 0) convert_until(p, (float*)(unsigned char*)stage, p.cvc + (DOWN ? 3 : 2), S.G, gemm_wg);
}
__device__ __forceinline__ void phase_final(const Params& p, LAS int* tab, int bid, int nb) {
    moe_tables(p, tab, 1);
    const int tix = otid();
    const int wid = tix >> 6, lane = tix & 63;
    float4 vn[8]; CombPre cn;
    { const int r = bid * 8 + wid; if (r < NB * L) { const int g = (r / L) * TT + LC + r % L; const float* xr = p.xcur + (size_t)g * D;
#pragma unroll
        for (int i = 0; i < 8; ++i) vn[i] = *(const float4*)(xr + (i * 64 + lane) * 4);
        comb_prefetch(p, g, cn); } }
    for (int r = bid * 8 + wid; r < NB * L; r += nb * 8) {
        const int b = r / L, t = r % L;
        float4 v[8]; float ss = 0.f; CombPre cc = cn;
#pragma unroll
        for (int i = 0; i < 8; ++i) v[i] = vn[i];
        { const int rn = r + nb * 8; if (rn < NB * L) { const int gn = (rn / L) * TT + LC + rn % L; const float* xr = p.xcur + (size_t)gn * D;
#pragma unroll
            for (int i = 0; i < 8; ++i) vn[i] = *(const float4*)(xr + (i * 64 + lane) * 4);
            comb_prefetch(p, gn, cn); } }
        moe_combine_row(p, tab, 1, b * TT + LC + t, lane, cc, v);
#pragma unroll
        for (int i = 0; i < 8; ++i) ss += v[i].x * v[i].x + v[i].y * v[i].y + v[i].z * v[i].z + v[i].w * v[i].w;
        ss = wave_sum(ss); const float rs = rsqrtf(ss * (1.0f / D) + 1e-6f);
        pg8::f32x4 fg[8];
#pragma unroll
        for (int i = 0; i < 8; ++i) fg[i] = *(const pg8::f32x4*)(p.final_g + (i * 64 + lane) * 4);
        LOAD_FENCE8(fg);
#pragma unroll
        for (int i = 0; i < 8; ++i) { const int d = (i * 64 + lane) * 4;
            float4 o; o.x = v[i].x * rs * fg[i][0]; o.y = v[i].y * rs * fg[i][1]; o.z = v[i].z * rs * fg[i][2]; o.w = v[i].w * rs * fg[i][3];
            *(float4*)(p.out + (size_t)r * D + d) = o; }
    }
}


constexpr int LDS_BYTES = 160 * 1024;
extern __shared__ __attribute__((aligned(16))) unsigned char dyn_lds_raw[];
__device__ __forceinline__ LAS unsigned char* lds_las(unsigned off) { asm volatile("" : "+s"(off)); return (LAS unsigned char*)(unsigned long)off; }
__device__ __forceinline__ int obid() { int b = blockIdx.x; asm volatile("" : "+s"(b)); return b; }
__device__ __forceinline__ int onb() { int b = gridDim.x; asm volatile("" : "+s"(b)); return b; }
typedef const __attribute__((address_space(4))) Params* KParams;
__device__ __forceinline__ KParams kp_opaque(KParams q) { asm volatile("" : "+s"(q)); return q; }
#define PPH (*(const Params*)kp_opaque(kp))
__global__ __launch_bounds__(512, 2) void mega(Params p_byval) {
    const KParams kp = (KParams)__builtin_amdgcn_kernarg_segment_ptr();
    if (threadIdx.x == 0) *(uint4*)dyn_lds_raw = make_uint4(0u, 0u, 0u, 0u);
    __syncthreads();
    XcdBarrier bar = xcd_barrier_post(PPH.bar, (volatile LAS unsigned*)dyn_lds_raw);
    const unsigned lds0 = (unsigned)(unsigned long long)(LAS unsigned char*)dyn_lds_raw;
#define LDSB ((unsigned char*)lds_las(lds0 + 1024u))
#define lds ((float*)LDSB)
#define stage (lds_las(lds0 + 1024u))
#define tab ((LAS int*)lds_las(lds0 + 1024u + 131072u))
#define rowtab ((LAS unsigned*)lds_las(lds0 + 1024u + 131072u + 1024u))
#define bid (obid())
#define nb (onb())
    phase_copy(PPH, bid, nb);
    phase_router_w(PPH, bid, nb);
    phase_lora_w(PPH, bid, nb);
    phase_adaln(PPH, lds, bid, nb);
    xcd_barrier(bar);
#pragma unroll 1
    for (int l = 0; l < 2; ++l) {
        phase_norm<0>(PPH, lds, tab, l, bid, nb);
        { int first = 0; if (l == 1) { first = __hip_atomic_load(PPH.cvc, __ATOMIC_RELAXED, __HIP_MEMORY_SCOPE_AGENT); first = first < CV_EARLY ? first : CV_EARLY; }
          phase_convert(PPH, lds, l, first, bid, nb); }
        xcd_barrier(bar);
        phase_gemm_in(PPH, stage, l, bid, nb);
        xcd_barrier(bar);
        phase_prep(PPH, lds, l, bid, nb);
        { const int b1 = obid(), n1 = onb(); RwPre pre; rwkv_prefetch(PPH, l, b1, otid(), pre); for (int unit = b1; unit < RW_UNITS; unit += n1) rwkv_unit(PPH, LDSB, l, unit, unit + n1, pre); }
        xcd_barrier(bar);
        { const int tix = otid(), wid = __builtin_amdgcn_readfirstlane(tix >> 6); const int bid_l = obid(), nb_l = onb();
          float* const rp_l = lds + 32768;
          { const Params& pr = PPH; for (int i = tix; i < 12 * 465; i += NT) rp_l[i] = pr.rpb[(size_t)l * 12 * 465 + i] * 1.4426950408889634f; }
          __syncthreads();
          if (bid_l < 96) rwkv_chain(PPH, LDSB, bid_l);
          { const int wt = nb_l > 96 ? 96 + 2 * (nb_l - 96) : nb_l, w0 = nb_l > 96 ? (bid_l < 96 ? bid_l : 96 + 2 * (bid_l - 96)) : bid_l, w1 = nb_l > 96 ? (bid_l < 96 ? bid_l + 1 : 96 + 2 * (bid_l - 95)) : bid_l + 1;
            const int lo = (int)((long)w0 * ATT_LAT2 / wt), hi = (int)((long)w1 * ATT_LAT2 / wt); for (int task = lo + wid; task < hi; task += 8) attn_task2(PPH, rp_l, task); }
          if (l == 0) for (int task = ATT_LAT2 + bid_l * 8 + wid; task < ATT_TASKS2; task += nb_l * 8) attn_task2(PPH, rp_l, task); }
        xcd_barrier(bar);
        { const int b1 = obid(), n1 = onb(); for (int u3 = b1; u3 < RW_UNITS / 2; u3 += n1) if (l == 0 || u3 % (TT / 64) >= 4) rwkv_out(PPH, LDSB, l, u3); }
        xcd_barrier(bar);
        phase_gemm_out(PPH, stage, l, bid, nb);
        xcd_barrier(bar);
        phase_router(PPH, LDSB, l, bid, nb);
        xcd_barrier(bar);
        phase_gemm_moe<false>(PPH, stage, tab, rowtab, l, bid, nb);
        xcd_barrier(bar);
        phase_gemm_moe<true>(PPH, stage, tab, rowtab, l, bid, nb);
        xcd_barrier(bar);
    }
    phase_final(PPH, tab, bid, nb);
}

#undef bid
#undef nb
#undef LDSB
#undef lds
#undef stage
#undef tab
#undef rowtab
extern "C" void kernel_launch(void* const* d_in, const int* in_sizes, int n_in, void* d_out, int out_size, void* d_ws, size_t ws_size, hipStream_t stream) {
    static int grid = 0;
    if (grid == 0) {
        int dev = 0, cus = 0, per_cu = 0;
        if (hipGetDevice(&dev) != hipSuccess || hipDeviceGetAttribute(&cus, hipDeviceAttributeMultiprocessorCount, dev) != hipSuccess) { grid = -1; return; }
        if (hipFuncSetAttribute((const void*)mega, hipFuncAttributeMaxDynamicSharedMemorySize, LDS_BYTES) != hipSuccess) { grid = -1; return; }
        if (hipOccupancyMaxActiveBlocksPerMultiprocessor(&per_cu, (const void*)mega, NT, LDS_BYTES) != hipSuccess || per_cu < 1) { grid = -1; return; }
        (void)hipGetLastError();
        grid = cus;
        if (grid < 96) { grid = -1; return; }
    }
    if (grid < 0) return;
    Params p{};
    const float** pf = (const float**)&p;
    for (int i = 0; i < 32; ++i) pf[i] = (const float*)d_in[i];
    p.out = (float*)d_out;
    char* w = (char*)d_ws; size_t o = 0;
    auto take = [&](size_t bytes) { char* r = w + o; o += (bytes + 255) & ~(size_t)255; return r; };
    p.bar = (unsigned*)take(XCD_BAR_WORDS * 4 + 2 * NEXP * CNT_STRIDE * 4 + 64);
    p.cnt = (int*)(p.bar + XCD_BAR_WORDS); p.cvc = p.cnt + 2 * NEXP * CNT_STRIDE;
    p.mod = (float*)take((size_t)2 * 5 * 6 * D * 4);
    p.xcur = (float*)take((size_t)M * D * 4);
    p.h = (bf16_t*)take((size_t)(M + 1) * D * 2);
    p.mix = (bf16_t*)take((size_t)M * D * 2);
    p.z = (bf16_t*)take((size_t)M * ZLD * 2);
    p.Y = p.z;
    p.streams = (float*)take((size_t)RW_UNITS * 4096 * 16);
    p.bonus = (float*)take((size_t)2 * M * 12 * 4);
    { char* sb = (char*)p.streams; const size_t U = (size_t)RW_UNITS * 4096;
      p.rw_P = (bf16_t*)sb; sb += U * 2; p.rw_Ry = (bf16_t*)sb; sb += U * 2; p.rw_H0 = (bf16_t*)sb; sb += U * 2; p.rw_QT = (float*)sb; sb += U * 4; p.rw_Y0 = (float*)sb; sb += U * 4;
      p.rw_vb = (bf16_t*)sb; sb += U; p.rw_gb = (bf16_t*)sb; sb += U; }
    p.tpos = (int*)take((size_t)M * TOPK * 4);
    p.sel = (int*)take((size_t)M * TOPK * 4);
    p.selw = (float*)take((size_t)M * TOPK * 4);
    p.ltok = (int*)take((size_t)NEXP * LCAP * 4);
    p.lw = (float*)take((size_t)NEXP * LCAP * 4);
    p.U = (bf16_t*)take((size_t)(UROWS + M) * DE * 2);
    p.WinT = (bf16_t*)take((size_t)ZLD * D * 2);
    p.WoutT = (bf16_t*)take((size_t)2 * D * D * 2);
    p.WguT = (bf16_t*)take((size_t)65 * 1024 * D * 2); p.WguE = (bf16_t*)take((size_t)CV_EEARLY * 1024 * D * 2);
    p.WdnT = (bf16_t*)take((size_t)65 * D * DE * 2); p.WdnE = (bf16_t*)take((size_t)CV_EEARLY * D * DE * 2);
    p.Qa = (bf16_t*)take((size_t)NB * 12 * TT * 64 * 2);
    p.Qr = (bf16_t*)take((size_t)NB * 12 * L * 64 * 2);
    p.Ka = (bf16_t*)take((size_t)NB * 12 * TT * 64 * 2);
    p.Vt = (bf16_t*)take((size_t)NB * 12 * 64 * TT * 2);
    p.Wr = (float*)take((size_t)2 * D * NEXP * 4);
    p.Lwa = (bf16_t*)take((size_t)2 * 2 * 12 * 2 * 64 * 72 * 2);
    p.Lg = (bf16_t*)take((size_t)2 * 12 * 64 * 104 * 2);
    if (o > ws_size) return;
    if (hipMemsetAsync(p.bar, 0, XCD_BAR_WORDS * sizeof(unsigned) + 2 * NEXP * CNT_STRIDE * 4 + 64, stream) != hipSuccess) return;
    hipLaunchKernelGGL(mega, dim3(grid), dim3(NT), LDS_BYTES, stream, p);
}
```
